# Optimizing an MI355X kernel written in HIP

```python
import numpy as np
import jax
import jax.numpy as jnp
from jax import lax

D_MODEL = 1024
BATCH = 16
SEQ = 2048
DEPTH = 1

HEAD_DIM = 64
PLE_DIM = 256
NORM_EPS = 1e-6
NEG_INF = -1e30

RW_HEADS = 8
RW_WIDTH = RW_HEADS * HEAD_DIM
RW_DECAY_LORA = 64
RW_AAA_LORA = 64
RW_GATE_LORA = 160
RW_LNX_EPS = 64e-5

NSA_Q_HEADS = 8
NSA_KV_HEADS = 2
NSA_GROUP = NSA_Q_HEADS // NSA_KV_HEADS
NSA_WIDTH = NSA_Q_HEADS * HEAD_DIM
NSA_KV_WIDTH = NSA_KV_HEADS * HEAD_DIM
CMP_BLOCK = 32
CMP_STRIDE = 16
CMP_HIDDEN = 128
SEL_BLOCK = 64
SEL_TOP = 16
SEL_QCHUNK = 64
SEL_FORCE_SCORE = 1e4
WINDOW = 512
WIN_QBLOCK = 128

D_FF = 2816
CONV_WIDTH = 3

IN_SIZES = (RW_WIDTH, RW_WIDTH, RW_WIDTH, NSA_WIDTH, NSA_KV_WIDTH, NSA_KV_WIDTH, NSA_KV_WIDTH, NSA_KV_WIDTH, NSA_KV_WIDTH, NSA_KV_WIDTH, 3 * NSA_Q_HEADS, D_MODEL, D_MODEL)
D_IN = 3 * RW_WIDTH + NSA_WIDTH + 6 * NSA_KV_WIDTH + 3 * NSA_Q_HEADS + 2 * D_MODEL

kernel_name = "hybrid_rwkv7_nsa_convglu_block"


def rmsnorm(x, g):
    xf = x.astype(jnp.float32)
    y = xf * lax.rsqrt(jnp.mean(xf * xf, axis=-1, keepdims=True) + NORM_EPS)
    return (y * g.astype(jnp.float32)).astype(x.dtype)


def token_shift(t):
    return jnp.pad(t, ((0, 0), (1, 0), (0, 0)))[:, :-1]


def masked_softmax(s, mask):
    s = jnp.where(mask, s.astype(jnp.float32), NEG_INF)
    return jnp.where(mask, jax.nn.softmax(s, axis=-1), 0.0)


def rwkv7_time_mix(u, r, k, v, mu_rkv, mu_wag, w0, w1, w2, a0, a1, a2, g1, g2, k_k, k_a, r_k, lnx_g, lnx_b):
    B, S, _ = u.shape
    H, N = RW_HEADS, HEAD_DIM
    f32 = jnp.float32
    r = r + (token_shift(r) - r) * mu_rkv[0]
    k = k + (token_shift(k) - k) * mu_rkv[1]
    v = v + (token_shift(v) - v) * mu_rkv[2]
    du = token_shift(u) - u
    xw = u + du * mu_wag[0]
    xa = u + du * mu_wag[1]
    xg = u + du * mu_wag[2]
    w = -jax.nn.softplus(-(w0 + jnp.tanh(xw @ w1) @ w2)) - 0.5
    decay = jnp.exp(-jnp.exp(w.astype(f32)))
    a = jax.nn.sigmoid(a0 + (xa @ a1) @ a2)
    g = jax.nn.sigmoid(xg @ g1) @ g2
    heads = lambda t: t.astype(f32).reshape(B, S, H, N)
    kk = heads(k * k_k)
    kk = kk / jnp.maximum(jnp.linalg.norm(kk, axis=-1, keepdims=True), 1e-12)
    k = k * (1.0 + (a - 1.0) * k_a)
    rh, kh, vh, ah, wh = heads(r), heads(k), heads(v), heads(a), heads(decay)

    def step(state, inp):
        r_t, w_t, k_t, v_t, kk_t, a_t = inp
        sa = jnp.einsum('bhvk,bhk->bhv', state, -kk_t)
        state = (state * w_t[:, :, None, :]
                 + sa[..., None] * (kk_t * a_t)[:, :, None, :]
                 + v_t[..., None] * k_t[:, :, None, :])
        return state, jnp.einsum('bhvk,bhk->bhv', state, r_t)

    tm = lambda t: jnp.moveaxis(t, 1, 0)
    state0 = jnp.zeros((B, H, N, N), f32)
    _, y = lax.scan(step, state0, (tm(rh), tm(wh), tm(kh), tm(vh), tm(kk), tm(ah)))
    y = jnp.moveaxis(y, 0, 1)
    mean = jnp.mean(y, axis=-1, keepdims=True)
    var = jnp.mean(jnp.square(y - mean), axis=-1, keepdims=True)
    y = ((y - mean) * lax.rsqrt(var + RW_LNX_EPS)).reshape(B, S, RW_WIDTH) * lnx_g + lnx_b
    bonus = jnp.sum(rh * kh * r_k, axis=-1, keepdims=True) * vh
    y = y + bonus.reshape(B, S, RW_WIDTH)
    return y.astype(u.dtype) * g


def nsa_attention(q, kc, vc, ks, vs, kw, vw, gates, cmp_pos, cmp_w1, cmp_w2):
    B, S, _ = q.shape
    Hk, G, Dh = NSA_KV_HEADS, NSA_GROUP, HEAD_DIM
    dt = q.dtype
    tpos = jnp.arange(S)
    q = (q * HEAD_DIM ** -0.5).reshape(B, S, Hk, G, Dh).transpose(0, 2, 3, 1, 4)
    kvh = lambda t: t.reshape(B, S, Hk, Dh).transpose(0, 2, 1, 3)
    kc, vc, ks, vs, kw, vw = kvh(kc), kvh(vc), kvh(ks), kvh(vs), kvh(kw), kvh(vw)

    n_cmp = (S - CMP_BLOCK) // CMP_STRIDE + 1
    cmp_start = np.arange(n_cmp) * CMP_STRIDE
    cmp_idx = cmp_start[:, None] + np.arange(CMP_BLOCK)

    def compress(t, pos, w1, w2):
        blk = t[:, :, cmp_idx] + pos
        return jax.nn.silu(blk.reshape(B, Hk, n_cmp, CMP_BLOCK * Dh) @ w1) @ w2

    kcb = compress(kc, cmp_pos[0], cmp_w1[0], cmp_w2[0])
    vcb = compress(vc, cmp_pos[1], cmp_w1[1], cmp_w2[1])
    cmp_mask = jnp.asarray((cmp_start + CMP_BLOCK - 1)[None, :] <= np.arange(S)[:, None])
    p_cmp = masked_softmax(jnp.einsum('bhgsd,bhcd->bhgsc', q, kcb), cmp_mask)
    o_cmp = jnp.einsum('bhgsc,bhcd->bhgsd', p_cmp.astype(dt), vcb)

    n_sel = S // SEL_BLOCK
    n_top = min(SEL_TOP, n_sel)
    sel_start = np.arange(n_sel) * SEL_BLOCK
    overlap = ((cmp_start[:, None] <= sel_start[None, :] + SEL_BLOCK - 1)
               & (cmp_start[:, None] + CMP_BLOCK - 1 >= sel_start[None, :])).astype(np.float32)
    importance = jnp.einsum('bhgsc,cj->bhsj', p_cmp, jnp.asarray(overlap))
    cur = (tpos // SEL_BLOCK)[:, None]
    blk = jnp.arange(n_sel)[None, :]
    forced = (blk == 0) | (blk == cur) | (blk == cur - 1)
    score = jnp.where(forced, SEL_FORCE_SCORE, jnp.where(blk <= cur, importance, -1.0))
    _, sel_idx = lax.top_k(score, n_top)
    ksb = ks.reshape(B, Hk, n_sel, SEL_BLOCK, Dh)
    vsb = vs.reshape(B, Hk, n_sel, SEL_BLOCK, Dh)
    bi = jnp.arange(B)[:, None, None, None]
    hi = jnp.arange(Hk)[None, :, None, None]
    n_q = S // SEL_QCHUNK

    def sel_chunk(args):
        qc, ic, pc = args
        kb = ksb[bi, hi, ic]
        vb = vsb[bi, hi, ic]
        s = jnp.einsum('bhgqd,bhqnld->bhgqnl', qc, kb)
        kpos = ic[..., None] * SEL_BLOCK + jnp.arange(SEL_BLOCK)
        mask = (kpos <= pc[:, None, None])[:, :, None]
        flat = n_top * SEL_BLOCK
        pr = masked_softmax(s.reshape(B, Hk, G, SEL_QCHUNK, flat),
                            mask.reshape(B, Hk, 1, SEL_QCHUNK, flat))
        return jnp.einsum('bhgqnl,bhqnld->bhgqd', pr.reshape(s.shape).astype(dt), vb)

    q_ch = q.reshape(B, Hk, G, n_q, SEL_QCHUNK, Dh).transpose(3, 0, 1, 2, 4, 5)
    i_ch = sel_idx.reshape(B, Hk, n_q, SEL_QCHUNK, n_top).transpose(2, 0, 1, 3, 4)
    p_ch = tpos.reshape(n_q, SEL_QCHUNK)
    o_sel = lax.map(sel_chunk, (q_ch, i_ch, p_ch))
    o_sel = o_sel.transpose(1, 2, 3, 0, 4, 5).reshape(B, Hk, G, S, Dh)

    n_b = S // WIN_QBLOCK
    n_w = WINDOW // WIN_QBLOCK
    span = (n_w + 1) * WIN_QBLOCK

    def band(t):
        tp = jnp.pad(t, ((0, 0), (0, 0), (WINDOW, 0), (0, 0))).reshape(B, Hk, n_b + n_w, WIN_QBLOCK, Dh)
        return jnp.concatenate([tp[:, :, j:j + n_b] for j in range(n_w + 1)], axis=3)

    kwb, vwb = band(kw), band(vw)
    qpos = np.arange(n_b)[:, None] * WIN_QBLOCK + np.arange(WIN_QBLOCK)
    kpos = np.arange(n_b)[:, None] * WIN_QBLOCK - WINDOW + np.arange(span)
    dist = qpos[:, :, None] - kpos[:, None, :]
    win_mask = jnp.asarray((dist >= 0) & (dist < WINDOW) & (kpos[:, None, :] >= 0))
    s_w = jnp.einsum('bhgnqd,bhnkd->bhgnqk', q.reshape(B, Hk, G, n_b, WIN_QBLOCK, Dh), kwb)
    p_w = masked_softmax(s_w, win_mask)
    o_win = jnp.einsum('bhgnqk,bhnkd->bhgnqd', p_w.astype(dt), vwb).reshape(B, Hk, G, S, Dh)

    gt = jax.nn.sigmoid(gates.reshape(B, S, Hk, G, 3).transpose(0, 2, 3, 1, 4))
    o = gt[..., 0:1] * o_cmp + gt[..., 1:2] * o_sel + gt[..., 2:3] * o_win
    return o.transpose(0, 3, 1, 2, 4).reshape(B, S, NSA_WIDTH)


def conv_glu_ffn(u, w_up, conv_w, conv_b, w_down):
    S = u.shape[1]
    up = u @ w_up
    upp = jnp.pad(up, ((0, 0), (CONV_WIDTH - 1, 0), (0, 0)))
    hc = conv_b + sum(conv_w[j] * upp[:, j:j + S] for j in range(CONV_WIDTH))
    a, b = jnp.split(hc, 2, axis=-1)
    return (jax.nn.silu(a) * b) @ w_down


def setup_inputs(seed: int = 0) -> dict:
    key = jax.random.key(seed)
    ks = iter(list(jax.random.split(key, 40)))
    nrm = lambda shape, scale: scale * jax.random.normal(next(ks), shape, jnp.float32)
    uni = lambda shape, lo, hi: jax.random.uniform(next(ks), shape, jnp.float32, lo, hi)
    L, D, Da = DEPTH, D_MODEL, RW_WIDTH
    return {
        'x': nrm((BATCH, SEQ, D), 1.0),
        'p': nrm((L, BATCH, SEQ, PLE_DIM), 1.0),
        'ln1_g': 1.0 + nrm((L, D), 0.02),
        'w_in': nrm((L, D, D_IN), D ** -0.5),
        'rw_mu_rkv': uni((L, 3, Da), 0.0, 1.0),
        'rw_mu_wag': uni((L, 3, D), 0.0, 1.0),
        'rw_w0': uni((L, Da), -6.0, 1.0),
        'rw_w1': nrm((L, D, RW_DECAY_LORA), D ** -0.5),
        'rw_w2': nrm((L, RW_DECAY_LORA, Da), 0.5 * RW_DECAY_LORA ** -0.5),
        'rw_a0': nrm((L, Da), 0.5),
        'rw_a1': nrm((L, D, RW_AAA_LORA), D ** -0.5),
        'rw_a2': nrm((L, RW_AAA_LORA, Da), 0.5 * RW_AAA_LORA ** -0.5),
        'rw_g1': nrm((L, D, RW_GATE_LORA), D ** -0.5),
        'rw_g2': nrm((L, RW_GATE_LORA, Da), RW_GATE_LORA ** -0.5),
        'rw_k_k': 0.85 + nrm((L, Da), 0.02),
        'rw_k_a': 1.0 + nrm((L, Da), 0.02),
        'rw_r_k': nrm((L, RW_HEADS, HEAD_DIM), 0.1),
        'rw_lnx_g': 1.0 + nrm((L, Da), 0.02),
        'rw_lnx_b': nrm((L, Da), 0.01),
        'nsa_cmp_pos': nrm((L, 2, CMP_BLOCK, HEAD_DIM), 0.1),
        'nsa_cmp_w1': nrm((L, 2, CMP_BLOCK * HEAD_DIM, CMP_HIDDEN), (CMP_BLOCK * HEAD_DIM) ** -0.5),
        'nsa_cmp_w2': nrm((L, 2, CMP_HIDDEN, HEAD_DIM), CMP_HIDDEN ** -0.5),
        'w_out_a': nrm((L, Da, D), Da ** -0.5),
        'w_out_b': nrm((L, NSA_WIDTH, D), NSA_WIDTH ** -0.5),
        'w_out': nrm((L, D, D), D ** -0.5),
        'ln2_g': 1.0 + nrm((L, D), 0.02),
        'w_up': nrm((L, D, 2 * D_FF), D ** -0.5),
        'conv_w': nrm((L, CONV_WIDTH, 2 * D_FF), CONV_WIDTH ** -0.5),
        'conv_b': nrm((L, 2 * D_FF), 0.01),
        'w_down': nrm((L, D_FF, D), D_FF ** -0.5),
        'ln3_g': 1.0 + nrm((L, D), 0.02),
        'w_ple_gate': nrm((L, D, D), D ** -0.5),
        'w_ple_proj': nrm((L, PLE_DIM, D), PLE_DIM ** -0.5),
        'ln_f_g': 1.0 + nrm((D,), 0.02),
    }


def reference(x, p, ln1_g, w_in, rw_mu_rkv, rw_mu_wag, rw_w0, rw_w1, rw_w2, rw_a0, rw_a1, rw_a2,
              rw_g1, rw_g2, rw_k_k, rw_k_a, rw_r_k, rw_lnx_g, rw_lnx_b, nsa_cmp_pos, nsa_cmp_w1,
              nsa_cmp_w2, w_out_a, w_out_b, w_out, ln2_g, w_up, conv_w, conv_b, w_down, ln3_g,
              w_ple_gate, w_ple_proj, ln_f_g):
    splits = [int(s) for s in np.cumsum(IN_SIZES)[:-1]]
    h = x
    for i in range(DEPTH):
        u = rmsnorm(h, ln1_g[i])
        (r, k, v, q, kc, vc, ks, vs, kw, vw, nsa_g, gate_a, gate_b) = jnp.split(u @ w_in[i], splits, axis=-1)
        y_a = rwkv7_time_mix(u, r, k, v, rw_mu_rkv[i], rw_mu_wag[i], rw_w0[i], rw_w1[i], rw_w2[i],
                             rw_a0[i], rw_a1[i], rw_a2[i], rw_g1[i], rw_g2[i], rw_k_k[i], rw_k_a[i],
                             rw_r_k[i], rw_lnx_g[i], rw_lnx_b[i]) @ w_out_a[i]
        y_b = nsa_attention(q, kc, vc, ks, vs, kw, vw, nsa_g, nsa_cmp_pos[i], nsa_cmp_w1[i],
                            nsa_cmp_w2[i]) @ w_out_b[i]
        h = h + (jax.nn.sigmoid(gate_a) * y_a + jax.nn.sigmoid(gate_b) * y_b) @ w_out[i]
        h = h + conv_glu_ffn(rmsnorm(h, ln2_g[i]), w_up[i], conv_w[i], conv_b[i], w_down[i])
        h = h + jax.nn.sigmoid(rmsnorm(h, ln3_g[i]) @ w_ple_gate[i]) * (p[i] @ w_ple_proj[i])
    return rmsnorm(h, ln_f_g)
```

```cpp
#include <hip/hip_runtime.h>
#include <hip/hip_cooperative_groups.h>
#include <cstdio>
#include <cstdint>
namespace cg = cooperative_groups;

#define LAS __attribute__((address_space(3)))
typedef unsigned short bf16_t;
typedef short bf16x8 __attribute__((ext_vector_type(8)));
typedef short s16x4 __attribute__((ext_vector_type(4)));
typedef float f32x4 __attribute__((ext_vector_type(4)));
typedef float f32x2 __attribute__((ext_vector_type(2)));
typedef float f32x16 __attribute__((ext_vector_type(16)));
typedef unsigned u32x4 __attribute__((ext_vector_type(4)));
typedef unsigned u32x2 __attribute__((ext_vector_type(2)));

constexpr int T = 32768, SEQ = 2048, NBATCH = 16, DM = 1024, DFF = 2816, PLE = 256;
constexpr int LDP = 3416;
constexpr int C_R = 0, C_K = 512, C_V = 1024, C_Q = 1536, C_KC = 2048, C_VC = 2176, C_KS = 2304, C_VS = 2432, C_KW = 2560, C_VW = 2688, C_NG = 2816, C_L1 = 2840, C_L2 = 3128;
constexpr int WIN_LD = 4888;
constexpr float QSCALE = 0.125f * 1.4426950408889634f;
constexpr int NTHREADS = 512, NWAVES = 8;
constexpr int LDS_BYTES = 160768;

constexpr size_t MiB = 1u << 20, KiB = 1u << 10;
constexpr size_t WS_CTL = 0;
constexpr size_t WS_WIN = 1 * MiB, WS_WG = 8 * MiB, WS_WUP = 12 * MiB, WS_WDN = 23 * MiB, WS_WO = 29 * MiB, WS_WPG = 31 * MiB, WS_WOA = 33 * MiB, WS_WOB = 34 * MiB;
constexpr size_t WS_WPP = 35 * MiB, WS_WL2 = 35 * MiB + 512 * KiB, WS_WC1K = 36 * MiB + 768 * KiB, WS_WC1V = 37 * MiB + 256 * KiB, WS_CB = 37 * MiB + 768 * KiB;
constexpr size_t WS_KCB = 38 * MiB, WS_VCB = 38 * MiB + 512 * KiB, WS_H12K = 39 * MiB, WS_H12V = 41 * MiB, WS_PB = 43 * MiB;
constexpr size_t WS_PROJ = 59 * MiB, WS_LO = 273 * MiB, WS_A2 = 369 * MiB, WS_YA = 393 * MiB, WS_YB = 425 * MiB;
constexpr size_t WS_SG = 59 * MiB, WS_M = 187 * MiB, WS_U2 = 251 * MiB, WS_ACT = 59 * MiB, WS_PP = 315 * MiB, WS_H12P = 457 * MiB, WS_GH = 393 * MiB, WS_PART = 425 * MiB, WS_RS = 428 * MiB;
constexpr size_t WS_END = 491 * MiB;

__device__ __forceinline__ float bf2f(unsigned v) { return __uint_as_float(v << 16); }
typedef __bf16 bf16x2_t __attribute__((ext_vector_type(2)));
__device__ __forceinline__ unsigned cvt_pk_bf16(float lo, float hi) { const f32x2 v = {lo, hi}; const bf16x2_t b = __builtin_convertvector(v, bf16x2_t); return __builtin_bit_cast(unsigned, b); }
__device__ __forceinline__ float sigmoidf_(float x) { return __builtin_amdgcn_rcpf(1.f + __expf(-x)); }
__device__ __forceinline__ float tanhf_(float x) { return 1.f - 2.f * __builtin_amdgcn_rcpf(__expf(2.f * x) + 1.f); }
__device__ __forceinline__ void unpack8(const u32x4 w, float* f) {
    f[0] = bf2f(w.x & 0xffffu); f[1] = __uint_as_float(w.x & 0xffff0000u); f[2] = bf2f(w.y & 0xffffu); f[3] = __uint_as_float(w.y & 0xffff0000u);
    f[4] = bf2f(w.z & 0xffffu); f[5] = __uint_as_float(w.z & 0xffff0000u); f[6] = bf2f(w.w & 0xffffu); f[7] = __uint_as_float(w.w & 0xffff0000u);
}
__device__ __forceinline__ void unpack4(const u32x2 w, float* f) {
    f[0] = bf2f(w.x & 0xffffu); f[1] = __uint_as_float(w.x & 0xffff0000u); f[2] = bf2f(w.y & 0xffffu); f[3] = __uint_as_float(w.y & 0xffff0000u);
}
template <int CTRL> __device__ __forceinline__ float dpp_f(float x) { return __builtin_bit_cast(float, __builtin_amdgcn_update_dpp(0, __builtin_bit_cast(int, x), CTRL, 0xf, 0xf, true)); }
__device__ __forceinline__ float red8(float x) { x += dpp_f<0xB1>(x); x += dpp_f<0x4E>(x); x += dpp_f<0x141>(x); return x; }
__device__ __forceinline__ float red16(float x) { x = red8(x); x += dpp_f<0x140>(x); return x; }
__device__ __forceinline__ float wave_sum(float v) {
#pragma unroll
    for (int o = 1; o < 64; o <<= 1) v += __shfl_xor(v, o);
    return v;
}

namespace pg8 {
constexpr int BM = 256, BK = 64, HALF = 128, HTB = HALF * BK * 2, STAGE_BYTES = 8 * HTB, NXCD = 8, WGM = 4;
__host__ __device__ __forceinline__ int lds_byte(int r, int c) { const int st = (r >> 4) * 2 + (c >> 5), rr = r & 15, cc = c & 31, ob = rr * 64 + cc * 2; return st * 1024 + (ob ^ (((ob >> 9) & 1) << 5)); }
__host__ __device__ __forceinline__ void stage_rc(int b, int& R, int& C) { const int st = b / 1024, sb = b % 1024, swz = sb ^ (((sb >> 9) & 1) << 5); R = (st >> 1) * 16 + swz / 64; C = (st & 1) * 32 + (swz % 64) / 2; }
__host__ __device__ __forceinline__ int perm32(int rho) { const int n = rho >> 4, i = rho & 15; return 8 * (i >> 2) + 4 * n + (i & 3); }
struct Unit { int pm, pn; };
struct Gemm { const bf16_t* A; const bf16_t* Bt; int M, N, K; unsigned a_row; size_t a_kstep, a_hstep, a_tstep; int ldb; };
__device__ __forceinline__ Gemm mk_gemm(const bf16_t* A, int lda, const bf16_t* Bt, int M, int N, int K) {
    Gemm g; g.A = A; g.Bt = Bt; g.M = M; g.N = N; g.K = K; g.a_row = (unsigned)lda * 2u; g.a_kstep = 128; g.a_hstep = (size_t)HALF * lda * 2; g.a_tstep = 2 * g.a_hstep; g.ldb = K; return g;
}
struct StaticOrder {
    int nM, nN, nwg, G, c;
    __device__ __forceinline__ void init(int M, int N, int G_, int c_) { nM = M / BM; nN = N / BM; nwg = nM * nN; G = G_; c = c_; }
    __device__ __forceinline__ bool next(int i, Unit& u) const {
        const long L = (long)i * G + c; if (L >= nwg) return false;
        int wgid = (int)L; { const int q = nwg / NXCD, r = nwg % NXCD, xcd = wgid % NXCD, off = wgid / NXCD; wgid = (xcd < r ? xcd * (q + 1) : r * (q + 1) + (xcd - r) * q) + off; }
        const int nig = WGM * nN, gid = wgid / nig, fm = gid * WGM, gsz = (nM - fm) < WGM ? (nM - fm) : WGM;
        u.pm = fm + ((wgid % nig) % gsz); u.pn = (wgid % nig) / gsz; return true;
    }
};

template <int MODE> struct EpiB {
    static constexpr bool PERM = true;
    bf16_t* O; int ldc; int ncols; const float* bias; const float* bias2; const bf16_t* mul; int ldm; const bf16_t* add;
    __device__ __forceinline__ void operator()(const f32x4 (&acc)[2][2][4][2], const Unit& u, int wr, int wc, int fr, int fq) const {
        const int row0 = u.pm * BM + wr * 64 + fr, col0 = u.pn * BM + wc * 32 + 8 * fq;
#pragma unroll
        for (int ai = 0; ai < 2; ++ai)
#pragma unroll
            for (int m = 0; m < 4; ++m) {
                const size_t row = (size_t)(row0 + ai * HALF + m * 16);
#pragma unroll
                for (int bj = 0; bj < 2; ++bj) {
                    const int col = col0 + bj * HALF;
                    if (col < ncols) {
                        f32x4 v0 = acc[ai][bj][m][0], v1 = acc[ai][bj][m][1];
                        if (MODE == 1) {
                            unsigned q[8];
#pragma unroll
                            for (int e = 0; e < 4; ++e) { q[e] = (unsigned)(sigmoidf_(v0[e]) * 255.f + 0.5f); q[4 + e] = (unsigned)(sigmoidf_(v1[e]) * 255.f + 0.5f); }
                            u32x2 wq; wq.x = q[0] | (q[1] << 8) | (q[2] << 16) | (q[3] << 24); wq.y = q[4] | (q[5] << 8) | (q[6] << 16) | (q[7] << 24);
                            *(u32x2*)((unsigned char*)O + row * ldc + col) = wq;
                            continue;
                        }
                        if (MODE == 2) {
                            if (col < 1024) {
                                const float* bp = col < 512 ? bias + col : bias2 + (col - 512); const f32x4 b0 = *(const f32x4*)bp, b1 = *(const f32x4*)(bp + 4);
                                const float sc = col < 512 ? 0.6065306597f : 1.f;
#pragma unroll
                                for (int e = 0; e < 4; ++e) { v0[e] = sigmoidf_(v0[e] + b0[e]) * sc; v1[e] = sigmoidf_(v1[e] + b1[e]) * sc; }
                            }
                        }
                        if (MODE == 3) {
                            float mf[8]; { const u32x2 mq = *(const u32x2*)((const unsigned char*)mul + row * ldm + col);
#pragma unroll
                                for (int e = 0; e < 4; ++e) { mf[e] = (float)((mq.x >> (8 * e)) & 0xffu) * (1.f / 255.f); mf[4 + e] = (float)((mq.y >> (8 * e)) & 0xffu) * (1.f / 255.f); } }
#pragma unroll
                            for (int e = 0; e < 4; ++e) { v0[e] *= mf[e]; v1[e] *= mf[4 + e]; }
                            if (add) { float af[8]; unpack8(*(const u32x4*)(add + row * ldc + col), af);
#pragma unroll
                                for (int e = 0; e < 4; ++e) { v0[e] += af[e]; v1[e] += af[4 + e]; } }
                        }
                        u32x4 w; w.x = cvt_pk_bf16(v0[0], v0[1]); w.y = cvt_pk_bf16(v0[2], v0[3]); w.z = cvt_pk_bf16(v1[0], v1[1]); w.w = cvt_pk_bf16(v1[2], v1[3]);
                        *(u32x4*)(O + row * ldc + col) = w;
                    }
                }
            }
    }
};
struct EpiProj {
    static constexpr bool PERM = true;
    bf16_t* P; unsigned char* SG8;
    __device__ __forceinline__ void operator()(const f32x4 (&acc)[2][2][4][2], const Unit& u, int wr, int wc, int fr, int fq) const {
        const int row0 = u.pm * BM + wr * 64 + fr, col0 = u.pn * BM + wc * 32 + 8 * fq;
        const bool gates = u.pn >= 14;
#pragma unroll
        for (int ai = 0; ai < 2; ++ai)
#pragma unroll
            for (int m = 0; m < 4; ++m) {
                const size_t row = (size_t)(row0 + ai * HALF + m * 16);
#pragma unroll
                for (int bj = 0; bj < 2; ++bj) {
                    const int col = col0 + bj * HALF;
                    const f32x4 v0 = acc[ai][bj][m][0], v1 = acc[ai][bj][m][1];
                    if (gates) {
                        unsigned q[8];
#pragma unroll
                        for (int e = 0; e < 4; ++e) { q[e] = (unsigned)(sigmoidf_(v0[e]) * 255.f + 0.5f); q[4 + e] = (unsigned)(sigmoidf_(v1[e]) * 255.f + 0.5f); }
                        u32x2 wq; wq.x = q[0] | (q[1] << 8) | (q[2] << 16) | (q[3] << 24); wq.y = q[4] | (q[5] << 8) | (q[6] << 16) | (q[7] << 24);
                        *(u32x2*)(SG8 + row * 2048 + (col - 3584)) = wq;
                    } else if (col < LDP) {
                        u32x4 w; w.x = cvt_pk_bf16(v0[0], v0[1]); w.y = cvt_pk_bf16(v0[2], v0[3]); w.z = cvt_pk_bf16(v1[0], v1[1]); w.w = cvt_pk_bf16(v1[2], v1[3]);
                        *(u32x4*)(P + row * LDP + col) = w;
                    }
                }
            }
    }
};
template <int MODE> struct EpiF {
    static constexpr bool PERM = true;
    const float* base; float* out; int ldc; const bf16_t* pp; const float* rs;
    __device__ __forceinline__ void operator()(const f32x4 (&acc)[2][2][4][2], const Unit& u, int wr, int wc, int fr, int fq) const {
        const int row0 = u.pm * BM + wr * 64 + fr, col0 = u.pn * BM + wc * 32 + 8 * fq;
#pragma unroll
        for (int ai = 0; ai < 2; ++ai)
#pragma unroll
            for (int m = 0; m < 4; ++m) {
                const size_t row = (size_t)(row0 + ai * HALF + m * 16);
#pragma unroll
                for (int bj = 0; bj < 2; ++bj) {
                    const size_t off = row * ldc + col0 + bj * HALF;
                    f32x4 v0 = acc[ai][bj][m][0], v1 = acc[ai][bj][m][1];
                    if (MODE == 1) {
                        float pf[8]; unpack8(*(const u32x4*)(pp + off), pf); const float rr = rs[row];
#pragma unroll
                        for (int e = 0; e < 4; ++e) { v0[e] = sigmoidf_(v0[e] * rr) * pf[e]; v1[e] = sigmoidf_(v1[e] * rr) * pf[4 + e]; }
                    }
                    const f32x4 b0 = *(const f32x4*)(base + off), b1 = *(const f32x4*)(base + off + 4);
                    *(f32x4*)(out + off) = b0 + v0; *(f32x4*)(out + off + 4) = b1 + v1;
                }
                asm volatile("" ::: "memory");
            }
    }
};

template <bool BASEBF> struct EpiFN {
    static constexpr bool PERM = true;
    const void* base; bf16_t* hb; int ldc; float* part;
    __device__ __forceinline__ void operator()(const f32x4 (&acc)[2][2][4][2], const Unit& u, int wr, int wc, int fr, int fq) const {
        const int row0 = u.pm * BM + wr * 64 + fr, col0 = u.pn * BM + wc * 32 + 8 * fq;
        f32x4 bv[4][2][2]; u32x4 bw[4][2];
        auto fetch = [&](int gi) { const size_t row = (size_t)(row0 + (gi >> 2) * HALF + (gi & 3) * 16);
#pragma unroll
            for (int bj = 0; bj < 2; ++bj) { const size_t off = row * ldc + col0 + bj * HALF;
                if (BASEBF) bw[gi & 3][bj] = *(const u32x4*)((const bf16_t*)base + off);
                else { bv[gi & 3][bj][0] = *(const f32x4*)((const float*)base + off); bv[gi & 3][bj][1] = *(const f32x4*)((const float*)base + off + 4); } } };
        fetch(0); fetch(1); fetch(2);
#pragma unroll
        for (int gi = 0; gi < 8; ++gi) {
            const int ai = gi >> 2, m = gi & 3;
            if (gi + 3 < 8) fetch(gi + 3);
            const size_t row = (size_t)(row0 + ai * HALF + m * 16);
            float ss = 0.f;
#pragma unroll
            for (int bj = 0; bj < 2; ++bj) {
                const size_t off = row * ldc + col0 + bj * HALF;
                f32x4 o0, o1;
                if (BASEBF) { float bf[8]; unpack8(bw[gi & 3][bj], bf); o0 = (f32x4){bf[0], bf[1], bf[2], bf[3]} + acc[ai][bj][m][0]; o1 = (f32x4){bf[4], bf[5], bf[6], bf[7]} + acc[ai][bj][m][1]; }
                else { o0 = bv[gi & 3][bj][0] + acc[ai][bj][m][0]; o1 = bv[gi & 3][bj][1] + acc[ai][bj][m][1]; }
                ss += (o0[0] * o0[0] + o0[1] * o0[1]) + (o0[2] * o0[2] + o0[3] * o0[3]) + (o1[0] * o1[0] + o1[1] * o1[1]) + (o1[2] * o1[2] + o1[3] * o1[3]);
                u32x4 w; w.x = cvt_pk_bf16(o0[0], o0[1]); w.y = cvt_pk_bf16(o0[2], o0[3]); w.z = cvt_pk_bf16(o1[0], o1[1]); w.w = cvt_pk_bf16(o1[2], o1[3]);
                *(u32x4*)(hb + off) = w;
            }
            ss += __shfl_xor(ss, 16); ss += __shfl_xor(ss, 32);
            if (fq == 0) part[(size_t)(u.pn * 4 + wc) * T + row] = ss;
        }
    }
};
struct EpiFinal {
    static constexpr bool PERM = true;
    const bf16_t* base; float* out; int ldc; const bf16_t* pp; const float* rs; const float* gf; float* xch; unsigned* cnt; LAS float* lds;
    __device__ __forceinline__ void operator()(f32x4 (&acc)[2][2][4][2], const Unit& u, int wr, int wc, int fr, int fq) const {
        const int row0 = u.pm * BM + wr * 64 + fr, col0 = u.pn * BM + wc * 32 + 8 * fq;
        const int tid = threadIdx.x;
        LAS float* P = lds;
        LAS float* S = lds + 1024;
        u32x4 bv[2][2]; u32x4 pv[2][2]; float rrv[2];
        auto fetch = [&](int gi) { const int rl = (gi >> 2) * HALF + wr * 64 + (gi & 3) * 16 + fr; const size_t row = (size_t)u.pm * BM + rl; rrv[gi & 1] = rs[row];
#pragma unroll
            for (int bj = 0; bj < 2; ++bj) { const size_t off = row * ldc + col0 + bj * HALF; bv[gi & 1][bj] = *(const u32x4*)(base + off); pv[gi & 1][bj] = *(const u32x4*)(pp + off); } };
        fetch(0);
#pragma unroll
        for (int gi = 0; gi < 8; ++gi) {
            const int ai = gi >> 2, m = gi & 3;
            if (gi + 1 < 8) fetch(gi + 1);
            const int rl = ai * HALF + wr * 64 + m * 16 + fr;
            const float rr = rrv[gi & 1];
            float ss = 0.f;
#pragma unroll
            for (int bj = 0; bj < 2; ++bj) {
                float pf[8]; unpack8(pv[gi & 1][bj], pf);
                float bfv[8]; unpack8(bv[gi & 1][bj], bfv); const f32x4 b0 = (f32x4){bfv[0], bfv[1], bfv[2], bfv[3]}, b1 = (f32x4){bfv[4], bfv[5], bfv[6], bfv[7]};
                f32x4 v0 = acc[ai][bj][m][0], v1 = acc[ai][bj][m][1];
#pragma unroll
                for (int e = 0; e < 4; ++e) { v0[e] = b0[e] + sigmoidf_(v0[e] * rr) * pf[e]; v1[e] = b1[e] + sigmoidf_(v1[e] * rr) * pf[4 + e]; }
                acc[ai][bj][m][0] = v0; acc[ai][bj][m][1] = v1;
                ss += (v0[0] * v0[0] + v0[1] * v0[1]) + (v0[2] * v0[2] + v0[3] * v0[3]) + (v1[0] * v1[0] + v1[1] * v1[1]) + (v1[2] * v1[2] + v1[3] * v1[3]);
            }
            ss += __shfl_xor(ss, 16); ss += __shfl_xor(ss, 32);
            if (fq == 0) P[rl * 4 + wc] = ss;
        }
        (void)row0;
        asm volatile("s_waitcnt lgkmcnt(0)" ::: "memory"); __builtin_amdgcn_s_barrier(); asm volatile("" ::: "memory");
        if (tid < 256) { const float sp = (P[tid * 4] + P[tid * 4 + 1]) + (P[tid * 4 + 2] + P[tid * 4 + 3]);
            __hip_atomic_store(xch + ((size_t)(u.pm * 4 + u.pn) * 256 + tid), sp, __ATOMIC_RELAXED, __HIP_MEMORY_SCOPE_AGENT); }
        asm volatile("s_waitcnt vmcnt(0)" ::: "memory"); __builtin_amdgcn_s_barrier(); asm volatile("" ::: "memory");
        if (tid == 0) {
            unsigned* c = cnt + 64 * u.pm;
            __hip_atomic_fetch_add(c, 1u, __ATOMIC_RELEASE, __HIP_MEMORY_SCOPE_AGENT);
            unsigned spin = 0;
            while (__hip_atomic_load(c, __ATOMIC_RELAXED, __HIP_MEMORY_SCOPE_AGENT) < 4u) { __builtin_amdgcn_s_sleep(2); if (++spin > (1u << 22)) break; }
            __builtin_amdgcn_fence(__ATOMIC_ACQUIRE, "agent");
            asm volatile("s_waitcnt vmcnt(0)" ::: "memory");
        }
        __builtin_amdgcn_s_barrier(); asm volatile("" ::: "memory");
        if (tid < 256) { float tot = 0.f;
#pragma unroll
            for (int q = 0; q < 4; ++q) tot += __hip_atomic_load(xch + ((size_t)(u.pm * 4 + q) * 256 + tid), __ATOMIC_RELAXED, __HIP_MEMORY_SCOPE_AGENT);
            S[tid] = 1.f / sqrtf(tot * (1.f / 1024.f) + 1e-6f); }
        asm volatile("s_waitcnt vmcnt(0) lgkmcnt(0)" ::: "memory"); __builtin_amdgcn_s_barrier(); asm volatile("" ::: "memory");
        f32x4 gv[2][2];
#pragma unroll
        for (int bj = 0; bj < 2; ++bj) { gv[bj][0] = *(const f32x4*)(gf + col0 + bj * HALF); gv[bj][1] = *(const f32x4*)(gf + col0 + bj * HALF + 4); }
#pragma unroll
        for (int ai = 0; ai < 2; ++ai)
#pragma unroll
            for (int m = 0; m < 4; ++m) {
                const int rl = ai * HALF + wr * 64 + m * 16 + fr;
                const size_t row = (size_t)u.pm * BM + rl;
                const float sr = S[rl];
#pragma unroll
                for (int bj = 0; bj < 2; ++bj) { const size_t off = row * ldc + col0 + bj * HALF;
                    *(f32x4*)(out + off) = acc[ai][bj][m][0] * sr * gv[bj][0]; *(f32x4*)(out + off + 4) = acc[ai][bj][m][1] * sr * gv[bj][1]; }
            }
        asm volatile("s_waitcnt lgkmcnt(0)" ::: "memory"); __builtin_amdgcn_s_barrier(); asm volatile("" ::: "memory");
    }
};
struct EpiGlu {
    static constexpr bool PERM = true;
    bf16_t* ACT; const float* cw; const float* cb; float* GH; LAS float* halo; const float* rs;
    __device__ __forceinline__ void operator()(const f32x4 (&accr)[2][2][4][2], const Unit& u, int wr, int wc, int fr, int fq) const {
        const int colp = u.pn * 128 + wc * 32 + fq * 8;
        f32x4 acc[2][2][4][2];
        { const size_t tk = (size_t)u.pm * BM + 8 * (16 * wr + fr); const f32x4 r0 = *(const f32x4*)(rs + tk), r1 = *(const f32x4*)(rs + tk + 4);
#pragma unroll
          for (int ai = 0; ai < 2; ++ai)
#pragma unroll
              for (int m = 0; m < 4; ++m) { const float rr = ai ? r1[m] : r0[m];
#pragma unroll
                  for (int bj = 0; bj < 2; ++bj) { acc[ai][bj][m][0] = accr[ai][bj][m][0] * rr; acc[ai][bj][m][1] = accr[ai][bj][m][1] * rr; } } }
        if (wr == 0 && fr == 15) {
#pragma unroll
            for (int bj = 0; bj < 2; ++bj)
#pragma unroll
                for (int jj = 0; jj < 2; ++jj) { LAS float* h = halo + (((wc * 4 + fq) * 2 + bj) * 2 + jj) * 8; *(LAS f32x4*)h = acc[1][bj][2 + jj][0]; *(LAS f32x4*)(h + 4) = acc[1][bj][2 + jj][1]; }
        }
        if (wr == 0 && fr == 0) {
#pragma unroll
            for (int bj = 0; bj < 2; ++bj)
#pragma unroll
                for (int jj = 0; jj < 2; ++jj) { float* gp = GH + ((size_t)(u.pm * 4 + jj) * 2 + bj) * DFF + colp; *(f32x4*)gp = acc[0][bj][jj][0]; *(f32x4*)(gp + 4) = acc[0][bj][jj][1]; }
        }
        if (wr == 1 && fr == 15) {
#pragma unroll
            for (int bj = 0; bj < 2; ++bj)
#pragma unroll
                for (int jj = 0; jj < 2; ++jj) { float* gp = GH + ((size_t)(u.pm * 4 + 2 + jj) * 2 + bj) * DFF + colp; *(f32x4*)gp = acc[1][bj][2 + jj][0]; *(f32x4*)(gp + 4) = acc[1][bj][2 + jj][1]; }
        }
        asm volatile("s_waitcnt lgkmcnt(0)" ::: "memory"); __builtin_amdgcn_s_barrier(); asm volatile("" ::: "memory");
        const size_t tok0 = (size_t)u.pm * BM + 8 * (16 * wr + fr);
#pragma unroll
        for (int n = 0; n < 2; ++n) {
            f32x4 xm1[2], xm2[2];
#pragma unroll
            for (int bj = 0; bj < 2; ++bj) {
#pragma unroll
                for (int e = 0; e < 4; ++e) { xm1[bj][e] = dpp_f<0x111>(acc[1][bj][3][n][e]); xm2[bj][e] = dpp_f<0x111>(acc[1][bj][2][n][e]); }
                if (fr == 0) {
                    if (wr == 1) { const LAS float* h = halo + (((wc * 4 + fq) * 2 + bj) * 2) * 8 + 4 * n; xm2[bj] = *(const LAS f32x4*)h; xm1[bj] = *(const LAS f32x4*)(h + 8); }
                    else { xm1[bj] = (f32x4){0.f, 0.f, 0.f, 0.f}; xm2[bj] = xm1[bj]; }
                }
            }
            const int c0 = colp + 4 * n;
            const f32x4 wa0 = *(const f32x4*)(cw + c0), wa1 = *(const f32x4*)(cw + 5632 + c0), wa2 = *(const f32x4*)(cw + 2 * 5632 + c0), ba = *(const f32x4*)(cb + c0);
            const f32x4 wb0 = *(const f32x4*)(cw + DFF + c0), wb1 = *(const f32x4*)(cw + 5632 + DFF + c0), wb2 = *(const f32x4*)(cw + 2 * 5632 + DFF + c0), bb = *(const f32x4*)(cb + DFF + c0);
#pragma unroll
            for (int j = 0; j < 8; ++j) {
                const f32x4 xa = acc[j >> 2][0][j & 3][n], xb = acc[j >> 2][1][j & 3][n];
                const f32x4 ha = ba + wa0 * xm2[0] + wa1 * xm1[0] + wa2 * xa, hb = bb + wb0 * xm2[1] + wb1 * xm1[1] + wb2 * xb;
                float o[4];
#pragma unroll
                for (int e = 0; e < 4; ++e) o[e] = ha[e] * sigmoidf_(ha[e]) * hb[e];
                u32x2 w; w.x = cvt_pk_bf16(o[0], o[1]); w.y = cvt_pk_bf16(o[2], o[3]);
                *(u32x2*)(ACT + (tok0 + j) * DFF + c0) = w;
                xm2[0] = xm1[0]; xm1[0] = xa; xm2[1] = xm1[1]; xm1[1] = xb;
            }
        }
    }
};

template <class Epi, bool ALIGN_EPI, bool ROWPERM = false>
__device__ __forceinline__ void gemm_phase(LAS unsigned char* lds, const Gemm g, const StaticOrder& S, const Epi& E) {
    int tid = threadIdx.x; asm volatile("" : "+v"(tid));
    const int wid = __builtin_amdgcn_readfirstlane(tid >> 6), lane = tid & 63, wr = wid >> 2, wc = wid & 3, fr = lane & 15, fq = lane >> 4;
    const int K = g.K, nt = K / BK;
    unsigned voffA[2], voffA1[2], voffB[2];
#pragma unroll
    for (int i = 0; i < 2; ++i) { int R, C; stage_rc(tid * 16 + i * 8192, R, C); const int Rb = Epi::PERM ? ((R & ~31) + perm32(R & 31)) : R;
        if constexpr (ROWPERM) { const int tau0 = 8 * (16 * (R >> 6) + (R & 15)) + ((R >> 4) & 3);
            voffA[i] = (unsigned)tau0 * g.a_row + (unsigned)C * 2u; voffA1[i] = (unsigned)(tau0 + 4) * g.a_row + (unsigned)C * 2u; }
        else { voffA[i] = (unsigned)R * g.a_row + (unsigned)C * 2u; voffA1[i] = 0u; }
        voffB[i] = (unsigned)(Rb * g.ldb + C) * 2u; }
#define PG8_STAGE_A1(bufoff, gbase) do { if constexpr (ROWPERM) { PG8_STAGE(bufoff, gbase, voffA1); } else { PG8_STAGE(bufoff, (gbase) + ahstep, voffA); } } while (0)
    const size_t akstep = g.a_kstep, ahstep = g.a_hstep, atstep = g.a_tstep;
    const size_t bkstep = (size_t)(BK * 2), bhstep = (size_t)HALF * g.ldb * 2, btstep = 2 * bhstep;
    const unsigned ldsw = (unsigned)wid * 1024u;
    const int aoff = lds_byte(wr * 64 + fr, fq * 8), boff = lds_byte(wc * 32 + fr, fq * 8);
#define PG8_SA(b, h) (((b) * 2 + (h)) * HTB)
#define PG8_SB(b, h) ((4 + (b) * 2 + (h)) * HTB)
#define PG8_STAGE(bufoff, gbase, voff) do { _Pragma("unroll") for (int _i = 0; _i < 2; ++_i) \
        __builtin_amdgcn_global_load_lds((const unsigned*)((const char*)(gbase) + (voff)[_i]), (LAS unsigned*)(lds + (bufoff) + ldsw + _i * 8192), 16, 0, 0); } while (0)
#define PG8_LDA(dst, b, h) do { _Pragma("unroll") for (int m = 0; m < 4; ++m) _Pragma("unroll") for (int k = 0; k < 2; ++k) dst[m][k] = *(const LAS bf16x8*)(lds + PG8_SA(b, h) + aoff + m * 2048 + k * 1024); } while (0)
#define PG8_LDB(dst, b, h) do { _Pragma("unroll") for (int n = 0; n < 2; ++n) _Pragma("unroll") for (int k = 0; k < 2; ++k) dst[n][k] = *(const LAS bf16x8*)(lds + PG8_SB(b, h) + boff + n * 2048 + k * 1024); } while (0)
#define PG8_MMA(ai, bj, At, Bt) do { __builtin_amdgcn_s_setprio(1); _Pragma("unroll") for (int m = 0; m < 4; ++m) _Pragma("unroll") for (int n = 0; n < 2; ++n) _Pragma("unroll") for (int k = 0; k < 2; ++k) \
        acc[ai][bj][m][n] = __builtin_amdgcn_mfma_f32_16x16x32_bf16(Bt[n][k], At[m][k], acc[ai][bj][m][n], 0, 0, 0); __builtin_amdgcn_s_setprio(0); } while (0)
#define PG8_WAIT_V(n) asm volatile("s_waitcnt vmcnt(" #n ")" ::: "memory")
#define PG8_WAIT_L(n) asm volatile("s_waitcnt lgkmcnt(" #n ")" ::: "memory")
#define PG8_BAR __builtin_amdgcn_s_barrier()
#define PG8_SCHED __builtin_amdgcn_sched_barrier(0)
    Unit cur, nxt; int ui = 0;
    if (!S.next(0, cur)) return;
    f32x4 acc[2][2][4][2];
#pragma unroll
    for (int a = 0; a < 2; ++a)
#pragma unroll
        for (int b = 0; b < 2; ++b)
#pragma unroll
            for (int m = 0; m < 4; ++m)
#pragma unroll
                for (int n = 0; n < 2; ++n) acc[a][b][m][n] = (f32x4){0.f, 0.f, 0.f, 0.f};
    bf16x8 At[4][2], B0[2][2], B1[2][2];
    const char* cA = (const char*)g.A + (size_t)cur.pm * atstep; const char* cB = (const char*)g.Bt + (size_t)cur.pn * btstep;
    PG8_STAGE(PG8_SB(0, 0), cB, voffB); PG8_STAGE(PG8_SB(0, 1), cB + bhstep, voffB); PG8_STAGE(PG8_SA(0, 0), cA, voffA); PG8_STAGE_A1(PG8_SA(0, 1), cA);
    if (wr == 1) PG8_BAR;
    PG8_WAIT_V(2); PG8_BAR;
    PG8_STAGE(PG8_SB(1, 0), cB + bkstep, voffB); PG8_STAGE(PG8_SA(1, 0), cA + akstep, voffA); PG8_STAGE(PG8_SB(1, 1), cB + bhstep + bkstep, voffB);
    PG8_WAIT_V(6); PG8_BAR;
    for (;;) {
        const bool has_next = S.next(ui + 1, nxt);
        const char* nA = has_next ? (const char*)g.A + (size_t)nxt.pm * atstep : cA; const char* nB = has_next ? (const char*)g.Bt + (size_t)nxt.pn * btstep : cB;
        for (int t = 0; t < nt; t += 2) {
            const bool last = (t == nt - 2);
            const char* a1 = cA + (size_t)(t + 1) * akstep;
            const char* a2 = last ? nA : cA + (size_t)(t + 2) * akstep; const char* b2 = last ? nB : cB + (size_t)(t + 2) * bkstep;
            const char* a3 = a2 + akstep; const char* b3 = b2 + bkstep;
            PG8_LDB(B0, 0, 0); PG8_LDB(B1, 0, 1); PG8_SCHED; PG8_LDA(At, 0, 0); PG8_STAGE_A1(PG8_SA(1, 1), a1);
            PG8_WAIT_V(8); PG8_WAIT_L(0); PG8_BAR; PG8_MMA(0, 0, At, B0); PG8_MMA(0, 1, At, B1); PG8_BAR; PG8_SCHED;
            PG8_LDA(At, 0, 1); PG8_STAGE(PG8_SB(0, 0), b2, voffB); PG8_STAGE(PG8_SB(0, 1), b2 + bhstep, voffB); PG8_STAGE(PG8_SA(0, 0), a2, voffA);
            PG8_WAIT_V(8); PG8_WAIT_L(0); PG8_BAR; PG8_MMA(1, 0, At, B0); PG8_MMA(1, 1, At, B1); PG8_BAR; PG8_SCHED;
            PG8_LDB(B0, 1, 0); PG8_LDB(B1, 1, 1); PG8_SCHED; PG8_LDA(At, 1, 0); PG8_STAGE_A1(PG8_SA(0, 1), a2);
            PG8_WAIT_V(8); PG8_WAIT_L(0); PG8_BAR; PG8_MMA(0, 0, At, B0); PG8_MMA(0, 1, At, B1); PG8_BAR; PG8_SCHED;
            PG8_LDA(At, 1, 1); PG8_STAGE(PG8_SB(1, 0), b3, voffB); PG8_STAGE(PG8_SB(1, 1), b3 + bhstep, voffB); PG8_STAGE(PG8_SA(1, 0), a3, voffA);
            PG8_WAIT_V(8); PG8_WAIT_L(0); PG8_BAR; PG8_MMA(1, 0, At, B0); PG8_MMA(1, 1, At, B1); PG8_BAR; PG8_SCHED;
        }
        if constexpr (ALIGN_EPI) { if (wr == 0) PG8_BAR; }
        E(acc, cur, wr, wc, fr, fq);
        if (!has_next) break;
#pragma unroll
        for (int a = 0; a < 2; ++a)
#pragma unroll
            for (int b = 0; b < 2; ++b)
#pragma unroll
                for (int m = 0; m < 4; ++m)
#pragma unroll
                    for (int n = 0; n < 2; ++n) acc[a][b][m][n] = (f32x4){0.f, 0.f, 0.f, 0.f};
        cur = nxt; cA = nA; cB = nB; ++ui;
        if constexpr (ALIGN_EPI) { if (wr == 1) PG8_BAR; }
    }
    PG8_WAIT_V(0);
    if constexpr (!ALIGN_EPI) { if (wr == 0) PG8_BAR; }
    PG8_BAR;
#undef PG8_SA
#undef PG8_SB
#undef PG8_STAGE
#undef PG8_STAGE_A1
#undef PG8_LDA
#undef PG8_LDB
#undef PG8_MMA
#undef PG8_WAIT_V
#undef PG8_WAIT_L
#undef PG8_BAR
#undef PG8_SCHED
}
}

struct Args {
    const float* in[34];
    float* out; unsigned char* ws;
};
enum { I_X = 0, I_P, I_LN1, I_WIN, I_MURKV, I_MUWAG, I_W0, I_W1, I_W2, I_A0, I_A1, I_A2, I_G1, I_G2, I_KK, I_KA, I_RK, I_LNXG, I_LNXB, I_CPOS, I_CW1, I_CW2,
       I_WOA, I_WOB, I_WO, I_LN2, I_WUP, I_CONVW, I_CONVB, I_WDN, I_LN3, I_WPG, I_WPP, I_LNF };

template <class F> __device__ __forceinline__ void tr_matrix(F f, int Kd, int Nd, bf16_t* WT, float* scr, int gw, int NGW, int lane) {
    const int nblk = Nd / 32, nitems = (Kd / 64) * nblk;
    for (int item = gw; item < nitems; item += NGW) {
        const int kb = item / nblk, nb = item % nblk, k0 = 64 * kb, n0 = 32 * nb;
#pragma unroll 16
        for (int i = 0; i < 32; ++i) { const int kk = 2 * i + (lane >> 5); scr[kk * 33 + (lane & 31)] = f(k0 + kk, n0 + (lane & 31)); }
        asm volatile("s_waitcnt lgkmcnt(0)" ::: "memory");
        const int c = lane & 7;
#pragma unroll
        for (int j = 0; j < 4; ++j) { const int n = (lane >> 3) + 8 * j; const float* s = scr + (8 * c) * 33 + n;
            u32x4 o; o.x = cvt_pk_bf16(s[0 * 33], s[1 * 33]); o.y = cvt_pk_bf16(s[2 * 33], s[3 * 33]); o.z = cvt_pk_bf16(s[4 * 33], s[5 * 33]); o.w = cvt_pk_bf16(s[6 * 33], s[7 * 33]);
            *(u32x4*)(WT + (size_t)(n0 + n) * Kd + k0 + 8 * c) = o; }
        asm volatile("s_waitcnt lgkmcnt(0)" ::: "memory");
    }
}
template <bool OUT_BF16, bool NT = false> __device__ __forceinline__ void rms_rows(float* x, const float* g, bf16_t* ob, int gw, int NGW, int lane) {
    const f32x4* gr = (const f32x4*)g + lane;
    f32x4 gg[4];
#pragma unroll
    for (int j = 0; j < 4; ++j) gg[j] = gr[64 * j];
    for (int r0 = gw; r0 < T; r0 += 4 * NGW) {
        f32x4 v[4][4];
#pragma unroll
        for (int u = 0; u < 4; ++u) { const int r = r0 + u * NGW; if (r < T) { const f32x4* xr = (const f32x4*)(x + (size_t)r * DM) + lane;
#pragma unroll
            for (int j = 0; j < 4; ++j) v[u][j] = NT ? __builtin_nontemporal_load(xr + 64 * j) : xr[64 * j]; } }
#pragma unroll
        for (int u = 0; u < 4; ++u) { const int r = r0 + u * NGW; if (r < T) {
            float s = 0.f;
#pragma unroll
            for (int j = 0; j < 4; ++j) s += (v[u][j].x * v[u][j].x + v[u][j].y * v[u][j].y) + (v[u][j].z * v[u][j].z + v[u][j].w * v[u][j].w);
            const float rs = 1.f / sqrtf(wave_sum(s) * (1.f / 1024.f) + 1e-6f);
            if (OUT_BF16) { u32x2* o8 = (u32x2*)(ob + (size_t)r * DM) + lane;
#pragma unroll
                for (int j = 0; j < 4; ++j) { u32x2 w; w.x = cvt_pk_bf16(v[u][j].x * rs * gg[j].x, v[u][j].y * rs * gg[j].y); w.y = cvt_pk_bf16(v[u][j].z * rs * gg[j].z, v[u][j].w * rs * gg[j].w); o8[64 * j] = w; }
            } else { f32x4* xr = (f32x4*)(x + (size_t)r * DM) + lane;
#pragma unroll
                for (int j = 0; j < 4; ++j) xr[64 * j] = v[u][j] * rs * gg[j]; }
        } }
    }
}

__device__ __forceinline__ bf16x8 afrag(const bf16_t* base, int pitch, int row, int kofs, int hi) {
    const bf16_t* p = base + row * pitch + kofs + 4 * hi;
    const s16x4 lo = *(const s16x4*)p, hh = *(const s16x4*)(p + 8);
    return (bf16x8){lo[0], lo[1], lo[2], lo[3], hh[0], hh[1], hh[2], hh[3]};
}
__device__ __forceinline__ bf16x8 pack8(const f32x16& a, int b) {
    u32x4 w; w.x = cvt_pk_bf16(a[b + 0], a[b + 1]); w.y = cvt_pk_bf16(a[b + 2], a[b + 3]); w.z = cvt_pk_bf16(a[b + 4], a[b + 5]); w.w = cvt_pk_bf16(a[b + 6], a[b + 7]);
    return __builtin_bit_cast(bf16x8, w);
}
#define LBAR() asm volatile("s_waitcnt lgkmcnt(0)\n\ts_barrier" ::: "memory")
constexpr int SC_KK = 0, SC_WW = 8192, SC_BB = 16384, SC_K2 = 24576, SC_RR = 32768, SC_YY = 40960, SC_VV = 49152  , SC_BON = 73728  ;
constexpr int SC_KBT = 74240  , SC_CT = 82944  , SC_OPS = 93440  , SC_OPB = 15616;
constexpr int SC_TAB = 155904;
constexpr int OP_XT = 0, OP_KB = 4352, OP_VT = 8960, OP_WL = 11520, OP_A3 = 11776, OP_A4 = 13056, OP_A5 = 14336;
static_assert(SC_OPS + 4 * SC_OPB <= SC_TAB && SC_TAB + 2048 <= LDS_BYTES - 64, "scan LDS map");
__device__ __forceinline__ void scan_unit(const Args& A, int bh, unsigned char* L) {
    int tid = threadIdx.x; asm volatile("" : "+v"(tid));
    const int b = bh >> 3, h = bh & 7;
    const bf16_t* PROJ = (const bf16_t*)(A.ws + WS_PROJ); const bf16_t* LO = (const bf16_t*)(A.ws + WS_LO); bf16_t* YA = (bf16_t*)(A.ws + WS_YA);
    float* KK = (float*)(L + SC_KK); float* WW = (float*)(L + SC_WW); float* BB = (float*)(L + SC_BB); float* K2 = (float*)(L + SC_K2); float* RR = (float*)(L + SC_RR); float* YY = (float*)(L + SC_YY);
    const int tt = tid >> 4, c4 = (tid & 15) * 4, ch = h * 64 + c4;
    const int lane = tid & 63, wv = __builtin_amdgcn_readfirstlane(tid >> 6), r32 = lane & 31, hi = lane >> 5;
    float* TAB = (float*)(L + SC_TAB);
    if (tid < 64) { const int cc = h * 64 + tid;
        TAB[tid] = A.in[I_MURKV][cc]; TAB[64 + tid] = A.in[I_MURKV][512 + cc]; TAB[128 + tid] = A.in[I_MURKV][1024 + cc]; TAB[192 + tid] = A.in[I_KK][cc];
        TAB[256 + tid] = A.in[I_KA][cc]; TAB[320 + tid] = A.in[I_RK][cc]; TAB[384 + tid] = A.in[I_LNXG][cc]; TAB[448 + tid] = A.in[I_LNXB][cc]; }
    LBAR();
    const f32x16 zero16s = (f32x16){0.f,0.f,0.f,0.f,0.f,0.f,0.f,0.f,0.f,0.f,0.f,0.f,0.f,0.f,0.f,0.f};
    f32x16 St[2]; St[0] = zero16s; St[1] = zero16s;
    u32x2 raw[9];
    float gq_prev[4] = {0.f, 0.f, 0.f, 0.f}, gq_cur[4] = {0.f, 0.f, 0.f, 0.f}, gq_next[4];
    auto load_raw = [&](int chunk) {
        const size_t t = (size_t)b * SEQ + chunk * 32 + tt;
        const bf16_t* p = PROJ + t * LDP + ch;
        raw[0] = *(const u32x2*)(p + C_R); raw[1] = *(const u32x2*)(p + C_K); raw[2] = *(const u32x2*)(p + C_V);
        if (chunk == 0 && tt == 0) { raw[3] = (u32x2){0u, 0u}; raw[4] = raw[3]; raw[5] = raw[3]; }
        else { raw[3] = *(const u32x2*)(p - LDP + C_R); raw[4] = *(const u32x2*)(p - LDP + C_K); raw[5] = *(const u32x2*)(p - LDP + C_V); }
        const bf16_t* q = LO + t * 1536 + ch;
        raw[6] = *(const u32x2*)(q); raw[7] = *(const u32x2*)(q + 512); raw[8] = *(const u32x2*)(q + 1024);
    };
    auto prep = [&](int c) {
        float* VV = (float*)(L + SC_VV + (c % 3) * 8192); float* BON = (float*)(L + SC_BON + (c % 3) * 128);
        float r[4], k[4], v[4], rp[4], kp[4], vp[4], ew[4], a[4];
        unpack4(raw[0], r); unpack4(raw[1], k); unpack4(raw[2], v); unpack4(raw[3], rp); unpack4(raw[4], kp); unpack4(raw[5], vp); unpack4(raw[6], ew); unpack4(raw[7], a); unpack4(raw[8], gq_next);
        const f32x4 mu_r = *(const f32x4*)(TAB + c4), mu_k = *(const f32x4*)(TAB + 64 + c4), mu_v = *(const f32x4*)(TAB + 128 + c4), k_k = *(const f32x4*)(TAB + 192 + c4), k_a = *(const f32x4*)(TAB + 256 + c4), r_k = *(const f32x4*)(TAB + 320 + c4);
        float kku[4], k2[4], ss = 0.f, bon = 0.f;
#pragma unroll
        for (int e = 0; e < 4; ++e) { r[e] += (rp[e] - r[e]) * mu_r[e]; k[e] += (kp[e] - k[e]) * mu_k[e]; v[e] += (vp[e] - v[e]) * mu_v[e];
            kku[e] = k[e] * k_k[e]; ss += kku[e] * kku[e]; k2[e] = k[e] * (1.f + (a[e] - 1.f) * k_a[e]); bon += r[e] * k2[e] * r_k[e]; }
        ss = red16(ss); bon = red16(bon);
        const float inv = 1.f / fmaxf(sqrtf(ss), 1e-12f);
        f32x4 kk4, w4, b4, k24, r4, v4;
#pragma unroll
        for (int e = 0; e < 4; ++e) { const float kk = kku[e] * inv; kk4[e] = kk; w4[e] = __expf(-ew[e]); b4[e] = kk * a[e]; k24[e] = k2[e]; r4[e] = r[e]; v4[e] = v[e]; }
        const int o = tt * 64 + c4;
        *(f32x4*)(KK + o) = kk4; *(f32x4*)(WW + o) = w4; *(f32x4*)(BB + o) = b4; *(f32x4*)(K2 + o) = k24; *(f32x4*)(RR + o) = r4; *(f32x4*)(VV + o) = v4;
        if ((tid & 15) == 0) BON[tt] = bon;
    };
    auto stageB = [&](int c) {
        const float* VV = (const float*)(L + SC_VV + (c % 3) * 8192);
        const int sc = wv >> 2, tq = wv & 3, k = lane;
        unsigned char* blk = L + SC_OPS + ((c & 1) * 2 + sc) * SC_OPB;
        bf16_t* XT = (bf16_t*)(blk + OP_XT); bf16_t* KB = (bf16_t*)(blk + OP_KB); bf16_t* VTt = (bf16_t*)(blk + OP_VT); float* WL = (float*)(blk + OP_WL); bf16_t* KBT = (bf16_t*)(L + SC_KBT + sc * 4352);
        float W = 1.f;
#pragma unroll
        for (int t = 0; t < 12; ++t) { const float wq = WW[(16 * sc + t) * 64 + k]; W *= (t < 4 * tq) ? wq : 1.f; }
#pragma unroll
        for (int t4 = 0; t4 < 4; ++t4) {
            const int t = 4 * tq + t4;
            const int o = (16 * sc + t) * 64 + k;
            const float w = WW[o], kk = KK[o], bq = BB[o], k2 = K2[o], r = RR[o], vv = VV[o];
            const float alpha = W * kk; W *= w; const float invW = __builtin_amdgcn_rcpf(W);
            const float beta = bq * invW, kappa = k2 * invW, rho = W * r;
            const unsigned pa = cvt_pk_bf16(alpha, rho), pk = cvt_pk_bf16(kappa, beta), pn = cvt_pk_bf16(-beta, vv);
            XT[t * 68 + k] = (bf16_t)(pa & 0xffffu); XT[(16 + t) * 68 + k] = (bf16_t)(pa >> 16);
            KBT[t * 68 + k] = (bf16_t)(pk & 0xffffu); KBT[(16 + t) * 68 + k] = (bf16_t)(pk >> 16);
            KB[k * 36 + t] = (bf16_t)(pk & 0xffffu); KB[k * 36 + 16 + t] = (bf16_t)(pn & 0xffffu);
            VTt[k * 20 + t] = (bf16_t)(pn >> 16);
        }
        if (tq == 3) WL[k] = W;
    };
    auto stageC = [&](int c) {
        const int sc = wv - 2;
        unsigned char* blk = L + SC_OPS + ((c & 1) * 2 + sc) * SC_OPB;
        const bf16_t* XT = (const bf16_t*)(blk + OP_XT); const bf16_t* KBT = (const bf16_t*)(L + SC_KBT + sc * 4352);
        float* SM = (float*)(L + SC_CT + sc * 5248); float* QT = SM + 1056; bf16_t* A3 = (bf16_t*)(blk + OP_A3); bf16_t* A4 = (bf16_t*)(blk + OP_A4); bf16_t* A5 = (bf16_t*)(blk + OP_A5);
        f32x16 sm = zero16s;
#pragma unroll
        for (int cc = 0; cc < 4; ++cc) sm = __builtin_amdgcn_mfma_f32_32x32x16_bf16(afrag(KBT, 68, r32, 16 * cc, hi), afrag(XT, 68, r32, 16 * cc, hi), sm, 0, 0, 0);
#pragma unroll
        for (int r = 0; r < 16; ++r) SM[((r & 3) + 8 * (r >> 2) + 4 * hi) * 33 + r32] = sm[r];
        if (r32 < 16) { *(f32x4*)(QT + r32 * 16 + 4 * hi) = (f32x4){sm[8], sm[9], sm[10], sm[11]}; *(f32x4*)(QT + r32 * 16 + 8 + 4 * hi) = (f32x4){sm[12], sm[13], sm[14], sm[15]}; }
        asm volatile("s_waitcnt lgkmcnt(0)" ::: "memory");
        {
            const int rr = lane & 15;
            f32x4 q[16][4];
#pragma unroll
            for (int t = 1; t < 16; ++t)
#pragma unroll
                for (int v4 = 0; v4 < 4; ++v4) if (4 * v4 < t) q[t][v4] = *(const f32x4*)(QT + t * 16 + 4 * v4);
            float N[16];
#pragma unroll
            for (int t = 0; t < 16; ++t) {
                float acc0 = (rr == t) ? 1.f : 0.f, acc1 = 0.f;
#pragma unroll
                for (int i = 0; i < t; ++i) { if (i & 1) acc1 -= N[i] * q[t][i >> 2][i & 3]; else acc0 -= N[i] * q[t][i >> 2][i & 3]; }
                N[t] = acc0 + acc1;
            }
            if (lane < 16) {
#pragma unroll
                for (int t = 0; t < 16; ++t) A4[t * 20 + rr] = (bf16_t)(cvt_pk_bf16(N[t], 0.f) & 0xffffu);
            } else if (lane < 32) {
#pragma unroll
                for (int i = 0; i < 16; ++i) A4[lane * 20 + i] = 0;
            }
        }
        {
            const int m = lane & 31, i0 = (lane >> 5) * 8;
#pragma unroll
            for (int e = 0; e < 8; ++e) { const int i = i0 + e;
                float a3, a5;
                if (m < 16) { a3 = (i < m) ? SM[i * 33 + m] : 0.f; a5 = 0.f; }
                else { const int t = m - 16; a3 = (i <= t) ? SM[i * 33 + 16 + t] : 0.f; a5 = (i <= t) ? -SM[(16 + i) * 33 + 16 + t] : 0.f; }
                const unsigned pk = cvt_pk_bf16(a3, a5);
                A3[m * 20 + i] = (bf16_t)(pk & 0xffffu); A5[m * 20 + i] = (bf16_t)(pk >> 16); }
        }
    };
    auto stageD = [&](int c) {
        bf16x8 fXT[2][4], fKB[2][4], fV[2], fA3[2], fA4[2], fA5[2];
#pragma unroll
        for (int sc = 0; sc < 2; ++sc) {
            const unsigned char* blk = L + SC_OPS + ((c & 1) * 2 + sc) * SC_OPB;
            const bf16_t* XT = (const bf16_t*)(blk + OP_XT); const bf16_t* KB = (const bf16_t*)(blk + OP_KB); const bf16_t* VTt = (const bf16_t*)(blk + OP_VT);
#pragma unroll
            for (int q4 = 0; q4 < 4; ++q4) fXT[sc][q4] = afrag(XT, 68, r32, 16 * q4, hi);
            fV[sc] = afrag(VTt, 20, 32 * wv + r32, 0, hi);
            fA3[sc] = afrag((const bf16_t*)(blk + OP_A3), 20, r32, 0, hi); fA4[sc] = afrag((const bf16_t*)(blk + OP_A4), 20, r32, 0, hi); fA5[sc] = afrag((const bf16_t*)(blk + OP_A5), 20, r32, 0, hi);
#pragma unroll
            for (int t2 = 0; t2 < 2; ++t2) { fKB[sc][2 * t2] = afrag(KB, 36, 32 * t2 + r32, 0, hi); fKB[sc][2 * t2 + 1] = afrag(KB, 36, 32 * t2 + r32, 16, hi); }
        }
#pragma unroll
        for (int sc = 0; sc < 2; ++sc) {
            const float* WL = (const float*)(L + SC_OPS + ((c & 1) * 2 + sc) * SC_OPB + OP_WL);
            f32x4 wl[2][4];
#pragma unroll
            for (int t2 = 0; t2 < 2; ++t2)
#pragma unroll
                for (int g4 = 0; g4 < 4; ++g4) wl[t2][g4] = *(const f32x4*)(WL + 32 * t2 + 8 * g4 + 4 * hi);
            f32x16 Gm = zero16s;
#pragma unroll
            for (int t2 = 0; t2 < 2; ++t2)
#pragma unroll
                for (int cc = 0; cc < 2; ++cc) Gm = __builtin_amdgcn_mfma_f32_32x32x16_bf16(fXT[sc][2 * t2 + cc], pack8(St[t2], 8 * cc), Gm, 0, 0, 0);
            Gm = __builtin_amdgcn_mfma_f32_32x32x16_bf16(fA3[sc], fV[sc], Gm, 0, 0, 0);
            const f32x16 Um = __builtin_amdgcn_mfma_f32_32x32x16_bf16(fA4[sc], pack8(Gm, 0), zero16s, 0, 0, 0);
            const bf16x8 ub = pack8(Um, 0);
#pragma unroll
            for (int t2 = 0; t2 < 2; ++t2) {
                St[t2] = __builtin_amdgcn_mfma_f32_32x32x16_bf16(fKB[sc][2 * t2], fV[sc], St[t2], 0, 0, 0);
                St[t2] = __builtin_amdgcn_mfma_f32_32x32x16_bf16(fKB[sc][2 * t2 + 1], ub, St[t2], 0, 0, 0);
            }
            Gm = __builtin_amdgcn_mfma_f32_32x32x16_bf16(fA5[sc], ub, Gm, 0, 0, 0);
#pragma unroll
            for (int t2 = 0; t2 < 2; ++t2)
#pragma unroll
                for (int g4 = 0; g4 < 4; ++g4)
#pragma unroll
                    for (int e = 0; e < 4; ++e) St[t2][4 * g4 + e] *= wl[t2][g4][e];
#pragma unroll
            for (int e = 0; e < 4; ++e) { YY[(16 * sc + 4 * hi + e) * 64 + 32 * wv + r32] = Gm[8 + e]; YY[(16 * sc + 8 + 4 * hi + e) * 64 + 32 * wv + r32] = Gm[12 + e]; }
        }
    };
    auto outst = [&](int c, const float (&gq)[4]) {
        const float* VV = (const float*)(L + SC_VV + (c % 3) * 8192); const float* BON = (const float*)(L + SC_BON + (c % 3) * 128);
        const int o = tt * 64 + c4;
        const f32x4 y4 = *(const f32x4*)(YY + o), v4 = *(const f32x4*)(VV + o);
        const float mean = red16((y4[0] + y4[1]) + (y4[2] + y4[3])) * (1.f / 64.f);
        float q = 0.f;
#pragma unroll
        for (int e = 0; e < 4; ++e) { const float d = y4[e] - mean; q += d * d; }
        const float rstd = 1.f / sqrtf(red16(q) * (1.f / 64.f) + 64e-5f);
        const float bon = BON[tt];
        const f32x4 lg = *(const f32x4*)(TAB + 384 + c4), lb = *(const f32x4*)(TAB + 448 + c4);
        float o4[4];
#pragma unroll
        for (int e = 0; e < 4; ++e) o4[e] = ((y4[e] - mean) * rstd * lg[e] + lb[e] + bon * v4[e]) * gq[e];
        u32x2 w; w.x = cvt_pk_bf16(o4[0], o4[1]); w.y = cvt_pk_bf16(o4[2], o4[3]);
        *(u32x2*)(YA + ((size_t)b * SEQ + c * 32 + tt) * 512 + ch) = w;
    };
    load_raw(0);
    prep(0);
#pragma unroll
    for (int e = 0; e < 4; ++e) gq_cur[e] = gq_next[e];
    load_raw(1);
    LBAR();
    stageB(0);
    LBAR();
    if (wv == 2 || wv == 3) stageC(0);
    LBAR();
    for (int c = 0; c < 64; ++c) {
        if (c >= 1) outst(c - 1, gq_prev);
        if (c + 1 < 64) prep(c + 1);
#pragma unroll
        for (int e = 0; e < 4; ++e) { gq_prev[e] = gq_cur[e]; gq_cur[e] = gq_next[e]; }
        if (c + 2 < 64) load_raw(c + 2);
        LBAR();
        if (c + 1 < 64) stageB(c + 1);
        LBAR();
        if (wv < 2) stageD(c);
        else if (wv < 4) { if (c + 1 < 64) stageC(c + 1); }
        LBAR();
    }
    outst(63, gq_prev);
    LBAR();
}

__device__ __forceinline__ float other_half(float x) {
    const auto rr = __builtin_amdgcn_permlane32_swap(__float_as_uint(x), __float_as_uint(x), false, false);
    const float a = __uint_as_float(rr[0]), b = __uint_as_float(rr[1]);
    return (threadIdx.x & 32) ? a : b;
}
__device__ __forceinline__ float halves_max(float x) { const auto rr = __builtin_amdgcn_permlane32_swap(__float_as_uint(x), __float_as_uint(x), false, false); return fmaxf(__uint_as_float(rr[0]), __uint_as_float(rr[1])); }
__device__ __forceinline__ float halves_sum(float x) { const auto rr = __builtin_amdgcn_permlane32_swap(__float_as_uint(x), __float_as_uint(x), false, false); return __uint_as_float(rr[0]) + __uint_as_float(rr[1]); }
typedef short v4i16_t __attribute__((ext_vector_type(4)));
__device__ __forceinline__ s16x4 lds_tr16(const void* p) { return __builtin_bit_cast(s16x4, __builtin_amdgcn_ds_read_tr16_b64_v4i16((LAS v4i16_t*)p)); }
constexpr int KS_PITCH = 72;
struct AttnLds { bf16_t* Ks; bf16_t* Vt; float* IMP; float* SC; unsigned* SEL; };

template <bool MASKED, class VF> __device__ __forceinline__ void attn_step(const AttnLds& Z, const bf16x8 (&qf)[4], f32x16 (&o)[2], float& m, float& l, VF valid, bool lanesel, int r32, int hi) {
    f32x16 s[2];
#pragma unroll
    for (int hv = 0; hv < 2; ++hv) {
        s[hv] = (f32x16){0.f,0.f,0.f,0.f,0.f,0.f,0.f,0.f,0.f,0.f,0.f,0.f,0.f,0.f,0.f,0.f};
#pragma unroll
        for (int c = 0; c < 4; ++c) { const bf16x8 kf = *(const bf16x8*)(Z.Ks + (32 * hv + r32) * KS_PITCH + 16 * c + 8 * hi); s[hv] = __builtin_amdgcn_mfma_f32_32x32x16_bf16(kf, qf[c], s[hv], 0, 0, 0); }
    }
    if (MASKED) {
#pragma unroll
        for (int hv = 0; hv < 2; ++hv)
#pragma unroll
            for (int r = 0; r < 16; ++r) { const int kvl = 32 * hv + (r & 3) + 8 * (r >> 2) + 4 * hi; s[hv][r] = valid(kvl) ? s[hv][r] : -1e30f; }
    }
    float mx0 = fmaxf(s[0][0], s[1][0]), mx1 = fmaxf(s[0][1], s[1][1]);
#pragma unroll
    for (int r = 2; r < 16; r += 2) { mx0 = fmaxf(fmaxf(mx0, s[0][r]), s[1][r]); mx1 = fmaxf(fmaxf(mx1, s[0][r + 1]), s[1][r + 1]); }
    float mx = fmaxf(mx0, mx1);
    mx = halves_max(mx);
    if (__any(mx > m + 8.f)) { const float mn = fmaxf(m, mx); const float alpha = __builtin_amdgcn_exp2f(m - mn); l *= alpha; o[0] = o[0] * alpha; o[1] = o[1] * alpha; m = mn; }
    const float nb = lanesel ? -m : -__builtin_inff();
    f32x2 ps2 = (f32x2){0.f, 0.f};
#pragma unroll
    for (int hv = 0; hv < 2; ++hv) {
#pragma unroll
        for (int r = 0; r < 16; r += 2) {
            const f32x2 d = (f32x2){s[hv][r], s[hv][r + 1]} + (f32x2){nb, nb};
            float p0 = __builtin_amdgcn_exp2f(d.x), p1 = __builtin_amdgcn_exp2f(d.y);
            if (MASKED) { p0 = s[hv][r] > -1e29f ? p0 : 0.f; p1 = s[hv][r + 1] > -1e29f ? p1 : 0.f; }
            s[hv][r] = p0; s[hv][r + 1] = p1; ps2 += (f32x2){p0, p1};
        }
#pragma unroll
        for (int cc = 0; cc < 2; ++cc) {
            const int c = 2 * hv + cc, rb = 8 * cc;
            u32x4 pw; pw.x = cvt_pk_bf16(s[hv][rb + 0], s[hv][rb + 1]); pw.y = cvt_pk_bf16(s[hv][rb + 2], s[hv][rb + 3]); pw.z = cvt_pk_bf16(s[hv][rb + 4], s[hv][rb + 5]); pw.w = cvt_pk_bf16(s[hv][rb + 6], s[hv][rb + 7]);
            const bf16x8 pb = __builtin_bit_cast(bf16x8, pw);
#pragma unroll
            for (int dh = 0; dh < 2; ++dh) {
                const unsigned char* vp = (const unsigned char*)Z.Vt + dh * 4096 + (16 * c + 4 * hi + ((r32 & 15) >> 2)) * 64 + (r32 >> 4) * 32 + (r32 & 3) * 8;
                const s16x4 lo = lds_tr16(vp), hh = lds_tr16(vp + 8 * 64);
                const bf16x8 va = (bf16x8){lo[0], lo[1], lo[2], lo[3], hh[0], hh[1], hh[2], hh[3]};
                o[dh] = __builtin_amdgcn_mfma_f32_32x32x16_bf16(va, pb, o[dh], 0, 0, 0);
            }
        }
    }
    l += ps2.x + ps2.y;
}
__device__ __forceinline__ void attn_stage(const AttnLds& Z, const u32x4 kreg, const u32x4 vreg, int tid) {
    const int row = tid >> 3, chn = tid & 7;
    *(u32x4*)(Z.Ks + row * KS_PITCH + chn * 8) = kreg;
    *(u32x4*)((unsigned char*)Z.Vt + (chn >> 2) * 4096 + row * 64 + (chn & 3) * 16) = vreg;
}

__device__ __forceinline__ void attn_unit(const Args& A, int b, int hk, int qt, unsigned char* lds) {
    int tid = threadIdx.x; asm volatile("" : "+v"(tid));
    const int lane = tid & 63, w = tid >> 6, r32 = lane & 31, hi = lane >> 5, g = w >> 1, th = w & 1;
    AttnLds Z; Z.Ks = (bf16_t*)lds; Z.Vt = (bf16_t*)(lds + 9216); Z.IMP = (float*)(lds + 35840); Z.SC = (float*)(lds + 35840 + 32768); Z.SEL = (unsigned*)(lds + 35840 + 32768 + 8192);
    auto ZBf = [&](int q) -> AttnLds { AttnLds z = Z; z.Ks = (bf16_t*)(lds + q * 17920); z.Vt = (bf16_t*)(lds + q * 17920 + 9216); return z; };
    const bf16_t* PROJ = (const bf16_t*)(A.ws + WS_PROJ);
    const bf16_t* KCB = (const bf16_t*)(A.ws + WS_KCB); const bf16_t* VCB = (const bf16_t*)(A.ws + WS_VCB);
    bf16_t* YB = (bf16_t*)(A.ws + WS_YB);
    const int tokl = 32 * th + r32, spos = 64 * qt + tokl;
    const size_t trow = (size_t)b * SEQ + spos;
    const int head = hk * 4 + g;
    bf16x8 qf[4];
#pragma unroll
    for (int c = 0; c < 4; ++c) qf[c] = *(const bf16x8*)(PROJ + trow * LDP + C_Q + head * 64 + 16 * c + 8 * hi);
    float gate[3];
#pragma unroll
    for (int e = 0; e < 3; ++e) gate[e] = sigmoidf_(bf2f(PROJ[trow * LDP + C_NG + head * 3 + e]));
    f32x16 out[2], o[2];
    const f32x16 zero16 = (f32x16){0.f,0.f,0.f,0.f,0.f,0.f,0.f,0.f,0.f,0.f,0.f,0.f,0.f,0.f,0.f,0.f};
    out[0] = zero16; out[1] = zero16;
    const int srow = tid >> 3, schn = tid & 7;
    u32x4 kreg, vreg;
    float m, l;
    auto finish = [&](float gt) {
        const float lt = halves_sum(l);
        const float sc = lt > 0.f ? gt / lt : 0.f;
        out[0] += o[0] * sc; out[1] += o[1] * sc;
    };
    const int ncmp = 4 * qt + 3 < 127 ? 4 * qt + 3 : 127;
    const int ntl = (ncmp + 63) / 64;
    const bf16_t* kcb = KCB + (size_t)((b * 2 + hk) * 128) * 64; const bf16_t* vcb = VCB + (size_t)((b * 2 + hk) * 128) * 64;
    m = -1e30f; l = 0.f; o[0] = zero16; o[1] = zero16;
    kreg = *(const u32x4*)(kcb + srow * 64 + schn * 8); vreg = *(const u32x4*)(vcb + srow * 64 + schn * 8);
    attn_stage(ZBf(0), kreg, vreg, tid); __syncthreads();
    if (ntl > 1) { kreg = *(const u32x4*)(kcb + (64 + srow) * 64 + schn * 8); vreg = *(const u32x4*)(vcb + (64 + srow) * 64 + schn * 8); }
    for (int tl = 0; tl < ntl; ++tl) {
        if (tl + 1 < ntl) attn_stage(ZBf((tl + 1) & 1), kreg, vreg, tid);
        const int cb0 = 64 * tl;
        if (tl == 0 && qt >= 17) attn_step<false>(ZBf(tl & 1), qf, o, m, l, [&](int) { return true; }, true, r32, hi);
        else attn_step<true>(ZBf(tl & 1), qf, o, m, l, [&](int kvl) { const int c = cb0 + kvl; return (16 * c + 31 <= spos) && (c < 127); }, true, r32, hi);
        __syncthreads();
    }
    finish(gate[0]);
    unsigned selm, uni;
    if (qt >= 16) {
        const float lt = l + __shfl_xor(l, 32);
        const float linv = lt > 0.f ? 1.f / lt : 0.f;
        float carry = 0.f;
        kreg = *(const u32x4*)(kcb + srow * 64 + schn * 8);
        for (int tl = 0; tl < 2; ++tl) {
            __syncthreads(); *(u32x4*)(Z.Ks + srow * KS_PITCH + schn * 8) = kreg; __syncthreads();
            if (tl == 0) kreg = *(const u32x4*)(kcb + (64 + srow) * 64 + schn * 8);
#pragma unroll
            for (int hv = 0; hv < 2; ++hv) {
                f32x16 s = zero16;
#pragma unroll
                for (int c = 0; c < 4; ++c) { const bf16x8 kf = *(const bf16x8*)(Z.Ks + (32 * hv + r32) * KS_PITCH + 16 * c + 8 * hi); s = __builtin_amdgcn_mfma_f32_32x32x16_bf16(kf, qf[c], s, 0, 0, 0); }
#pragma unroll
                for (int gq = 0; gq < 4; ++gq) {
                    float pn[4];
#pragma unroll
                    for (int e = 0; e < 4; ++e) { const int c = 64 * tl + 32 * hv + 8 * gq + 4 * hi + e; const bool ok = (16 * c + 31 <= spos) && (c < 127); pn[e] = ok ? __builtin_amdgcn_exp2f(s[4 * gq + e] - m) * linv : 0.f; }
                    const float qsum = (pn[0] + pn[1]) + (pn[2] + pn[3]);
                    const float other_last = __shfl_xor(pn[3], 32);
                    const float extra = hi ? other_last : carry;
                    carry = other_last;
                    const int j = 16 * tl + 8 * hv + 2 * gq + hi;
                    Z.IMP[(g * 64 + tokl) * 32 + j] = qsum + extra;
                }
            }
        }
        __syncthreads();
        {
            const int tok = tid >> 3, jg = tid & 7;
            float sc4[4];
#pragma unroll
            for (int e = 0; e < 4; ++e) { const int j = 4 * jg + e;
                const float imp = (Z.IMP[(0 * 64 + tok) * 32 + j] + Z.IMP[(1 * 64 + tok) * 32 + j]) + (Z.IMP[(2 * 64 + tok) * 32 + j] + Z.IMP[(3 * 64 + tok) * 32 + j]);
                const bool forced = (j == 0) || (j == qt) || (j == qt - 1);
                sc4[e] = forced ? 1e4f : (j <= qt ? imp : -1.f); }
            *(f32x4*)(Z.SC + tok * 32 + 4 * jg) = (f32x4){sc4[0], sc4[1], sc4[2], sc4[3]};
            __syncthreads();
            int rank[4] = {0, 0, 0, 0};
#pragma unroll
            for (int i4 = 0; i4 < 8; ++i4) { const f32x4 v = *(const f32x4*)(Z.SC + tok * 32 + 4 * i4);
#pragma unroll
                for (int ie = 0; ie < 4; ++ie) { const int i = 4 * i4 + ie;
#pragma unroll
                    for (int e = 0; e < 4; ++e) { const int j = 4 * jg + e; rank[e] += (v[ie] > sc4[e] || (v[ie] == sc4[e] && i < j)) ? 1 : 0; } } }
            unsigned bits = 0u;
#pragma unroll
            for (int e = 0; e < 4; ++e) { const int j = 4 * jg + e; if (rank[e] < 16 && j <= qt) bits |= 1u << j; }
            bits |= __shfl_xor(bits, 1); bits |= __shfl_xor(bits, 2); bits |= __shfl_xor(bits, 4);
            if (jg == 0) Z.SEL[tok] = bits;
        }
        __syncthreads();
        selm = Z.SEL[tokl];
        unsigned u = Z.SEL[lane];
#pragma unroll
        for (int ofs = 1; ofs < 64; ofs <<= 1) u |= __shfl_xor(u, ofs);
        uni = u;
    } else { selm = (2u << qt) - 1u; uni = selm; }
    uni = __builtin_amdgcn_readfirstlane(uni);
    {
        const bf16_t* kb = PROJ + (size_t)b * SEQ * LDP + C_KS + hk * 64; const bf16_t* vb = PROJ + (size_t)b * SEQ * LDP + C_VS + hk * 64;
        m = -1e30f; l = 0.f; o[0] = zero16; o[1] = zero16;
        unsigned rem = uni;
        auto popb = [&]() -> int { if (!rem) return -1; const int q = __builtin_ctz(rem); rem &= rem - 1u; return q; };
        int j = popb(), jn = popb();
        kreg = *(const u32x4*)(kb + (size_t)(64 * j + srow) * LDP + schn * 8); vreg = *(const u32x4*)(vb + (size_t)(64 * j + srow) * LDP + schn * 8);
        attn_stage(ZBf(0), kreg, vreg, tid); __syncthreads();
        if (jn >= 0) { kreg = *(const u32x4*)(kb + (size_t)(64 * jn + srow) * LDP + schn * 8); vreg = *(const u32x4*)(vb + (size_t)(64 * jn + srow) * LDP + schn * 8); }
        int pb = 0;
        for (;;) {
            const int jnn = (jn >= 0) ? popb() : -1;
            if (jn >= 0) attn_stage(ZBf(pb ^ 1), kreg, vreg, tid);
            if (jnn >= 0) { kreg = *(const u32x4*)(kb + (size_t)(64 * jnn + srow) * LDP + schn * 8); vreg = *(const u32x4*)(vb + (size_t)(64 * jnn + srow) * LDP + schn * 8); }
            const bool sel = (selm >> j) & 1u; const int kv0 = 64 * j;
            if (j < qt) { if (__any(sel)) attn_step<false>(ZBf(pb), qf, o, m, l, [&](int) { return true; }, sel, r32, hi); }
            else attn_step<true>(ZBf(pb), qf, o, m, l, [&](int kvl) { return kv0 + kvl <= spos; }, sel, r32, hi);
            __syncthreads();
            if (jn < 0) break;
            j = jn; jn = jnn; pb ^= 1;
        }
        finish(gate[1]);
    }
    {
        const bf16_t* kb = PROJ + (size_t)b * SEQ * LDP + C_KW + hk * 64; const bf16_t* vb = PROJ + (size_t)b * SEQ * LDP + C_VW + hk * 64;
        m = -1e30f; l = 0.f; o[0] = zero16; o[1] = zero16;
        const int j0 = qt >= 8 ? qt - 8 : 0;
        kreg = *(const u32x4*)(kb + (size_t)(64 * j0 + srow) * LDP + schn * 8); vreg = *(const u32x4*)(vb + (size_t)(64 * j0 + srow) * LDP + schn * 8);
        attn_stage(ZBf(0), kreg, vreg, tid); __syncthreads();
        if (j0 < qt) { kreg = *(const u32x4*)(kb + (size_t)(64 * (j0 + 1) + srow) * LDP + schn * 8); vreg = *(const u32x4*)(vb + (size_t)(64 * (j0 + 1) + srow) * LDP + schn * 8); }
        for (int j = j0; j <= qt; ++j) {
            const int pb = (j - j0) & 1;
            if (j < qt) attn_stage(ZBf(pb ^ 1), kreg, vreg, tid);
            if (j + 2 <= qt) { kreg = *(const u32x4*)(kb + (size_t)(64 * (j + 2) + srow) * LDP + schn * 8); vreg = *(const u32x4*)(vb + (size_t)(64 * (j + 2) + srow) * LDP + schn * 8); }
            const int kv0 = 64 * j;
            if (j == qt || (qt >= 8 && j == qt - 8)) attn_step<true>(ZBf(pb), qf, o, m, l, [&](int kvl) { const int kp = kv0 + kvl; return (kp <= spos) && (kp > spos - 512); }, true, r32, hi);
            else attn_step<false>(ZBf(pb), qf, o, m, l, [&](int) { return true; }, true, r32, hi);
            __syncthreads();
        }
        finish(gate[2]);
    }
    bf16_t* yb = YB + trow * 512 + head * 64;
#pragma unroll
    for (int dh = 0; dh < 2; ++dh)
#pragma unroll
        for (int gq = 0; gq < 4; ++gq) {
            u32x2 wv; wv.x = cvt_pk_bf16(out[dh][4 * gq + 0], out[dh][4 * gq + 1]); wv.y = cvt_pk_bf16(out[dh][4 * gq + 2], out[dh][4 * gq + 3]);
            *(u32x2*)(yb + 32 * dh + 8 * gq + 4 * hi) = wv;
        }
    __syncthreads();
}

#define XB_TMO      128
#define XB_XCNT(j)  (256  + 64 * (j))
#define XB_XSUB(j)  (1280 + 64 * (j))
#define XB_XGEN(j)  (2304 + 64 * (j))
#define XB_TOP      3328
#define XB_TOPGEN   3392
#define XCD_BAR_WORDS 3456
#define XB_SPIN_CAP (1u << 18)

__device__ __forceinline__ unsigned xb_ld(unsigned* p)              { return __hip_atomic_load(p, __ATOMIC_RELAXED, __HIP_MEMORY_SCOPE_AGENT); }
__device__ __forceinline__ unsigned xb_add(unsigned* p, unsigned v) { return __hip_atomic_fetch_add(p, v, __ATOMIC_RELAXED, __HIP_MEMORY_SCOPE_AGENT); }
__device__ __forceinline__ unsigned xb_xcc_id() { return (unsigned)__builtin_amdgcn_s_getreg((3 << 11) | 20) & 0xFu; }
#define XB_SPIN(cond, bar) do { unsigned _sp = 0; while (cond) { __builtin_amdgcn_s_sleep(1); \
    if ((++_sp & 255u) == 0u) { if (xb_ld(&(bar)[XB_TMO])) break; if (_sp > XB_SPIN_CAP) { atomicAdd(&(bar)[XB_TMO], 1u); break; } } } } while (0)

struct XcdBarrier {
    unsigned* bar; unsigned x;
    volatile LAS unsigned* st;
};

__device__ __forceinline__ XcdBarrier xcd_barrier_post(unsigned* bar, volatile LAS unsigned* st) {
    XcdBarrier b; b.bar = bar; b.x = xb_xcc_id(); b.st = st;
    if (threadIdx.x == 0) (void)xb_add(&bar[XB_XCNT(b.x)], 1u);
    return b;
}
__device__ __forceinline__ void xcd_barrier_complete(unsigned* bar, unsigned x, unsigned& nloc, unsigned& nx) {
    const unsigned G = gridDim.x * gridDim.y * gridDim.z;
    unsigned sum, cnt, mine, sp = 0u;
    for (;;) {
        sum = 0u; cnt = 0u; mine = 0u;
#pragma unroll
        for (unsigned j = 0; j < 16; ++j) { const unsigned c = xb_ld(&bar[XB_XCNT(j)]); sum += c; cnt += (c > 0u) ? 1u : 0u; mine = (j == x) ? c : mine; }
        if (sum == G) break;
        __builtin_amdgcn_s_sleep(1);
        if ((++sp & 255u) == 0u) { if (xb_ld(&bar[XB_TMO])) break; if (sp > XB_SPIN_CAP) { atomicAdd(&bar[XB_TMO], 1u); break; } }
    }
    nloc = mine > 0u ? mine : 1u; nx = cnt > 0u ? cnt : 1u;
}

__device__ __forceinline__ void xcd_barrier(const XcdBarrier& b) {
    asm volatile("s_waitcnt vmcnt(0)" ::: "memory");
    __syncthreads();
    if (threadIdx.x == 0) {
        unsigned* bar = b.bar;
        __builtin_amdgcn_s_waitcnt(0);
        unsigned nloc = b.st[0], nx = b.st[1];
        if (nloc == 0u) { xcd_barrier_complete(bar, b.x, nloc, nx); b.st[0] = nloc; b.st[1] = nx; }
        const unsigned old = xb_add(&bar[XB_XSUB(b.x)], 1u);
        const unsigned gen = old / nloc;
        if (old + 1u == (gen + 1u) * nloc) {
            __builtin_amdgcn_fence(__ATOMIC_RELEASE, "agent");
            asm volatile("s_waitcnt vmcnt(0)" ::: "memory");
            const unsigned og = xb_add(&bar[XB_TOP], 1u);
            const unsigned tg = og / nx;
            if (og + 1u == (tg + 1u) * nx) xb_add(&bar[XB_TOPGEN], 1u);
            else XB_SPIN(xb_ld(&bar[XB_TOPGEN]) == tg, bar);
            __builtin_amdgcn_fence(__ATOMIC_ACQUIRE, "agent");
            xb_add(&bar[XB_XGEN(b.x)], 1u);
            asm volatile("s_waitcnt vmcnt(0)" ::: "memory");
        } else {
            XB_SPIN(xb_ld(&bar[XB_XGEN(b.x)]) == gen, bar);
            __builtin_amdgcn_fence(__ATOMIC_ACQUIRE, "agent");
            asm volatile("s_waitcnt vmcnt(0)" ::: "memory");
        }
    }
    __syncthreads();
}

__global__ void __launch_bounds__(NTHREADS) fwd_kernel(Args A) {
    extern __shared__ __attribute__((aligned(16))) unsigned char lds[];
    cg::grid_group grid = cg::this_grid();
    const int G = gridDim.x, bid = blockIdx.x;
    const int NGW = G * NWAVES, NGT = G * NTHREADS;
    LAS unsigned char* ldsl = (LAS unsigned char*)lds;
    volatile LAS unsigned* xst = (volatile LAS unsigned*)(ldsl + LDS_BYTES - 64);
    if (threadIdx.x < 16) xst[threadIdx.x] = 0u;
    __syncthreads();
    XcdBarrier xbar = xcd_barrier_post((unsigned*)(A.ws + WS_CTL) + 1024, xst);
    grid.sync();
#define GSYNC_CG() do { __threadfence(); grid.sync(); } while (0)
#define GSYNC() xcd_barrier(xbar)

#define WSP(name, off) bf16_t* name = (bf16_t*)(wsq + (off))
#define PHASE_BEGIN() unsigned char* wsq = A.ws; asm volatile("" : "+s"(wsq)); int tid = threadIdx.x; asm volatile("" : "+v"(tid)); const int lane = tid & 63, wave = __builtin_amdgcn_readfirstlane(tid >> 6); const int gw = bid * NWAVES + wave, gtid = bid * NTHREADS + tid; (void)lane; (void)gw; (void)gtid;
#define ALLPTRS() WSP(Win_t, WS_WIN); WSP(Wg_t, WS_WG); WSP(Wup_t, WS_WUP); WSP(Wdn_t, WS_WDN); WSP(Wo_t, WS_WO); WSP(Wpg_t, WS_WPG); WSP(Woa_t, WS_WOA); WSP(Wob_t, WS_WOB); \
    WSP(Wpp_t, WS_WPP); WSP(Wl2_t, WS_WL2); WSP(Wc1k_t, WS_WC1K); WSP(Wc1v_t, WS_WC1V); float* CB = (float*)(wsq + WS_CB); WSP(KCB, WS_KCB); WSP(VCB, WS_VCB); WSP(H12K, WS_H12K); WSP(H12V, WS_H12V); \
    WSP(PB, WS_PB); WSP(PROJ, WS_PROJ); WSP(LO, WS_LO); WSP(A2, WS_A2); WSP(YA, WS_YA); WSP(YB, WS_YB); WSP(SG, WS_SG); WSP(MB, WS_M); WSP(U2, WS_U2); WSP(ACT, WS_ACT); WSP(PP, WS_PP); \
    bf16_t* U = (bf16_t*)A.out; float* H = A.out; \
    (void)Win_t; (void)Wg_t; (void)Wup_t; (void)Wdn_t; (void)Wo_t; (void)Wpg_t; (void)Woa_t; (void)Wob_t; (void)Wpp_t; (void)Wl2_t; (void)Wc1k_t; (void)Wc1v_t; (void)CB; (void)KCB; (void)VCB; (void)H12K; (void)H12V; \
    (void)PB; (void)PROJ; (void)LO; (void)A2; (void)YA; (void)YB; (void)SG; (void)MB; (void)U2; (void)ACT; (void)PP; (void)U; (void)H;
    {
        PHASE_BEGIN(); ALLPTRS();
        float* scr = (float*)(lds + wave * 16384);
        { const float* w_in = A.in[I_WIN]; const float* w1 = A.in[I_W1]; const float* a1 = A.in[I_A1]; const float* g1 = A.in[I_G1]; const float* mu = A.in[I_MUWAG];
          tr_matrix([=](int k, int n) -> float {
              if (n < C_L1) { const float v = __builtin_nontemporal_load(w_in + (size_t)k * WIN_LD + n); return (n >= C_Q && n < C_KC) ? v * QSCALE : v; }
              if (n >= LDP) return 0.f;
              const bool second = n >= C_L2; const int i = n - (second ? C_L2 : C_L1);
              float v, mm;
              if (i < 64) { v = w1[k * 64 + i]; mm = mu[k]; } else if (i < 128) { v = a1[k * 64 + i - 64]; mm = mu[1024 + k]; } else { v = g1[k * 160 + i - 128]; mm = mu[2048 + k]; }
              return second ? v * mm : v * (1.f - mm);
          }, 1024, 3424, Win_t, scr, gw, NGW, lane);
          tr_matrix([=](int k, int n) -> float { return __builtin_nontemporal_load(w_in + (size_t)k * WIN_LD + C_L1 + n); }, 1024, 2048, Wg_t, scr, gw, NGW, lane); }
        { const float* w = A.in[I_WUP]; const float* g2 = A.in[I_LN2]; tr_matrix([=](int k, int n) -> float { const int pn = n >> 8, wq = n & 255; const int src = wq < 128 ? pn * 128 + wq : DFF + pn * 128 + (wq - 128); return __builtin_nontemporal_load(w + (size_t)k * 5632 + src) * g2[k]; }, 1024, 5632, Wup_t, scr, gw, NGW, lane); }
        { const float* w = A.in[I_WDN]; tr_matrix([=](int k, int n) -> float { return __builtin_nontemporal_load(w + (size_t)k * 1024 + n); }, 2816, 1024, Wdn_t, scr, gw, NGW, lane); }
        { const float* w = A.in[I_WO]; tr_matrix([=](int k, int n) -> float { return __builtin_nontemporal_load(w + (size_t)k * 1024 + n); }, 1024, 1024, Wo_t, scr, gw, NGW, lane); }
        { const float* w = A.in[I_WPG]; const float* g3 = A.in[I_LN3]; tr_matrix([=](int k, int n) -> float { return __builtin_nontemporal_load(w + (size_t)k * 1024 + n) * g3[k]; }, 1024, 1024, Wpg_t, scr, gw, NGW, lane); }
        { const float* w = A.in[I_WOA]; tr_matrix([=](int k, int n) -> float { return __builtin_nontemporal_load(w + (size_t)k * 1024 + n); }, 512, 1024, Woa_t, scr, gw, NGW, lane); }
        { const float* w = A.in[I_WOB]; tr_matrix([=](int k, int n) -> float { return __builtin_nontemporal_load(w + (size_t)k * 1024 + n); }, 512, 1024, Wob_t, scr, gw, NGW, lane); }
        { const float* w = A.in[I_WPP]; tr_matrix([=](int k, int n) -> float { return __builtin_nontemporal_load(w + (size_t)k * 1024 + n); }, 256, 1024, Wpp_t, scr, gw, NGW, lane); }
        { const float* w2 = A.in[I_W2]; const float* a2 = A.in[I_A2]; const float* g2 = A.in[I_G2];
          tr_matrix([=](int k, int n) -> float {
              if (n < 512) return k < 64 ? w2[k * 512 + n] : 0.f;
              if (n < 1024) return (k >= 64 && k < 128) ? a2[(k - 64) * 512 + n - 512] : 0.f;
              return (k >= 128 && k < 288) ? g2[(k - 128) * 512 + n - 1024] : 0.f;
          }, 384, 1536, Wl2_t, scr, gw, NGW, lane); }
        { const float* c1 = A.in[I_CW1];
          tr_matrix([=](int k, int n) -> float { return n < 128 ? c1[(size_t)k * 128 + n] : c1[(size_t)(1024 + k) * 128 + n - 128]; }, 1024, 256, Wc1k_t, scr, gw, NGW, lane);
          tr_matrix([=](int k, int n) -> float { return n < 128 ? c1[(size_t)(2048 + k) * 128 + n] : c1[(size_t)(2048 + 1024 + k) * 128 + n - 128]; }, 1024, 256, Wc1v_t, scr, gw, NGW, lane); }
        rms_rows<true, true>((float*)A.in[I_X], A.in[I_LN1], U, gw, NGW, lane);
        { const f32x4* p4 = (const f32x4*)A.in[I_P]; u32x2* o = (u32x2*)PB;
          for (int i0 = gtid; i0 < T * PLE / 4; i0 += 8 * NGT) { f32x4 v[8];
#pragma unroll
              for (int u = 0; u < 8; ++u) { const int i = i0 + u * NGT; if (i < T * PLE / 4) v[u] = __builtin_nontemporal_load(p4 + i); }
#pragma unroll
              for (int u = 0; u < 8; ++u) { const int i = i0 + u * NGT; if (i < T * PLE / 4) { u32x2 w; w.x = cvt_pk_bf16(v[u].x, v[u].y); w.y = cvt_pk_bf16(v[u].z, v[u].w); o[i] = w; } } } }
        {
            for (int it = gw; it < 2048; it += NGW) {
                const int o = it & 255, part = it >> 8, kv = o >> 7, n = o & 127; const float* pos = A.in[I_CPOS] + kv * 2048 + part * 256; const float* c1 = A.in[I_CW1] + ((size_t)kv * 2048 + part * 256) * 128;
                float s = 0.f;
#pragma unroll
                for (int q = 0; q < 4; ++q) { const int i = lane + 64 * q; s += pos[i] * c1[(size_t)i * 128 + n]; }
                s = wave_sum(s);
                if (lane == 0) CB[part * 256 + o] = s;
            }
        }
    }
    GSYNC();
    {
        PHASE_BEGIN(); ALLPTRS();
        pg8::Gemm g = pg8::mk_gemm(U, DM, Win_t, T, 5632, DM); pg8::StaticOrder S; S.init(T, 5632, G, bid);
        pg8::EpiProj E{PROJ, (unsigned char*)A.out + 64 * MiB};
        pg8::gemm_phase<pg8::EpiProj, true>(ldsl, g, S, E);
    }
    GSYNC();
    {
        PHASE_BEGIN(); ALLPTRS();
        {
            const int gt2 = gtid, NG2 = NGT;
            for (int i0 = gt2; i0 < T * 48; i0 += 4 * NG2) {
                u32x4 la[4], lb[4];
#pragma unroll
                for (int u = 0; u < 4; ++u) { const int i = i0 + u * NG2; la[u] = (u32x4){0u, 0u, 0u, 0u}; lb[u] = la[u];
                    if (i < T * 48) { const int t = i / 48, cg8 = (i % 48) * 8;
                        if (cg8 < 288) { la[u] = *(const u32x4*)(PROJ + (size_t)t * LDP + C_L1 + cg8); if ((t & (SEQ - 1)) != 0) lb[u] = *(const u32x4*)(PROJ + (size_t)(t - 1) * LDP + C_L2 + cg8); } } }
#pragma unroll
                for (int u = 0; u < 4; ++u) { const int i = i0 + u * NG2;
                    if (i < T * 48) { const int t = i / 48, cg8 = (i % 48) * 8;
                        u32x4 w = (u32x4){0u, 0u, 0u, 0u};
                        if (cg8 < 288) {
                            float a[8], bq[8]; unpack8(la[u], a); unpack8(lb[u], bq);
#pragma unroll
                            for (int e = 0; e < 8; ++e) a[e] += bq[e];
                            if (cg8 < 64) {
#pragma unroll
                                for (int e = 0; e < 8; ++e) a[e] = tanhf_(a[e]);
                            } else if (cg8 >= 128) {
#pragma unroll
                                for (int e = 0; e < 8; ++e) a[e] = sigmoidf_(a[e]);
                            }
                            w.x = cvt_pk_bf16(a[0], a[1]); w.y = cvt_pk_bf16(a[2], a[3]); w.z = cvt_pk_bf16(a[4], a[5]); w.w = cvt_pk_bf16(a[6], a[7]);
                        }
                        *(u32x4*)(A2 + (size_t)t * 384 + cg8) = w; } }
            }
        }
        __syncthreads();
        if (bid < 128) {
            const int isv = bid >> 6, sq = (bid >> 4) & 3;
            pg8::Gemm g; g.M = 4096; g.N = 256; g.K = 256; g.ldb = 1024; g.a_row = 16u * LDP * 2u; g.a_kstep = (size_t)LDP * 2; g.a_hstep = 128; g.a_tstep = (size_t)SEQ * LDP * 2;
            pg8::StaticOrder S; S.init(4096, 256, 16, bid & 15);
            g.A = PROJ + (isv ? C_VC : C_KC) + (size_t)(4 * sq) * LDP; g.Bt = (isv ? Wc1v_t : Wc1k_t) + 256 * sq;
            bf16_t* hdst = (bf16_t*)(wsq + WS_H12P) + (size_t)(isv * 4 + sq) * 4096 * 256;
            pg8::EpiB<0> E{hdst, 256, 256, nullptr, nullptr, nullptr, 0, nullptr}; pg8::gemm_phase<pg8::EpiB<0>, true>(ldsl, g, S, E);
        }
    }
    GSYNC();
    {
        PHASE_BEGIN(); ALLPTRS();
        {
            pg8::Gemm g = pg8::mk_gemm(A2, 384, Wl2_t, T, 1536, 384); pg8::StaticOrder S; S.init(T, 1536, G, bid);
            pg8::EpiB<2> E{LO, 1536, 1536, A.in[I_W0], A.in[I_A0], nullptr, 0, nullptr};
            pg8::gemm_phase<pg8::EpiB<2>, true>(ldsl, g, S, E);
        }
        const float* cw2 = A.in[I_CW2];
        for (int it = gw; it < 2 * 32 * 128; it += NGW) {
            const int kv = it >> 12, rowi = it & 4095, c = rowi & 127;
            bf16_t* dst = (kv ? VCB : KCB) + (size_t)rowi * 64;
            if (c == 127) { dst[lane] = 0; continue; }
            const bf16_t* Hm = (const bf16_t*)(wsq + WS_H12P) + (size_t)(kv * 4) * 4096 * 256;
            float cb0 = 0.f, cb1 = 0.f;
#pragma unroll
            for (int part = 0; part < 8; ++part) { cb0 += CB[part * 256 + kv * 128 + lane]; cb1 += CB[part * 256 + kv * 128 + 64 + lane]; }
            float h0 = cb0, h1 = cb1;
#pragma unroll
            for (int sq = 0; sq < 4; ++sq) { const bf16_t* Hs = Hm + (size_t)sq * 4096 * 256;
                h0 += bf2f(Hs[(size_t)rowi * 256 + lane]) + bf2f(Hs[(size_t)(rowi + 1) * 256 + 128 + lane]);
                h1 += bf2f(Hs[(size_t)rowi * 256 + 64 + lane]) + bf2f(Hs[(size_t)(rowi + 1) * 256 + 192 + lane]); }
            h0 = h0 * sigmoidf_(h0); h1 = h1 * sigmoidf_(h1);
            const float* w2 = cw2 + kv * 128 * 64;
            float acc = 0.f;
#pragma unroll 16
            for (int i = 0; i < 64; ++i) acc += __shfl(h0, i) * w2[i * 64 + lane];
#pragma unroll 16
            for (int i = 0; i < 64; ++i) acc += __shfl(h1, i) * w2[(64 + i) * 64 + lane];
            dst[lane] = (bf16_t)(cvt_pk_bf16(acc, 0.f) & 0xffffu);
        }
    }
    GSYNC();
    {
        PHASE_BEGIN(); ALLPTRS();
        if (bid < 128) scan_unit(A, bid, lds);
        unsigned* qheads = (unsigned*)(wsq + WS_CTL) + 6144;
        unsigned* slot = (unsigned*)(lds + 35840 + 32768 + 8192 + 512);
        const int myx = (int)(xb_xcc_id() & 7u);
        for (int qq = 0; qq < 8; ++qq) {
            const int q = (myx + qq) & 7;
            for (;;) {
                __syncthreads();
                if (tid == 0) *slot = atomicAdd(qheads + 64 * q, 1u);
                __syncthreads();
                const unsigned v = *slot;
                if (v >= 128u) break;
                const int qt = 31 - (int)(v >> 2), bh = 4 * q + (int)(v & 3);
                attn_unit(A, bh >> 1, bh & 1, qt, lds);
            }
        }
    }
    GSYNC();
    {
        PHASE_BEGIN(); ALLPTRS();
        pg8::StaticOrder S; S.init(T, 1024, G, bid);
        { pg8::Gemm g = pg8::mk_gemm(YA, 512, Woa_t, T, 1024, 512); pg8::EpiB<3> E{MB, 1024, 1024, nullptr, nullptr, (const bf16_t*)((const unsigned char*)A.out + 64 * MiB), 2048, nullptr}; pg8::gemm_phase<pg8::EpiB<3>, true>(ldsl, g, S, E); }
        asm volatile("s_waitcnt vmcnt(0)" ::: "memory"); __syncthreads();
        { pg8::Gemm g = pg8::mk_gemm(YB, 512, Wob_t, T, 1024, 512); pg8::EpiB<3> E{MB, 1024, 1024, nullptr, nullptr, (const bf16_t*)((const unsigned char*)A.out + 64 * MiB + 1024), 2048, MB}; pg8::gemm_phase<pg8::EpiB<3>, true>(ldsl, g, S, E); }
    }
    GSYNC();
    {
        PHASE_BEGIN(); ALLPTRS();
        pg8::Gemm g = pg8::mk_gemm(MB, 1024, Wo_t, T, 1024, 1024); pg8::StaticOrder S; S.init(T, 1024, G, bid);
        pg8::EpiFN<false> E{A.in[I_X], U2, 1024, (float*)(wsq + WS_PART)};
        pg8::gemm_phase<pg8::EpiFN<false>, true>(ldsl, g, S, E);
        {
            pg8::Gemm g2 = pg8::mk_gemm(PB, 256, Wpp_t, T, 1024, 256); pg8::StaticOrder S2; S2.init(T, 1024, G, bid);
            pg8::EpiB<0> E2{PP, 1024, 1024, nullptr, nullptr, nullptr, 0, nullptr};
            pg8::gemm_phase<pg8::EpiB<0>, true>(ldsl, g2, S2, E2);
        }
    }
    GSYNC();
    {
        PHASE_BEGIN(); ALLPTRS();
        pg8::Gemm g = pg8::mk_gemm(U2, DM, Wup_t, T, 5632, DM); pg8::StaticOrder S; S.init(T, 5632, G, bid);
        {
            const float* part = (const float*)(wsq + WS_PART); float* RS = (float*)(wsq + WS_RS); pg8::Unit uu; int lastpm = -1;
            for (int ui = 0; S.next(ui, uu); ++ui) { if (uu.pm == lastpm) continue; lastpm = uu.pm;
                if (tid < 256) { const int r = uu.pm * 256 + tid; float sum = 0.f;
#pragma unroll
                    for (int q = 0; q < 16; ++q) sum += part[(size_t)q * T + r];
                    RS[r] = 1.f / sqrtf(sum * (1.f / 1024.f) + 1e-6f); } }
            asm volatile("s_waitcnt vmcnt(0)" ::: "memory"); __syncthreads();
        }
        pg8::EpiGlu E{ACT, A.in[I_CONVW], A.in[I_CONVB], (float*)(wsq + WS_GH), (LAS float*)(ldsl + 131072), (const float*)(wsq + WS_RS)};
        pg8::gemm_phase<pg8::EpiGlu, true, true>(ldsl, g, S, E);
    }
    GSYNC();
    {
        PHASE_BEGIN(); ALLPTRS();
        pg8::Gemm g = pg8::mk_gemm(ACT, DFF, Wdn_t, T, 1024, DFF); pg8::StaticOrder S; S.init(T, 1024, G, bid);
        {
            const float* cw = A.in[I_CONVW]; const float* cb = A.in[I_CONVB]; const float* GH = (const float*)(wsq + WS_GH);
            pg8::Unit uu;
            for (int ui = 0; S.next(ui, uu); ++ui) {
                const int pm = uu.pm; if ((pm & 7) == 0) continue;
                for (int idx = tid; idx < 2 * DFF; idx += NTHREADS) {
                    const int row = idx / DFF, col = idx - row * DFF;
                    float xa[4], xb[4];
#pragma unroll
                    for (int q = 0; q < 4; ++q) { const int tp = q < 2 ? pm - 1 : pm, rr = q < 2 ? 2 + q : q - 2; xa[q] = GH[((size_t)(tp * 4 + rr) * 2 + 0) * DFF + col]; xb[q] = GH[((size_t)(tp * 4 + rr) * 2 + 1) * DFF + col]; }
                    const float a0 = row ? xa[1] : xa[0], a1 = row ? xa[2] : xa[1], a2 = row ? xa[3] : xa[2], b0 = row ? xb[1] : xb[0], b1 = row ? xb[2] : xb[1], b2 = row ? xb[3] : xb[2];
                    const float ha = cb[col] + cw[col] * a0 + cw[5632 + col] * a1 + cw[2 * 5632 + col] * a2;
                    const float hb = cb[DFF + col] + cw[DFF + col] * b0 + cw[5632 + DFF + col] * b1 + cw[2 * 5632 + DFF + col] * b2;
                    ACT[((size_t)pm * 256 + row) * DFF + col] = (bf16_t)(cvt_pk_bf16(ha * sigmoidf_(ha) * hb, 0.f) & 0xffffu);
                }
            }
            asm volatile("s_waitcnt vmcnt(0)" ::: "memory"); __syncthreads();
        }
        pg8::EpiFN<true> E{U2, U2, 1024, (float*)(wsq + WS_PART)};
        pg8::gemm_phase<pg8::EpiFN<true>, true>(ldsl, g, S, E);
    }
    GSYNC();
    {
        PHASE_BEGIN(); ALLPTRS();
        pg8::Gemm g = pg8::mk_gemm(U2, DM, Wpg_t, T, 1024, DM); pg8::StaticOrder S; S.init(T, 1024, G, bid);
        {
            const float* part = (const float*)(wsq + WS_PART); float* RS = (float*)(wsq + WS_RS); pg8::Unit uu; int lastpm = -1;
            for (int ui = 0; S.next(ui, uu); ++ui) { if (uu.pm == lastpm) continue; lastpm = uu.pm;
                if (tid < 256) { const int r = uu.pm * 256 + tid; float sum = 0.f;
#pragma unroll
                    for (int q = 0; q < 16; ++q) sum += part[(size_t)q * T + r];
                    RS[r] = 1.f / sqrtf(sum * (1.f / 1024.f) + 1e-6f); } }
            asm volatile("s_waitcnt vmcnt(0)" ::: "memory"); __syncthreads();
        }
        pg8::EpiFinal E{U2, H, 1024, PP, (const float*)(wsq + WS_RS), A.in[I_LNF], (float*)(wsq + WS_PART + 2 * MiB), (unsigned*)(wsq + WS_CTL + 32768), (LAS float*)(ldsl + 131072)};
        pg8::gemm_phase<pg8::EpiFinal, true>(ldsl, g, S, E);
    }
}

extern "C" void kernel_launch(void* const* d_in, const int* in_sizes, int n_in, void* d_out, int out_size, void* d_ws, size_t ws_size, hipStream_t stream) {
    static int grid = 0;
    if (grid == 0) {
        if (n_in != 34 || ws_size < WS_END) { fprintf(stderr, "kernel_launch: unexpected n_in %d / ws_size %zu\n", n_in, ws_size); grid = -1; return; }
        int dev = 0, cus = 0, per_cu = 0;
        hipGetDevice(&dev); hipDeviceGetAttribute(&cus, hipDeviceAttributeMultiprocessorCount, dev);
        hipFuncSetAttribute((const void*)fwd_kernel, hipFuncAttributeMaxDynamicSharedMemorySize, LDS_BYTES);
        hipOccupancyMaxActiveBlocksPerMultiprocessor(&per_cu, (const void*)fwd_kernel, NTHREADS, LDS_BYTES);
        if (per_cu < 1) { fprintf(stderr, "kernel_launch: occupancy query says %d\n", per_cu); per_cu = 1; }
        (void)hipGetLastError();
        grid = cus * 1;
        if (grid > 256) grid = 256;
    }
    if (grid < 0) return;
    hipMemsetAsync((char*)d_ws + WS_CTL, 0, 65536, stream);
    Args a{};
    for (int i = 0; i < 34; ++i) a.in[i] = (const float*)d_in[i];
    a.out = (float*)d_out; a.ws = (unsigned char*)d_ws;
    void* args[] = {&a};
    hipError_t e = hipLaunchCooperativeKernel((const void*)fwd_kernel, dim3(grid), dim3(NTHREADS), args, LDS_BYTES, stream);
    if (e != hipSuccess) fprintf(stderr, "cooperative launch failed: %s (grid %d)\n", hipGetErrorString(e), grid);
}
```

```cpp
#include <hip/hip_runtime.h>
#include <hip/hip_cooperative_groups.h>
#include <cstdio>
#include <cstdint>
namespace cg = cooperative_groups;

#define LAS __attribute__((address_space(3)))
typedef unsigned short bf16_t;
typedef short bf16x8 __attribute__((ext_vector_type(8)));
typedef short s16x4 __attribute__((ext_vector_type(4)));
typedef float f32x4 __attribute__((ext_vector_type(4)));
typedef float f32x2 __attribute__((ext_vector_type(2)));
typedef float f32x16 __attribute__((ext_vector_type(16)));
typedef unsigned u32x4 __attribute__((ext_vector_type(4)));
typedef unsigned u32x2 __attribute__((ext_vector_type(2)));

constexpr int T = 32768, SEQ = 2048, NBATCH = 16, DM = 1024, DFF = 2816, PLE = 256;
constexpr int LDP = 3416;
constexpr int C_R = 0, C_K = 512, C_V = 1024, C_Q = 1536, C_KC = 2048, C_VC = 2176, C_KS = 2304, C_VS = 2432, C_KW = 2560, C_VW = 2688, C_NG = 2816, C_L1 = 2840, C_L2 = 3128;
constexpr int WIN_LD = 4888;
constexpr float QSCALE = 0.125f * 1.4426950408889634f;
constexpr int NTHREADS = 512, NWAVES = 8;
constexpr int LDS_BYTES = 160768;

constexpr size_t MiB = 1u << 20, KiB = 1u << 10;
constexpr size_t WS_CTL = 0;
constexpr size_t WS_WIN = 1 * MiB, WS_WG = 8 * MiB, WS_WUP = 12 * MiB, WS_WDN = 23 * MiB, WS_WO = 29 * MiB, WS_WPG = 31 * MiB, WS_WOA = 33 * MiB, WS_WOB = 34 * MiB;
constexpr size_t WS_WPP = 35 * MiB, WS_WL2 = 35 * MiB + 512 * KiB, WS_WC1K = 36 * MiB + 768 * KiB, WS_WC1V = 37 * MiB + 256 * KiB, WS_CB = 37 * MiB + 768 * KiB;
constexpr size_t WS_KCB = 38 * MiB, WS_VCB = 38 * MiB + 512 * KiB, WS_H12K = 39 * MiB, WS_H12V = 41 * MiB, WS_PB = 43 * MiB;
constexpr size_t WS_PROJ = 59 * MiB, WS_LO = 273 * MiB, WS_A2 = 369 * MiB, WS_YA = 393 * MiB, WS_YB = 425 * MiB;
constexpr size_t WS_SG = 59 * MiB, WS_M = 187 * MiB, WS_U2 = 251 * MiB, WS_ACT = 59 * MiB, WS_PP = 315 * MiB, WS_H12P = 457 * MiB, WS_GH = 393 * MiB, WS_PART = 425 * MiB, WS_RS = 428 * MiB;
constexpr size_t WS_END = 491 * MiB;

__device__ __forceinline__ float bf2f(unsigned v) { return __uint_as_float(v << 16); }
typedef __bf16 bf16x2_t __attribute__((ext_vector_type(2)));
__device__ __forceinline__ unsigned cvt_pk_bf16(float lo, float hi) { const f32x2 v = {lo, hi}; const bf16x2_t b = __builtin_convertvector(v, bf16x2_t); return __builtin_bit_cast(unsigned, b); }
__device__ __forceinline__ float sigmoidf_(float x) { return __builtin_amdgcn_rcpf(1.f + __expf(-x)); }
__device__ __forceinline__ float tanhf_(float x) { return 1.f - 2.f * __builtin_amdgcn_rcpf(__expf(2.f * x) + 1.f); }
__device__ __forceinline__ void unpack8(const u32x4 w, float* f) {
    f[0] = bf2f(w.x & 0xffffu); f[1] = __uint_as_float(w.x & 0xffff0000u); f[2] = bf2f(w.y & 0xffffu); f[3] = __uint_as_float(w.y & 0xffff0000u);
    f[4] = bf2f(w.z & 0xffffu); f[5] = __uint_as_float(w.z & 0xffff0000u); f[6] = bf2f(w.w & 0xffffu); f[7] = __uint_as_float(w.w & 0xffff0000u);
}
__device__ __forceinline__ void unpack4(const u32x2 w, float* f) {
    f[0] = bf2f(w.x & 0xffffu); f[1] = __uint_as_float(w.x & 0xffff0000u); f[2] = bf2f(w.y & 0xffffu); f[3] = __uint_as_float(w.y & 0xffff0000u);
}
template <int CTRL> __device__ __forceinline__ float dpp_f(float x) { return __builtin_bit_cast(float, __builtin_amdgcn_update_dpp(0, __builtin_bit_cast(int, x), CTRL, 0xf, 0xf, true)); }
__device__ __forceinline__ float red8(float x) { x += dpp_f<0xB1>(x); x += dpp_f<0x4E>(x); x += dpp_f<0x141>(x); return x; }
__device__ __forceinline__ float red16(float x) { x = red8(x); x += dpp_f<0x140>(x); return x; }
__device__ __forceinline__ float wave_sum(float v) {
#pragma unroll
    for (int o = 1; o < 64; o <<= 1) v += __shfl_xor(v, o);
    return v;
}

namespace pg8 {
constexpr int BM = 256, BK = 64, HALF = 128, HTB = HALF * BK * 2, STAGE_BYTES = 8 * HTB, NXCD = 8, WGM = 4;
__host__ __device__ __forceinline__ int lds_byte(int r, int c) { const int st = (r >> 4) * 2 + (c >> 5), rr = r & 15, cc = c & 31, ob = rr * 64 + cc * 2; return st * 1024 + (ob ^ (((ob >> 9) & 1) << 5)); }
__host__ __device__ __forceinline__ void stage_rc(int b, int& R, int& C) { const int st = b / 1024, sb = b % 1024, swz = sb ^ (((sb >> 9) & 1) << 5); R = (st >> 1) * 16 + swz / 64; C = (st & 1) * 32 + (swz % 64) / 2; }
__host__ __device__ __forceinline__ int perm32(int rho) { const int n = rho >> 4, i = rho & 15; return 8 * (i >> 2) + 4 * n + (i & 3); }
struct Unit { int pm, pn; };
struct Gemm { const bf16_t* A; const bf16_t* Bt; int M, N, K; unsigned a_row; size_t a_kstep, a_hstep, a_tstep; int ldb; };
__device__ __forceinline__ Gemm mk_gemm(const bf16_t* A, int lda, const bf16_t* Bt, int M, int N, int K) {
    Gemm g; g.A = A; g.Bt = Bt; g.M = M; g.N = N; g.K = K; g.a_row = (unsigned)lda * 2u; g.a_kstep = 128; g.a_hstep = (size_t)HALF * lda * 2; g.a_tstep = 2 * g.a_hstep; g.ldb = K; return g;
}
struct StaticOrder {
    int nM, nN, nwg, G, c;
    __device__ __forceinline__ void init(int M, int N, int G_, int c_) { nM = M / BM; nN = N / BM; nwg = nM * nN; G = G_; c = c_; }
    __device__ __forceinline__ bool next(int i, Unit& u) const {
        const long L = (long)i * G + c; if (L >= nwg) return false;
        int wgid = (int)L; { const int q = nwg / NXCD, r = nwg % NXCD, xcd = wgid % NXCD, off = wgid / NXCD; wgid = (xcd < r ? xcd * (q + 1) : r * (q + 1) + (xcd - r) * q) + off; }
        const int nig = WGM * nN, gid = wgid / nig, fm = gid * WGM, gsz = (nM - fm) < WGM ? (nM - fm) : WGM;
        u.pm = fm + ((wgid % nig) % gsz); u.pn = (wgid % nig) / gsz; return true;
    }
};

template <int MODE> struct EpiB {
    static constexpr bool PERM = true;
    bf16_t* O; int ldc; int ncols; const float* bias; const float* bias2; const bf16_t* mul; int ldm; const bf16_t* add;
    __device__ __forceinline__ void operator()(const f32x4 (&acc)[2][2][4][2], const Unit& u, int wr, int wc, int fr, int fq) const {
        const int row0 = u.pm * BM + wr * 64 + fr, col0 = u.pn * BM + wc * 32 + 8 * fq;
#pragma unroll
        for (int ai = 0; ai < 2; ++ai)
#pragma unroll
            for (int m = 0; m < 4; ++m) {
                const size_t row = (size_t)(row0 + ai * HALF + m * 16);
#pragma unroll
                for (int bj = 0; bj < 2; ++bj) {
                    const int col = col0 + bj * HALF;
                    if (col < ncols) {
                        f32x4 v0 = acc[ai][bj][m][0], v1 = acc[ai][bj][m][1];
                        if (MODE == 1) {
                            unsigned q[8];
#pragma unroll
                            for (int e = 0; e < 4; ++e) { q[e] = (unsigned)(sigmoidf_(v0[e]) * 255.f + 0.5f); q[4 + e] = (unsigned)(sigmoidf_(v1[e]) * 255.f + 0.5f); }
                            u32x2 wq; wq.x = q[0] | (q[1] << 8) | (q[2] << 16) | (q[3] << 24); wq.y = q[4] | (q[5] << 8) | (q[6] << 16) | (q[7] << 24);
                            *(u32x2*)((unsigned char*)O + row * ldc + col) = wq;
                            continue;
                        }
                        if (MODE == 2) {
                            if (col < 1024) {
                                const float* bp = col < 512 ? bias + col : bias2 + (col - 512); const f32x4 b0 = *(const f32x4*)bp, b1 = *(const f32x4*)(bp + 4);
                                const float sc = col < 512 ? 0.6065306597f : 1.f;
#pragma unroll
                                for (int e = 0; e < 4; ++e) { v0[e] = sigmoidf_(v0[e] + b0[e]) * sc; v1[e] = sigmoidf_(v1[e] + b1[e]) * sc; }
                            }
                        }
                        if (MODE == 3) {
                            float mf[8]; { const u32x2 mq = *(const u32x2*)((const unsigned char*)mul + row * ldm + col);
#pragma unroll
                                for (int e = 0; e < 4; ++e) { mf[e] = (float)((mq.x >> (8 * e)) & 0xffu) * (1.f / 255.f); mf[4 + e] = (float)((mq.y >> (8 * e)) & 0xffu) * (1.f / 255.f); } }
#pragma unroll
                            for (int e = 0; e < 4; ++e) { v0[e] *= mf[e]; v1[e] *= mf[4 + e]; }
                            if (add) { float af[8]; unpack8(*(const u32x4*)(add + row * ldc + col), af);
#pragma unroll
                                for (int e = 0; e < 4; ++e) { v0[e] += af[e]; v1[e] += af[4 + e]; } }
                        }
                        u32x4 w; w.x = cvt_pk_bf16(v0[0], v0[1]); w.y = cvt_pk_bf16(v0[2], v0[3]); w.z = cvt_pk_bf16(v1[0], v1[1]); w.w = cvt_pk_bf16(v1[2], v1[3]);
                        *(u32x4*)(O + row * ldc + col) = w;
                    }
                }
            }
    }
};
struct EpiProj {
    static constexpr bool PERM = true;
    bf16_t* P; unsigned char* SG8;
    __device__ __forceinline__ void operator()(const f32x4 (&acc)[2][2][4][2], const Unit& u, int wr, int wc, int fr, int fq) const {
        const int row0 = u.pm * BM + wr * 64 + fr, col0 = u.pn * BM + wc * 32 + 8 * fq;
        const bool gates = u.pn >= 14;
#pragma unroll
        for (int ai = 0; ai < 2; ++ai)
#pragma unroll
            for (int m = 0; m < 4; ++m) {
                const size_t row = (size_t)(row0 + ai * HALF + m * 16);
#pragma unroll
                for (int bj = 0; bj < 2; ++bj) {
                    const int col = col0 + bj * HALF;
                    const f32x4 v0 = acc[ai][bj][m][0], v1 = acc[ai][bj][m][1];
                    if (gates) {
                        unsigned q[8];
#pragma unroll
                        for (int e = 0; e < 4; ++e) { q[e] = (unsigned)(sigmoidf_(v0[e]) * 255.f + 0.5f); q[4 + e] = (unsigned)(sigmoidf_(v1[e]) * 255.f + 0.5f); }
                        u32x2 wq; wq.x = q[0] | (q[1] << 8) | (q[2] << 16) | (q[3] << 24); wq.y = q[4] | (q[5] << 8) | (q[6] << 16) | (q[7] << 24);
                        *(u32x2*)(SG8 + row * 2048 + (col - 3584)) = wq;
                    } else if (col < LDP) {
                        u32x4 w; w.x = cvt_pk_bf16(v0[0], v0[1]); w.y = cvt_pk_bf16(v0[2], v0[3]); w.z = cvt_pk_bf16(v1[0], v1[1]); w.w = cvt_pk_bf16(v1[2], v1[3]);
                        *(u32x4*)(P + row * LDP + col) = w;
                    }
                }
            }
    }
};
template <int MODE> struct EpiF {
    static constexpr bool PERM = true;
    const float* base; float* out; int ldc; const bf16_t* pp; const float* rs;
    __device__ __forceinline__ void operator()(const f32x4 (&acc)[2][2][4][2], const Unit& u, int wr, int wc, int fr, int fq) const {
        const int row0 = u.pm * BM + wr * 64 + fr, col0 = u.pn * BM + wc * 32 + 8 * fq;
#pragma unroll
        for (int ai = 0; ai < 2; ++ai)
#pragma unroll
            for (int m = 0; m < 4; ++m) {
                const size_t row = (size_t)(row0 + ai * HALF + m * 16);
#pragma unroll
                for (int bj = 0; bj < 2; ++bj) {
                    const size_t off = row * ldc + col0 + bj * HALF;
                    f32x4 v0 = acc[ai][bj][m][0], v1 = acc[ai][bj][m][1];
                    if (MODE == 1) {
                        float pf[8]; unpack8(*(const u32x4*)(pp + off), pf); const float rr = rs[row];
#pragma unroll
                        for (int e = 0; e < 4; ++e) { v0[e] = sigmoidf_(v0[e] * rr) * pf[e]; v1[e] = sigmoidf_(v1[e] * rr) * pf[4 + e]; }
                    }
                    const f32x4 b0 = *(const f32x4*)(base + off), b1 = *(const f32x4*)(base + off + 4);
                    *(f32x4*)(out + off) = b0 + v0; *(f32x4*)(out + off + 4) = b1 + v1;
                }
                asm volatile("" ::: "memory");
            }
    }
};

template <bool BASEBF> struct EpiFN {
    static constexpr bool PERM = true;
    const void* base; bf16_t* hb; int ldc; float* part;
    __device__ __forceinline__ void operator()(const f32x4 (&acc)[2][2][4][2], const Unit& u, int wr, int wc, int fr, int fq) const {
        const int row0 = u.pm * BM + wr * 64 + fr, col0 = u.pn * BM + wc * 32 + 8 * fq;
        f32x4 bv[4][2][2]; u32x4 bw[4][2];
        auto fetch = [&](int gi) { const size_t row = (size_t)(row0 + (gi >> 2) * HALF + (gi & 3) * 16);
#pragma unroll
            for (int bj = 0; bj < 2; ++bj) { const size_t off = row * ldc + col0 + bj * HALF;
                if (BASEBF) bw[gi & 3][bj] = *(const u32x4*)((const bf16_t*)base + off);
                else { bv[gi & 3][bj][0] = *(const f32x4*)((const float*)base + off); bv[gi & 3][bj][1] = *(const f32x4*)((const float*)base + off + 4); } } };
        fetch(0); fetch(1); fetch(2);
#pragma unroll
        for (int gi = 0; gi < 8; ++gi) {
            const int ai = gi >> 2, m = gi & 3;
            if (gi + 3 < 8) fetch(gi + 3);
            const size_t row = (size_t)(row0 + ai * HALF + m * 16);
            float ss = 0.f;
#pragma unroll
            for (int bj = 0; bj < 2; ++bj) {
                const size_t off = row * ldc + col0 + bj * HALF;
                f32x4 o0, o1;
                if (BASEBF) { float bf[8]; unpack8(bw[gi & 3][bj], bf); o0 = (f32x4){bf[0], bf[1], bf[2], bf[3]} + acc[ai][bj][m][0]; o1 = (f32x4){bf[4], bf[5], bf[6], bf[7]} + acc[ai][bj][m][1]; }
                else { o0 = bv[gi & 3][bj][0] + acc[ai][bj][m][0]; o1 = bv[gi & 3][bj][1] + acc[ai][bj][m][1]; }
                ss += (o0[0] * o0[0] + o0[1] * o0[1]) + (o0[2] * o0[2] + o0[3] * o0[3]) + (o1[0] * o1[0] + o1[1] * o1[1]) + (o1[2] * o1[2] + o1[3] * o1[3]);
                u32x4 w; w.x = cvt_pk_bf16(o0[0], o0[1]); w.y = cvt_pk_bf16(o0[2], o0[3]); w.z = cvt_pk_bf16(o1[0], o1[1]); w.w = cvt_pk_bf16(o1[2], o1[3]);
                *(u32x4*)(hb + off) = w;
            }
            ss += __shfl_xor(ss, 16); ss += __shfl_xor(ss, 32);
            if (fq == 0) part[(size_t)(u.pn * 4 + wc) * T + row] = ss;
        }
    }
};
struct EpiFinal {
    static constexpr bool PERM = true;
    const bf16_t* base; float* out; int ldc; const bf16_t* pp; const float* rs; const float* gf; float* xch; unsigned* cnt; LAS float* lds;
    __device__ __forceinline__ void operator()(f32x4 (&acc)[2][2][4][2], const Unit& u, int wr, int wc, int fr, int fq) const {
        const int row0 = u.pm * BM + wr * 64 + fr, col0 = u.pn * BM + wc * 32 + 8 * fq;
        const int tid = threadIdx.x;
        LAS float* P = lds;
        LAS float* S = lds + 1024;
        u32x4 bv[2][2]; u32x4 pv[2][2]; float rrv[2];
        auto fetch = [&](int gi) { const int rl = (gi >> 2) * HALF + wr * 64 + (gi & 3) * 16 + fr; const size_t row = (size_t)u.pm * BM + rl; rrv[gi & 1] = rs[row];
#pragma unroll
            for (int bj = 0; bj < 2; ++bj) { const size_t off = row * ldc + col0 + bj * HALF; bv[gi & 1][bj] = *(const u32x4*)(base + off); pv[gi & 1][bj] = *(const u32x4*)(pp + off); } };
        fetch(0);
#pragma unroll
        for (int gi = 0; gi < 8; ++gi) {
            const int ai = gi >> 2, m = gi & 3;
            if (gi + 1 < 8) fetch(gi + 1);
            const int rl = ai * HALF + wr * 64 + m * 16 + fr;
            const float rr = rrv[gi & 1];
            float ss = 0.f;
#pragma unroll
            for (int bj = 0; bj < 2; ++bj) {
                float pf[8]; unpack8(pv[gi & 1][bj], pf);
                float bfv[8]; unpack8(bv[gi & 1][bj], bfv); const f32x4 b0 = (f32x4){bfv[0], bfv[1], bfv[2], bfv[3]}, b1 = (f32x4){bfv[4], bfv[5], bfv[6], bfv[7]};
                f32x4 v0 = acc[ai][bj][m][0], v1 = acc[ai][bj][m][1];
#pragma unroll
                for (int e = 0; e < 4; ++e) { v0[e] = b0[e] + sigmoidf_(v0[e] * rr) * pf[e]; v1[e] = b1[e] + sigmoidf_(v1[e] * rr) * pf[4 + e]; }
                acc[ai][bj][m][0] = v0; acc[ai][bj][m][1] = v1;
                ss += (v0[0] * v0[0] + v0[1] * v0[1]) + (v0[2] * v0[2] + v0[3] * v0[3]) + (v1[0] * v1[0] + v1[1] * v1[1]) + (v1[2] * v1[2] + v1[3] * v1[3]);
            }
            ss += __shfl_xor(ss, 16); ss += __shfl_xor(ss, 32);
            if (fq == 0) P[rl * 4 + wc] = ss;
        }
        (void)row0;
        asm volatile("s_waitcnt lgkmcnt(0)" ::: "memory"); __builtin_amdgcn_s_barrier(); asm volatile("" ::: "memory");
        if (tid < 256) { const float sp = (P[tid * 4] + P[tid * 4 + 1]) + (P[tid * 4 + 2] + P[tid * 4 + 3]);
            __hip_atomic_store(xch + ((size_t)(u.pm * 4 + u.pn) * 256 + tid), sp, __ATOMIC_RELAXED, __HIP_MEMORY_SCOPE_AGENT); }
        asm volatile("s_waitcnt vmcnt(0)" ::: "memory"); __builtin_amdgcn_s_barrier(); asm volatile("" ::: "memory");
        if (tid == 0) {
            unsigned* c = cnt + 64 * u.pm;
            __hip_atomic_fetch_add(c, 1u, __ATOMIC_RELEASE, __HIP_MEMORY_SCOPE_AGENT);
            unsigned spin = 0;
            while (__hip_atomic_load(c, __ATOMIC_RELAXED, __HIP_MEMORY_SCOPE_AGENT) < 4u) { __builtin_amdgcn_s_sleep(2); if (++spin > (1u << 22)) break; }
            __builtin_amdgcn_fence(__ATOMIC_ACQUIRE, "agent");
            asm volatile("s_waitcnt vmcnt(0)" ::: "memory");
        }
        __builtin_amdgcn_s_barrier(); asm volatile("" ::: "memory");
        if (tid < 256) { float tot = 0.f;
#pragma unroll
            for (int q = 0; q < 4; ++q) tot += __hip_atomic_load(xch + ((size_t)(u.pm * 4 + q) * 256 + tid), __ATOMIC_RELAXED, __HIP_MEMORY_SCOPE_AGENT);
            S[tid] = 1.f / sqrtf(tot * (1.f / 1024.f) + 1e-6f); }
        asm volatile("s_waitcnt vmcnt(0) lgkmcnt(0)" ::: "memory"); __builtin_amdgcn_s_barrier(); asm volatile("" ::: "memory");
        f32x4 gv[2][2];
#pragma unroll
        for (int bj = 0; bj < 2; ++bj) { gv[bj][0] = *(const f32x4*)(gf + col0 + bj * HALF); gv[bj][1] = *(const f32x4*)(gf + col0 + bj * HALF + 4); }
#pragma unroll
        for (int ai = 0; ai < 2; ++ai)
#pragma unroll
            for (int m = 0; m < 4; ++m) {
                const int rl = ai * HALF + wr * 64 + m * 16 + fr;
                const size_t row = (size_t)u.pm * BM + rl;
                const float sr = S[rl];
#pragma unroll
                for (int bj = 0; bj < 2; ++bj) { const size_t off = row * ldc + col0 + bj * HALF;
                    *(f32x4*)(out + off) = acc[ai][bj][m][0] * sr * gv[bj][0]; *(f32x4*)(out + off + 4) = acc[ai][bj][m][1] * sr * gv[bj][1]; }
            }
        asm volatile("s_waitcnt lgkmcnt(0)" ::: "memory"); __builtin_amdgcn_s_barrier(); asm volatile("" ::: "memory");
    }
};
struct EpiGlu {
    static constexpr bool PERM = true;
    bf16_t* ACT; const float* cw; const float* cb; float* GH; LAS float* halo; const float* rs;
    __device__ __forceinline__ void operator()(const f32x4 (&accr)[2][2][4][2], const Unit& u, int wr, int wc, int fr, int fq) const {
        const int colp = u.pn * 128 + wc * 32 + fq * 8;
        f32x4 acc[2][2][4][2];
        { const size_t tk = (size_t)u.pm * BM + 8 * (16 * wr + fr); const f32x4 r0 = *(const f32x4*)(rs + tk), r1 = *(const f32x4*)(rs + tk + 4);
#pragma unroll
          for (int ai = 0; ai < 2; ++ai)
#pragma unroll
              for (int m = 0; m < 4; ++m) { const float rr = ai ? r1[m] : r0[m];
#pragma unroll
                  for (int bj = 0; bj < 2; ++bj) { acc[ai][bj][m][0] = accr[ai][bj][m][0] * rr; acc[ai][bj][m][1] = accr[ai][bj][m][1] * rr; } } }
        if (wr == 0 && fr == 15) {
#pragma unroll
            for (int bj = 0; bj < 2; ++bj)
#pragma unroll
                for (int jj = 0; jj < 2; ++jj) { LAS float* h = halo + (((wc * 4 + fq) * 2 + bj) * 2 + jj) * 8; *(LAS f32x4*)h = acc[1][bj][2 + jj][0]; *(LAS f32x4*)(h + 4) = acc[1][bj][2 + jj][1]; }
        }
        if (wr == 0 && fr == 0) {
#pragma unroll
            for (int bj = 0; bj < 2; ++bj)
#pragma unroll
                for (int jj = 0; jj < 2; ++jj) { float* gp = GH + ((size_t)(u.pm * 4 + jj) * 2 + bj) * DFF + colp; *(f32x4*)gp = acc[0][bj][jj][0]; *(f32x4*)(gp + 4) = acc[0][bj][jj][1]; }
        }
        if (wr == 1 && fr == 15) {
#pragma unroll
            for (int bj = 0; bj < 2; ++bj)
#pragma unroll
                for (int jj = 0; jj < 2; ++jj) { float* gp = GH + ((size_t)(u.pm * 4 + 2 + jj) * 2 + bj) * DFF + colp; *(f32x4*)gp = acc[1][bj][2 + jj][0]; *(f32x4*)(gp + 4) = acc[1][bj][2 + jj][1]; }
        }
        asm volatile("s_waitcnt lgkmcnt(0)" ::: "memory"); __builtin_amdgcn_s_barrier(); asm volatile("" ::: "memory");
        const size_t tok0 = (size_t)u.pm * BM + 8 * (16 * wr + fr);
#pragma unroll
        for (int n = 0; n < 2; ++n) {
            f32x4 xm1[2], xm2[2];
#pragma unroll
            for (int bj = 0; bj < 2; ++bj) {
#pragma unroll
                for (int e = 0; e < 4; ++e) { xm1[bj][e] = dpp_f<0x111>(acc[1][bj][3][n][e]); xm2[bj][e] = dpp_f<0x111>(acc[1][bj][2][n][e]); }
                if (fr == 0) {
                    if (wr == 1) { const LAS float* h = halo + (((wc * 4 + fq) * 2 + bj) * 2) * 8 + 4 * n; xm2[bj] = *(const LAS f32x4*)h; xm1[bj] = *(const LAS f32x4*)(h + 8); }
                    else { xm1[bj] = (f32x4){0.f, 0.f, 0.f, 0.f}; xm2[bj] = xm1[bj]; }
                }
            }
            const int c0 = colp + 4 * n;
            const f32x4 wa0 = *(const f32x4*)(cw + c0), wa1 = *(const f32x4*)(cw + 5632 + c0), wa2 = *(const f32x4*)(cw + 2 * 5632 + c0), ba = *(const f32x4*)(cb + c0);
            const f32x4 wb0 = *(const f32x4*)(cw + DFF + c0), wb1 = *(const f32x4*)(cw + 5632 + DFF + c0), wb2 = *(const f32x4*)(cw + 2 * 5632 + DFF + c0), bb = *(const f32x4*)(cb + DFF + c0);
#pragma unroll
            for (int j = 0; j < 8; ++j) {
                const f32x4 xa = acc[j >> 2][0][j & 3][n], xb = acc[j >> 2][1][j & 3][n];
                const f32x4 ha = ba + wa0 * xm2[0] + wa1 * xm1[0] + wa2 * xa, hb = bb + wb0 * xm2[1] + wb1 * xm1[1] + wb2 * xb;
                float o[4];
#pragma unroll
                for (int e = 0; e < 4; ++e) o[e] = ha[e] * sigmoidf_(ha[e]) * hb[e];
                u32x2 w; w.x = cvt_pk_bf16(o[0], o[1]); w.y = cvt_pk_bf16(o[2], o[3]);
                *(u32x2*)(ACT + (tok0 + j) * DFF + c0) = w;
                xm2[0] = xm1[0]; xm1[0] = xa; xm2[1] = xm1[1]; xm1[1] = xb;
            }
        }
    }
};

template <class Epi, bool ALIGN_EPI, bool ROWPERM = false>
__device__ __forceinline__ void gemm_phase(LAS unsigned char* lds, const Gemm g, const StaticOrder& S, const Epi& E) {
    int tid = threadIdx.x; asm volatile("" : "+v"(tid));
    const int wid = __builtin_amdgcn_readfirstlane(tid >> 6), lane = tid & 63, wr = wid >> 2, wc = wid & 3, fr = lane & 15, fq = lane >> 4;
    const int K = g.K, nt = K / BK;
    unsigned voffA[2], voffA1[2], voffB[2];
#pragma unroll
    for (int i = 0; i < 2; ++i) { int R, C; stage_rc(tid * 16 + i * 8192, R, C); const int Rb = Epi::PERM ? ((R & ~31) + perm32(R & 31)) : R;
        if constexpr (ROWPERM) { const int tau0 = 8 * (16 * (R >> 6) + (R & 15)) + ((R >> 4) & 3);
            voffA[i] = (unsigned)tau0 * g.a_row + (unsigned)C * 2u; voffA1[i] = (unsigned)(tau0 + 4) * g.a_row + (unsigned)C * 2u; }
        else { voffA[i] = (unsigned)R * g.a_row + (unsigned)C * 2u; voffA1[i] = 0u; }
        voffB[i] = (unsigned)(Rb * g.ldb + C) * 2u; }
#define PG8_STAGE_A1(bufoff, gbase) do { if constexpr (ROWPERM) { PG8_STAGE(bufoff, gbase, voffA1); } else { PG8_STAGE(bufoff, (gbase) + ahstep, voffA); } } while (0)
    const size_t akstep = g.a_kstep, ahstep = g.a_hstep, atstep = g.a_tstep;
    const size_t bkstep = (size_t)(BK * 2), bhstep = (size_t)HALF * g.ldb * 2, btstep = 2 * bhstep;
    const unsigned ldsw = (unsigned)wid * 1024u;
    const int aoff = lds_byte(wr * 64 + fr, fq * 8), boff = lds_byte(wc * 32 + fr, fq * 8);
#define PG8_SA(b, h) (((b) * 2 + (h)) * HTB)
#define PG8_SB(b, h) ((4 + (b) * 2 + (h)) * HTB)
#define PG8_STAGE(bufoff, gbase, voff) do { _Pragma("unroll") for (int _i = 0; _i < 2; ++_i) \
        __builtin_amdgcn_global_load_lds((const unsigned*)((const char*)(gbase) + (voff)[_i]), (LAS unsigned*)(lds + (bufoff) + ldsw + _i * 8192), 16, 0, 0); } while (0)
#define PG8_LDA(dst, b, h) do { _Pragma("unroll") for (int m = 0; m < 4; ++m) _Pragma("unroll") for (int k = 0; k < 2; ++k) dst[m][k] = *(const LAS bf16x8*)(lds + PG8_SA(b, h) + aoff + m * 2048 + k * 1024); } while (0)
#define PG8_LDB(dst, b, h) do { _Pragma("unroll") for (int n = 0; n < 2; ++n) _Pragma("unroll") for (int k = 0; k < 2; ++k) dst[n][k] = *(const LAS bf16x8*)(lds + PG8_SB(b, h) + boff + n * 2048 + k * 1024); } while (0)
#define PG8_MMA(ai, bj, At, Bt) do { __builtin_amdgcn_s_setprio(1); _Pragma("unroll") for (int m = 0; m < 4; ++m) _Pragma("unroll") for (int n = 0; n < 2; ++n) _Pragma("unroll") for (int k = 0; k < 2; ++k) \
        acc[ai][bj][m][n] = __builtin_amdgcn_mfma_f32_16x16x32_bf16(Bt[n][k], At[m][k], acc[ai][bj][m][n], 0, 0, 0); __builtin_amdgcn_s_setprio(0); } while (0)
#define PG8_WAIT_V(n) asm volatile("s_waitcnt vmcnt(" #n ")" ::: "memory")
#define PG8_WAIT_L(n) asm volatile("s_waitcnt lgkmcnt(" #n ")" ::: "memory")
#define PG8_BAR __builtin_amdgcn_s_barrier()
#define PG8_SCHED __builtin_amdgcn_sched_barrier(0)
    Unit cur, nxt; int ui = 0;
    if (!S.next(0, cur)) return;
    f32x4 acc[2][2][4][2];
#pragma unroll
    for (int a = 0; a < 2; ++a)
#pragma unroll
        for (int b = 0; b < 2; ++b)
#pragma unroll
            for (int m = 0; m < 4; ++m)
#pragma unroll
                for (int n = 0; n < 2; ++n) acc[a][b][m][n] = (f32x4){0.f, 0.f, 0.f, 0.f};
    bf16x8 At[4][2], B0[2][2], B1[2][2];
    const char* cA = (const char*)g.A + (size_t)cur.pm * atstep; const char* cB = (const char*)g.Bt + (size_t)cur.pn * btstep;
    PG8_STAGE(PG8_SB(0, 0), cB, voffB); PG8_STAGE(PG8_SB(0, 1), cB + bhstep, voffB); PG8_STAGE(PG8_SA(0, 0), cA, voffA); PG8_STAGE_A1(PG8_SA(0, 1), cA);
    if (wr == 1) PG8_BAR;
    PG8_WAIT_V(2); PG8_BAR;
    PG8_STAGE(PG8_SB(1, 0), cB + bkstep, voffB); PG8_STAGE(PG8_SA(1, 0), cA + akstep, voffA); PG8_STAGE(PG8_SB(1, 1), cB + bhstep + bkstep, voffB);
    PG8_WAIT_V(6); PG8_BAR;
    for (;;) {
        const bool has_next = S.next(ui + 1, nxt);
        const char* nA = has_next ? (const char*)g.A + (size_t)nxt.pm * atstep : cA; const char* nB = has_next ? (const char*)g.Bt + (size_t)nxt.pn * btstep : cB;
        for (int t = 0; t < nt; t += 2) {
            const bool last = (t == nt - 2);
            const char* a1 = cA + (size_t)(t + 1) * akstep;
            const char* a2 = last ? nA : cA + (size_t)(t + 2) * akstep; const char* b2 = last ? nB : cB + (size_t)(t + 2) * bkstep;
            const char* a3 = a2 + akstep; const char* b3 = b2 + bkstep;
            PG8_LDB(B0, 0, 0); PG8_LDB(B1, 0, 1); PG8_SCHED; PG8_LDA(At, 0, 0); PG8_STAGE_A1(PG8_SA(1, 1), a1);
            PG8_WAIT_V(8); PG8_WAIT_L(0); PG8_BAR; PG8_MMA(0, 0, At, B0); PG8_MMA(0, 1, At, B1); PG8_BAR; PG8_SCHED;
            PG8_LDA(At, 0, 1); PG8_STAGE(PG8_SB(0, 0), b2, voffB); PG8_STAGE(PG8_SB(0, 1), b2 + bhstep, voffB); PG8_STAGE(PG8_SA(0, 0), a2, voffA);
            PG8_WAIT_V(8); PG8_WAIT_L(0); PG8_BAR; PG8_MMA(1, 0, At, B0); PG8_MMA(1, 1, At, B1); PG8_BAR; PG8_SCHED;
            PG8_LDB(B0, 1, 0); PG8_LDB(B1, 1, 1); PG8_SCHED; PG8_LDA(At, 1, 0); PG8_STAGE_A1(PG8_SA(0, 1), a2);
            PG8_WAIT_V(8); PG8_WAIT_L(0); PG8_BAR; PG8_MMA(0, 0, At, B0); PG8_MMA(0, 1, At, B1); PG8_BAR; PG8_SCHED;
            PG8_LDA(At, 1, 1); PG8_STAGE(PG8_SB(1, 0), b3, voffB); PG8_STAGE(PG8_SB(1, 1), b3 + bhstep, voffB); PG8_STAGE(PG8_SA(1, 0), a3, voffA);
            PG8_WAIT_V(8); PG8_WAIT_L(0); PG8_BAR; PG8_MMA(1, 0, At, B0); PG8_MMA(1, 1, At, B1); PG8_BAR; PG8_SCHED;
        }
        if constexpr (ALIGN_EPI) { if (wr == 0) PG8_BAR; }
        E(acc, cur, wr, wc, fr, fq);
        if (!has_next) break;
#pragma unroll
        for (int a = 0; a < 2; ++a)
#pragma unroll
            for (int b = 0; b < 2; ++b)
#pragma unroll
                for (int m = 0; m < 4; ++m)
#pragma unroll
                    for (int n = 0; n < 2; ++n) acc[a][b][m][n] = (f32x4){0.f, 0.f, 0.f, 0.f};
        cur = nxt; cA = nA; cB = nB; ++ui;
        if constexpr (ALIGN_EPI) { if (wr == 1) PG8_BAR; }
    }
    PG8_WAIT_V(0);
    if constexpr (!ALIGN_EPI) { if (wr == 0) PG8_BAR; }
    PG8_BAR;
#undef PG8_SA
#undef PG8_SB
#undef PG8_STAGE
#undef PG8_STAGE_A1
#undef PG8_LDA
#undef PG8_LDB
#undef PG8_MMA
#undef PG8_WAIT_V
#undef PG8_WAIT_L
#undef PG8_BAR
#undef PG8_SCHED
}
}

struct Args {
    const float* in[34];
    float* out; unsigned char* ws;
};
enum { I_X = 0, I_P, I_LN1, I_WIN, I_MURKV, I_MUWAG, I_W0, I_W1, I_W2, I_A0, I_A1, I_A2, I_G1, I_G2, I_KK, I_KA, I_RK, I_LNXG, I_LNXB, I_CPOS, I_CW1, I_CW2,
       I_WOA, I_WOB, I_WO, I_LN2, I_WUP, I_CONVW, I_CONVB, I_WDN, I_LN3, I_WPG, I_WPP, I_LNF };

template <class F> __device__ __forceinline__ void tr_matrix(F f, int Kd, int Nd, bf16_t* WT, float* scr, int gw, int NGW, int lane) {
    const int nblk = Nd / 32, nitems = (Kd / 64) * nblk;
    for (int item = gw; item < nitems; item += NGW) {
        const int kb = item / nblk, nb = item % nblk, k0 = 64 * kb, n0 = 32 * nb;
#pragma unroll 16
        for (int i = 0; i < 32; ++i) { const int kk = 2 * i + (lane >> 5); scr[kk * 33 + (lane & 31)] = f(k0 + kk, n0 + (lane & 31)); }
        asm volatile("s_waitcnt lgkmcnt(0)" ::: "memory");
        const int c = lane & 7;
#pragma unroll
        for (int j = 0; j < 4; ++j) { const int n = (lane >> 3) + 8 * j; const float* s = scr + (8 * c) * 33 + n;
            u32x4 o; o.x = cvt_pk_bf16(s[0 * 33], s[1 * 33]); o.y = cvt_pk_bf16(s[2 * 33], s[3 * 33]); o.z = cvt_pk_bf16(s[4 * 33], s[5 * 33]); o.w = cvt_pk_bf16(s[6 * 33], s[7 * 33]);
            *(u32x4*)(WT + (size_t)(n0 + n) * Kd + k0 + 8 * c) = o; }
        asm volatile("s_waitcnt lgkmcnt(0)" ::: "memory");
    }
}
template <bool OUT_BF16, bool NT = false> __device__ __forceinline__ void rms_rows(float* x, const float* g, bf16_t* ob, int gw, int NGW, int lane) {
    const f32x4* gr = (const f32x4*)g + lane;
    f32x4 gg[4];
#pragma unroll
    for (int j = 0; j < 4; ++j) gg[j] = gr[64 * j];
    for (int r0 = gw; r0 < T; r0 += 4 * NGW) {
        f32x4 v[4][4];
#pragma unroll
        for (int u = 0; u < 4; ++u) { const int r = r0 + u * NGW; if (r < T) { const f32x4* xr = (const f32x4*)(x + (size_t)r * DM) + lane;
#pragma unroll
            for (int j = 0; j < 4; ++j) v[u][j] = NT ? __builtin_nontemporal_load(xr + 64 * j) : xr[64 * j]; } }
#pragma unroll
        for (int u = 0; u < 4; ++u) { const int r = r0 + u * NGW; if (r < T) {
            float s = 0.f;
#pragma unroll
            for (int j = 0; j < 4; ++j) s += (v[u][j].x * v[u][j].x + v[u][j].y * v[u][j].y) + (v[u][j].z * v[u][j].z + v[u][j].w * v[u][j].w);
            const float rs = 1.f / sqrtf(wave_sum(s) * (1.f / 1024.f) + 1e-6f);
            if (OUT_BF16) { u32x2* o8 = (u32x2*)(ob + (size_t)r * DM) + lane;
#pragma unroll
                for (int j = 0; j < 4; ++j) { u32x2 w; w.x = cvt_pk_bf16(v[u][j].x * rs * gg[j].x, v[u][j].y * rs * gg[j].y); w.y = cvt_pk_bf16(v[u][j].z * rs * gg[j].z, v[u][j].w * rs * gg[j].w); o8[64 * j] = w; }
            } else { f32x4* xr = (f32x4*)(x + (size_t)r * DM) + lane;
#pragma unroll
                for (int j = 0; j < 4; ++j) xr[64 * j] = v[u][j] * rs * gg[j]; }
        } }
    }
}

__device__ __forceinline__ bf16x8 afrag(const bf16_t* base, int pitch, int row, int kofs, int hi) {
    const bf16_t* p = base + row * pitch + kofs + 4 * hi;
    const s16x4 lo = *(const s16x4*)p, hh = *(const s16x4*)(p + 8);
    return (bf16x8){lo[0], lo[1], lo[2], lo[3], hh[0], hh[1], hh[2], hh[3]};
}
__device__ __forceinline__ bf16x8 pack8(const f32x16& a, int b) {
    u32x4 w; w.x = cvt_pk_bf16(a[b + 0], a[b + 1]); w.y = cvt_pk_bf16(a[b + 2], a[b + 3]); w.z = cvt_pk_bf16(a[b + 4], a[b + 5]); w.w = cvt_pk_bf16(a[b + 6], a[b + 7]);
    return __builtin_bit_cast(bf16x8, w);
}
#define LBAR() asm volatile("s_waitcnt lgkmcnt(0)\n\ts_barrier" ::: "memory")
constexpr int SC_KK = 0, SC_WW = 8192, SC_BB = 16384, SC_K2 = 24576, SC_RR = 32768, SC_YY = 40960, SC_VV = 49152  , SC_BON = 73728  ;
constexpr int SC_KBT = 74240  , SC_CT = 82944  , SC_OPS = 93440  , SC_OPB = 15616;
constexpr int SC_TAB = 155904;
constexpr int OP_XT = 0, OP_KB = 4352, OP_VT = 8960, OP_WL = 11520, OP_A3 = 11776, OP_A4 = 13056, OP_A5 = 14336;
static_assert(SC_OPS + 4 * SC_OPB <= SC_TAB && SC_TAB + 2048 <= LDS_BYTES - 64, "scan LDS map");
__device__ __forceinline__ void scan_unit(const Args& A, int bh, unsigned char* L) {
    int tid = threadIdx.x; asm volatile("" : "+v"(tid));
    const int b = bh >> 3, h = bh & 7;
    const bf16_t* PROJ = (const bf16_t*)(A.ws + WS_PROJ); const bf16_t* LO = (const bf16_t*)(A.ws + WS_LO); bf16_t* YA = (bf16_t*)(A.ws + WS_YA);
    float* KK = (float*)(L + SC_KK); float* WW = (float*)(L + SC_WW); float* BB = (float*)(L + SC_BB); float* K2 = (float*)(L + SC_K2); float* RR = (float*)(L + SC_RR); float* YY = (float*)(L + SC_YY);
    const int tt = tid >> 4, c4 = (tid & 15) * 4, ch = h * 64 + c4;
    const int lane = tid & 63, wv = __builtin_amdgcn_readfirstlane(tid >> 6), r32 = lane & 31, hi = lane >> 5;
    float* TAB = (float*)(L + SC_TAB);
    if (tid < 64) { const int cc = h * 64 + tid;
        TAB[tid] = A.in[I_MURKV][cc]; TAB[64 + tid] = A.in[I_MURKV][512 + cc]; TAB[128 + tid] = A.in[I_MURKV][1024 + cc]; TAB[192 + tid] = A.in[I_KK][cc];
        TAB[256 + tid] = A.in[I_KA][cc]; TAB[320 + tid] = A.in[I_RK][cc]; TAB[384 + tid] = A.in[I_LNXG][cc]; TAB[448 + tid] = A.in[I_LNXB][cc]; }
    LBAR();
    const f32x16 zero16s = (f32x16){0.f,0.f,0.f,0.f,0.f,0.f,0.f,0.f,0.f,0.f,0.f,0.f,0.f,0.f,0.f,0.f};
    f32x16 St[2]; St[0] = zero16s; St[1] = zero16s;
    u32x2 raw[9];
    float gq_prev[4] = {0.f, 0.f, 0.f, 0.f}, gq_cur[4] = {0.f, 0.f, 0.f, 0.f}, gq_next[4];
    auto load_raw = [&](int chunk) {
        const size_t t = (size_t)b * SEQ + chunk * 32 + tt;
        const bf16_t* p = PROJ + t * LDP + ch;
        raw[0] = *(const u32x2*)(p + C_R); raw[1] = *(const u32x2*)(p + C_K); raw[2] = *(const u32x2*)(p + C_V);
        if (chunk == 0 && tt == 0) { raw[3] = (u32x2){0u, 0u}; raw[4] = raw[3]; raw[5] = raw[3]; }
        else { raw[3] = *(const u32x2*)(p - LDP + C_R); raw[4] = *(const u32x2*)(p - LDP + C_K); raw[5] = *(const u32x2*)(p - LDP + C_V); }
        const bf16_t* q = LO + t * 1536 + ch;
        raw[6] = *(const u32x2*)(q); raw[7] = *(const u32x2*)(q + 512); raw[8] = *(const u32x2*)(q + 1024);
    };
    auto prep = [&](int c) {
        float* VV = (float*)(L + SC_VV + (c % 3) * 8192); float* BON = (float*)(L + SC_BON + (c % 3) * 128);
        float r[4], k[4], v[4], rp[4], kp[4], vp[4], ew[4], a[4];
        unpack4(raw[0], r); unpack4(raw[1], k); unpack4(raw[2], v); unpack4(raw[3], rp); unpack4(raw[4], kp); unpack4(raw[5], vp); unpack4(raw[6], ew); unpack4(raw[7], a); unpack4(raw[8], gq_next);
        const f32x4 mu_r = *(const f32x4*)(TAB + c4), mu_k = *(const f32x4*)(TAB + 64 + c4), mu_v = *(const f32x4*)(TAB + 128 + c4), k_k = *(const f32x4*)(TAB + 192 + c4), k_a = *(const f32x4*)(TAB + 256 + c4), r_k = *(const f32x4*)(TAB + 320 + c4);
        float kku[4], k2[4], ss = 0.f, bon = 0.f;
#pragma unroll
        for (int e = 0; e < 4; ++e) { r[e] += (rp[e] - r[e]) * mu_r[e]; k[e] += (kp[e] - k[e]) * mu_k[e]; v[e] += (vp[e] - v[e]) * mu_v[e];
            kku[e] = k[e] * k_k[e]; ss += kku[e] * kku[e]; k2[e] = k[e] * (1.f + (a[e] - 1.f) * k_a[e]); bon += r[e] * k2[e] * r_k[e]; }
        ss = red16(ss); bon = red16(bon);
        const float inv = 1.f / fmaxf(sqrtf(ss), 1e-12f);
        f32x4 kk4, w4, b4, k24, r4, v4;
#pragma unroll
        for (int e = 0; e < 4; ++e) { const float kk = kku[e] * inv; kk4[e] = kk; w4[e] = __expf(-ew[e]); b4[e] = kk * a[e]; k24[e] = k2[e]; r4[e] = r[e]; v4[e] = v[e]; }
        const int o = tt * 64 + c4;
        *(f32x4*)(KK + o) = kk4; *(f32x4*)(WW + o) = w4; *(f32x4*)(BB + o) = b4; *(f32x4*)(K2 + o) = k24; *(f32x4*)(RR + o) = r4; *(f32x4*)(VV + o) = v4;
        if ((tid & 15) == 0) BON[tt] = bon;
    };
    auto stageB = [&](int c) {
        const float* VV = (const float*)(L + SC_VV + (c % 3) * 8192);
        const int sc = wv >> 2, tq = wv & 3, k = lane;
        unsigned char* blk = L + SC_OPS + ((c & 1) * 2 + sc) * SC_OPB;
        bf16_t* XT = (bf16_t*)(blk + OP_XT); bf16_t* KB = (bf16_t*)(blk + OP_KB); bf16_t* VTt = (bf16_t*)(blk + OP_VT); float* WL = (float*)(blk + OP_WL); bf16_t* KBT = (bf16_t*)(L + SC_KBT + sc * 4352);
        float W = 1.f;
#pragma unroll
        for (int t = 0; t < 12; ++t) { const float wq = WW[(16 * sc + t) * 64 + k]; W *= (t < 4 * tq) ? wq : 1.f; }
#pragma unroll
        for (int t4 = 0; t4 < 4; ++t4) {
            const int t = 4 * tq + t4;
            const int o = (16 * sc + t) * 64 + k;
            const float w = WW[o], kk = KK[o], bq = BB[o], k2 = K2[o], r = RR[o], vv = VV[o];
            const float alpha = W * kk; W *= w; const float invW = __builtin_amdgcn_rcpf(W);
            const float beta = bq * invW, kappa = k2 * invW, rho = W * r;
            const unsigned pa = cvt_pk_bf16(alpha, rho), pk = cvt_pk_bf16(kappa, beta), pn = cvt_pk_bf16(-beta, vv);
            XT[t * 68 + k] = (bf16_t)(pa & 0xffffu); XT[(16 + t) * 68 + k] = (bf16_t)(pa >> 16);
            KBT[t * 68 + k] = (bf16_t)(pk & 0xffffu); KBT[(16 + t) * 68 + k] = (bf16_t)(pk >> 16);
            KB[k * 36 + t] = (bf16_t)(pk & 0xffffu); KB[k * 36 + 16 + t] = (bf16_t)(pn & 0xffffu);
            VTt[k * 20 + t] = (bf16_t)(pn >> 16);
        }
        if (tq == 3) WL[k] = W;
    };
    auto stageC = [&](int c) {
        const int sc = wv - 2;
        unsigned char* blk = L + SC_OPS + ((c & 1) * 2 + sc) * SC_OPB;
        const bf16_t* XT = (const bf16_t*)(blk + OP_XT); const bf16_t* KBT = (const bf16_t*)(L + SC_KBT + sc * 4352);
        float* SM = (float*)(L + SC_CT + sc * 5248); float* QT = SM + 1056; bf16_t* A3 = (bf16_t*)(blk + OP_A3); bf16_t* A4 = (bf16_t*)(blk + OP_A4); bf16_t* A5 = (bf16_t*)(blk + OP_A5);
        f32x16 sm = zero16s;
#pragma unroll
        for (int cc = 0; cc < 4; ++cc) sm = __builtin_amdgcn_mfma_f32_32x32x16_bf16(afrag(KBT, 68, r32, 16 * cc, hi), afrag(XT, 68, r32, 16 * cc, hi), sm, 0, 0, 0);
#pragma unroll
        for (int r = 0; r < 16; ++r) SM[((r & 3) + 8 * (r >> 2) + 4 * hi) * 33 + r32] = sm[r];
        if (r32 < 16) { *(f32x4*)(QT + r32 * 16 + 4 * hi) = (f32x4){sm[8], sm[9], sm[10], sm[11]}; *(f32x4*)(QT + r32 * 16 + 8 + 4 * hi) = (f32x4){sm[12], sm[13], sm[14], sm[15]}; }
        asm volatile("s_waitcnt lgkmcnt(0)" ::: "memory");
        {
            const int rr = lane & 15;
            f32x4 q[16][4];
#pragma unroll
            for (int t = 1; t < 16; ++t)
#pragma unroll
                for (int v4 = 0; v4 < 4; ++v4) if (4 * v4 < t) q[t][v4] = *(const f32x4*)(QT + t * 16 + 4 * v4);
            float N[16];
#pragma unroll
            for (int t = 0; t < 16; ++t) {
                float acc0 = (rr == t) ? 1.f : 0.f, acc1 = 0.f;
#pragma unroll
                for (int i = 0; i < t; ++i) { if (i & 1) acc1 -= N[i] * q[t][i >> 2][i & 3]; else acc0 -= N[i] * q[t][i >> 2][i & 3]; }
                N[t] = acc0 + acc1;
            }
            if (lane < 16) {
#pragma unroll
                for (int t = 0; t < 16; ++t) A4[t * 20 + rr] = (bf16_t)(cvt_pk_bf16(N[t], 0.f) & 0xffffu);
            } else if (lane < 32) {
#pragma unroll
                for (int i = 0; i < 16; ++i) A4[lane * 20 + i] = 0;
            }
        }
        {
            const int m = lane & 31, i0 = (lane >> 5) * 8;
#pragma unroll
            for (int e = 0; e < 8; ++e) { const int i = i0 + e;
                float a3, a5;
                if (m < 16) { a3 = (i < m) ? SM[i * 33 + m] : 0.f; a5 = 0.f; }
                else { const int t = m - 16; a3 = (i <= t) ? SM[i * 33 + 16 + t] : 0.f; a5 = (i <= t) ? -SM[(16 + i) * 33 + 16 + t] : 0.f; }
                const unsigned pk = cvt_pk_bf16(a3, a5);
                A3[m * 20 + i] = (bf16_t)(pk & 0xffffu); A5[m * 20 + i] = (bf16_t)(pk >> 16); }
        }
    };
    auto stageD = [&](int c) {
        bf16x8 fXT[2][4], fKB[2][4], fV[2], fA3[2], fA4[2], fA5[2];
#pragma unroll
        for (int sc = 0; sc < 2; ++sc) {
            const unsigned char* blk = L + SC_OPS + ((c & 1) * 2 + sc) * SC_OPB;
            const bf16_t* XT = (const bf16_t*)(blk + OP_XT); const bf16_t* KB = (const bf16_t*)(blk + OP_KB); const bf16_t* VTt = (const bf16_t*)(blk + OP_VT);
#pragma unroll
            for (int q4 = 0; q4 < 4; ++q4) fXT[sc][q4] = afrag(XT, 68, r32, 16 * q4, hi);
            fV[sc] = afrag(VTt, 20, 32 * wv + r32, 0, hi);
            fA3[sc] = afrag((const bf16_t*)(blk + OP_A3), 20, r32, 0, hi); fA4[sc] = afrag((const bf16_t*)(blk + OP_A4), 20, r32, 0, hi); fA5[sc] = afrag((const bf16_t*)(blk + OP_A5), 20, r32, 0, hi);
#pragma unroll
            for (int t2 = 0; t2 < 2; ++t2) { fKB[sc][2 * t2] = afrag(KB, 36, 32 * t2 + r32, 0, hi); fKB[sc][2 * t2 + 1] = afrag(KB, 36, 32 * t2 + r32, 16, hi); }
        }
#pragma unroll
        for (int sc = 0; sc < 2; ++sc) {
            const float* WL = (const float*)(L + SC_OPS + ((c & 1) * 2 + sc) * SC_OPB + OP_WL);
            f32x4 wl[2][4];
#pragma unroll
            for (int t2 = 0; t2 < 2; ++t2)
#pragma unroll
                for (int g4 = 0; g4 < 4; ++g4) wl[t2][g4] = *(const f32x4*)(WL + 32 * t2 + 8 * g4 + 4 * hi);
            f32x16 Gm = zero16s;
#pragma unroll
            for (int t2 = 0; t2 < 2; ++t2)
#pragma unroll
                for (int cc = 0; cc < 2; ++cc) Gm = __builtin_amdgcn_mfma_f32_32x32x16_bf16(fXT[sc][2 * t2 + cc], pack8(St[t2], 8 * cc), Gm, 0, 0, 0);
            Gm = __builtin_amdgcn_mfma_f32_32x32x16_bf16(fA3[sc], fV[sc], Gm, 0, 0, 0);
            const f32x16 Um = __builtin_amdgcn_mfma_f32_32x32x16_bf16(fA4[sc], pack8(Gm, 0), zero16s, 0, 0, 0);
            const bf16x8 ub = pack8(Um, 0);
#pragma unroll
            for (int t2 = 0; t2 < 2; ++t2) {
                St[t2] = __builtin_amdgcn_mfma_f32_32x32x16_bf16(fKB[sc][2 * t2], fV[sc], St[t2], 0, 0, 0);
                St[t2] = __builtin_amdgcn_mfma_f32_32x32x16_bf16(fKB[sc][2 * t2 + 1], ub, St[t2], 0, 0, 0);
            }
            Gm = __builtin_amdgcn_mfma_f32_32x32x16_bf16(fA5[sc], ub, Gm, 0, 0, 0);
#pragma unroll
            for (int t2 = 0; t2 < 2; ++t2)
#pragma unroll
                for (int g4 = 0; g4 < 4; ++g4)
#pragma unroll
                    for (int e = 0; e < 4; ++e) St[t2][4 * g4 + e] *= wl[t2][g4][e];
#pragma unroll
            for (int e = 0; e < 4; ++e) { YY[(16 * sc + 4 * hi + e) * 64 + 32 * wv + r32] = Gm[8 + e]; YY[(16 * sc + 8 + 4 * hi + e) * 64 + 32 * wv + r32] = Gm[12 + e]; }
        }
    };
    auto outst = [&](int c, const float (&gq)[4]) {
        const float* VV = (const float*)(L + SC_VV + (c % 3) * 8192); const float* BON = (const float*)(L + SC_BON + (c % 3) * 128);
        const int o = tt * 64 + c4;
        const f32x4 y4 = *(const f32x4*)(YY + o), v4 = *(const f32x4*)(VV + o);
        const float mean = red16((y4[0] + y4[1]) + (y4[2] + y4[3])) * (1.f / 64.f);
        float q = 0.f;
#pragma unroll
        for (int e = 0; e < 4; ++e) { const float d = y4[e] - mean; q += d * d; }
        const float rstd = 1.f / sqrtf(red16(q) * (1.f / 64.f) + 64e-5f);
        const float bon = BON[tt];
        const f32x4 lg = *(const f32x4*)(TAB + 384 + c4), lb = *(const f32x4*)(TAB + 448 + c4);
        float o4[4];
#pragma unroll
        for (int e = 0; e < 4; ++e) o4[e] = ((y4[e] - mean) * rstd * lg[e] + lb[e] + bon * v4[e]) * gq[e];
        u32x2 w; w.x = cvt_pk_bf16(o4[0], o4[1]); w.y = cvt_pk_bf16(o4[2], o4[3]);
        *(u32x2*)(YA + ((size_t)b * SEQ + c * 32 + tt) * 512 + ch) = w;
    };
    load_raw(0);
    prep(0);
#pragma unroll
    for (int e = 0; e < 4; ++e) gq_cur[e] = gq_next[e];
    load_raw(1);
    LBAR();
    stageB(0);
    LBAR();
    if (wv == 2 || wv == 3) stageC(0);
    LBAR();
    for (int c = 0; c < 64; ++c) {
        if (c >= 1) outst(c - 1, gq_prev);
        if (c + 1 < 64) prep(c + 1);
#pragma unroll
        for (int e = 0; e < 4; ++e) { gq_prev[e] = gq_cur[e]; gq_cur[e] = gq_next[e]; }
        if (c + 2 < 64) load_raw(c + 2);
        LBAR();
        if (c + 1 < 64) stageB(c + 1);
        LBAR();
        if (wv < 2) stageD(c);
        else if (wv < 4) { if (c + 1 < 64) stageC(c + 1); }
        LBAR();
    }
    outst(63, gq_prev);
    LBAR();
}

__device__ __forceinline__ float other_half(float x) {
    const auto rr = __builtin_amdgcn_permlane32_swap(__float_as_uint(x), __float_as_uint(x), false, false);
    const float a = __uint_as_float(rr[0]), b = __uint_as_float(rr[1]);
    return (threadIdx.x & 32) ? a : b;
}
__device__ __forceinline__ float halves_max(float x) { const auto rr = __builtin_amdgcn_permlane32_swap(__float_as_uint(x), __float_as_uint(x), false, false); return fmaxf(__uint_as_float(rr[0]), __uint_as_float(rr[1])); }
__device__ __forceinline__ float halves_sum(float x) { const auto rr = __builtin_amdgcn_permlane32_swap(__float_as_uint(x), __float_as_uint(x), false, false); return __uint_as_float(rr[0]) + __uint_as_float(rr[1]); }
typedef short v4i16_t __attribute__((ext_vector_type(4)));
__device__ __forceinline__ s16x4 lds_tr16(const void* p) { return __builtin_bit_cast(s16x4, __builtin_amdgcn_ds_read_tr16_b64_v4i16((LAS v4i16_t*)p)); }
constexpr int KS_PITCH = 72;
struct AttnLds { bf16_t* Ks; bf16_t* Vt; float* IMP; float* SC; unsigned* SEL; };

template <bool MASKED, class VF> __device__ __forceinline__ void attn_step(const AttnLds& Z, const bf16x8 (&qf)[4], f32x16 (&o)[2], float& m, float& l, VF valid, bool lanesel, int r32, int hi) {
    f32x16 s[2];
#pragma unroll
    for (int hv = 0; hv < 2; ++hv) {
        s[hv] = (f32x16){0.f,0.f,0.f,0.f,0.f,0.f,0.f,0.f,0.f,0.f,0.f,0.f,0.f,0.f,0.f,0.f};
#pragma unroll
        for (int c = 0; c < 4; ++c) { const bf16x8 kf = *(const bf16x8*)(Z.Ks + (32 * hv + r32) * KS_PITCH + 16 * c + 8 * hi); s[hv] = __builtin_amdgcn_mfma_f32_32x32x16_bf16(kf, qf[c], s[hv], 0, 0, 0); }
    }
    if (MASKED) {
#pragma unroll
        for (int hv = 0; hv < 2; ++hv)
#pragma unroll
            for (int r = 0; r < 16; ++r) { const int kvl = 32 * hv + (r & 3) + 8 * (r >> 2) + 4 * hi; s[hv][r] = valid(kvl) ? s[hv][r] : -1e30f; }
    }
    float mx0 = fmaxf(s[0][0], s[1][0]), mx1 = fmaxf(s[0][1], s[1][1]);
#pragma unroll
    for (int r = 2; r < 16; r += 2) { mx0 = fmaxf(fmaxf(mx0, s[0][r]), s[1][r]); mx1 = fmaxf(fmaxf(mx1, s[0][r + 1]), s[1][r + 1]); }
    float mx = fmaxf(mx0, mx1);
    mx = halves_max(mx);
    if (__any(mx > m + 8.f)) { const float mn = fmaxf(m, mx); const float alpha = __builtin_amdgcn_exp2f(m - mn); l *= alpha; o[0] = o[0] * alpha; o[1] = o[1] * alpha; m = mn; }
    const float nb = lanesel ? -m : -__builtin_inff();
    f32x2 ps2 = (f32x2){0.f, 0.f};
#pragma unroll
    for (int hv = 0; hv < 2; ++hv) {
#pragma unroll
        for (int r = 0; r < 16; r += 2) {
            const f32x2 d = (f32x2){s[hv][r], s[hv][r + 1]} + (f32x2){nb, nb};
            float p0 = __builtin_amdgcn_exp2f(d.x), p1 = __builtin_amdgcn_exp2f(d.y);
            if (MASKED) { p0 = s[hv][r] > -1e29f ? p0 : 0.f; p1 = s[hv][r + 1] > -1e29f ? p1 : 0.f; }
            s[hv][r] = p0; s[hv][r + 1] = p1; ps2 += (f32x2){p0, p1};
        }
#pragma unroll
        for (int cc = 0; cc < 2; ++cc) {
            const int c = 2 * hv + cc, rb = 8 * cc;
            u32x4 pw; pw.x = cvt_pk_bf16(s[hv][rb + 0], s[hv][rb + 1]); pw.y = cvt_pk_bf16(s[hv][rb + 2], s[hv][rb + 3]); pw.z = cvt_pk_bf16(s[hv][rb + 4], s[hv][rb + 5]); pw.w = cvt_pk_bf16(s[hv][rb + 6], s[hv][rb + 7]);
            const bf16x8 pb = __builtin_bit_cast(bf16x8, pw);
#pragma unroll
            for (int dh = 0; dh < 2; ++dh) {
                const unsigned char* vp = (const unsigned char*)Z.Vt + dh * 4096 + (16 * c + 4 * hi + ((r32 & 15) >> 2)) * 64 + (r32 >> 4) * 32 + (r32 & 3) * 8;
                const s16x4 lo = lds_tr16(vp), hh = lds_tr16(vp + 8 * 64);
                const bf16x8 va = (bf16x8){lo[0], lo[1], lo[2], lo[3], hh[0], hh[1], hh[2], hh[3]};
                o[dh] = __builtin_amdgcn_mfma_f32_32x32x16_bf16(va, pb, o[dh], 0, 0, 0);
            }
        }
    }
    l += ps2.x + ps2.y;
}
__device__ __forceinline__ void attn_stage(const AttnLds& Z, const u32x4 kreg, const u32x4 vreg, int tid) {
    const int row = tid >> 3, chn = tid & 7;
    *(u32x4*)(Z.Ks + row * KS_PITCH + chn * 8) = kreg;
    *(u32x4*)((unsigned char*)Z.Vt + (chn >> 2) * 4096 + row * 64 + (chn & 3) * 16) = vreg;
}

__device__ __forceinline__ void attn_unit(const Args& A, int b, int hk, int qt, unsigned char* lds) {
    int tid = threadIdx.x; asm volatile("" : "+v"(tid));
    const int lane = tid & 63, w = tid >> 6, r32 = lane & 31, hi = lane >> 5, g = w >> 1, th = w & 1;
    AttnLds Z; Z.Ks = (bf16_t*)lds; Z.Vt = (bf16_t*)(lds + 9216); Z.IMP = (float*)(lds + 35840); Z.SC = (float*)(lds + 35840 + 32768); Z.SEL = (unsigned*)(lds + 35840 + 32768 + 8192);
    auto ZBf = [&](int q) -> AttnLds { AttnLds z = Z; z.Ks = (bf16_t*)(lds + q * 17920); z.Vt = (bf16_t*)(lds + q * 17920 + 9216); return z; };
    const bf16_t* PROJ = (const bf16_t*)(A.ws + WS_PROJ);
    const bf16_t* KCB = (const bf16_t*)(A.ws + WS_KCB); const bf16_t* VCB = (const bf16_t*)(A.ws + WS_VCB);
    bf16_t* YB = (bf16_t*)(A.ws + WS_YB);
    const int tokl = 32 * th + r32, spos = 64 * qt + tokl;
    const size_t trow = (size_t)b * SEQ + spos;
    const int head = hk * 4 + g;
    bf16x8 qf[4];
#pragma unroll
    for (int c = 0; c < 4; ++c) qf[c] = *(const bf16x8*)(PROJ + trow * LDP + C_Q + head * 64 + 16 * c + 8 * hi);
    float gate[3];
#pragma unroll
    for (int e = 0; e < 3; ++e) gate[e] = sigmoidf_(bf2f(PROJ[trow * LDP + C_NG + head * 3 + e]));
    f32x16 out[2], o[2];
    const f32x16 zero16 = (f32x16){0.f,0.f,0.f,0.f,0.f,0.f,0.f,0.f,0.f,0.f,0.f,0.f,0.f,0.f,0.f,0.f};
    out[0] = zero16; out[1] = zero16;
    const int srow = tid >> 3, schn = tid & 7;
    u32x4 kreg, vreg;
    float m, l;
    auto finish = [&](float gt) {
        const float lt = halves_sum(l);
        const float sc = lt > 0.f ? gt / lt : 0.f;
        out[0] += o[0] * sc; out[1] += o[1] * sc;
    };
    const int ncmp = 4 * qt + 3 < 127 ? 4 * qt + 3 : 127;
    const int ntl = (ncmp + 63) / 64;
    const bf16_t* kcb = KCB + (size_t)((b * 2 + hk) * 128) * 64; const bf16_t* vcb = VCB + (size_t)((b * 2 + hk) * 128) * 64;
    m = -1e30f; l = 0.f; o[0] = zero16; o[1] = zero16;
    kreg = *(const u32x4*)(kcb + srow * 64 + schn * 8); vreg = *(const u32x4*)(vcb + srow * 64 + schn * 8);
    attn_stage(ZBf(0), kreg, vreg, tid); __syncthreads();
    if (ntl > 1) { kreg = *(const u32x4*)(kcb + (64 + srow) * 64 + schn * 8); vreg = *(const u32x4*)(vcb + (64 + srow) * 64 + schn * 8); }
    for (int tl = 0; tl < ntl; ++tl) {
        if (tl + 1 < ntl) attn_stage(ZBf((tl + 1) & 1), kreg, vreg, tid);
        const int cb0 = 64 * tl;
        if (tl == 0 && qt >= 17) attn_step<false>(ZBf(tl & 1), qf, o, m, l, [&](int) { return true; }, true, r32, hi);
        else attn_step<true>(ZBf(tl & 1), qf, o, m, l, [&](int kvl) { const int c = cb0 + kvl; return (16 * c + 31 <= spos) && (c < 127); }, true, r32, hi);
        __syncthreads();
    }
    finish(gate[0]);
    unsigned selm, uni;
    if (qt >= 16) {
        const float lt = l + __shfl_xor(l, 32);
        const float linv = lt > 0.f ? 1.f / lt : 0.f;
        float carry = 0.f;
        kreg = *(const u32x4*)(kcb + srow * 64 + schn * 8);
        for (int tl = 0; tl < 2; ++tl) {
            __syncthreads(); *(u32x4*)(Z.Ks + srow * KS_PITCH + schn * 8) = kreg; __syncthreads();
            if (tl == 0) kreg = *(const u32x4*)(kcb + (64 + srow) * 64 + schn * 8);
#pragma unroll
            for (int hv = 0; hv < 2; ++hv) {
                f32x16 s = zero16;
#pragma unroll
                for (int c = 0; c < 4; ++c) { const bf16x8 kf = *(const bf16x8*)(Z.Ks + (32 * hv + r32) * KS_PITCH + 16 * c + 8 * hi); s = __builtin_amdgcn_mfma_f32_32x32x16_bf16(kf, qf[c], s, 0, 0, 0); }
#pragma unroll
                for (int gq = 0; gq < 4; ++gq) {
                    float pn[4];
#pragma unroll
                    for (int e = 0; e < 4; ++e) { const int c = 64 * tl + 32 * hv + 8 * gq + 4 * hi + e; const bool ok = (16 * c + 31 <= spos) && (c < 127); pn[e] = ok ? __builtin_amdgcn_exp2f(s[4 * gq + e] - m) * linv : 0.f; }
                    const float qsum = (pn[0] + pn[1]) + (pn[2] + pn[3]);
                    const float other_last = __shfl_xor(pn[3], 32);
                    const float extra = hi ? other_last : carry;
                    carry = other_last;
                    const int j = 16 * tl + 8 * hv + 2 * gq + hi;
                    Z.IMP[(g * 64 + tokl) * 32 + j] = qsum + extra;
                }
            }
        }
        __syncthreads();
        {
            const int tok = tid >> 3, jg = tid & 7;
            float sc4[4];
#pragma unroll
            for (int e = 0; e < 4; ++e) { const int j = 4 * jg + e;
                const float imp = (Z.IMP[(0 * 64 + tok) * 32 + j] + Z.IMP[(1 * 64 + tok) * 32 + j]) + (Z.IMP[(2 * 64 + tok) * 32 + j] + Z.IMP[(3 * 64 + tok) * 32 + j]);
                const bool forced = (j == 0) || (j == qt) || (j == qt - 1);
                sc4[e] = forced ? 1e4f : (j <= qt ? imp : -1.f); }
            *(f32x4*)(Z.SC + tok * 32 + 4 * jg) = (f32x4){sc4[0], sc4[1], sc4[2], sc4[3]};
            __syncthreads();
            int rank[4] = {0, 0, 0, 0};
#pragma unroll
            for (int i4 = 0; i4 < 8; ++i4) { const f32x4 v = *(const f32x4*)(Z.SC + tok * 32 + 4 * i4);
#pragma unroll
                for (int ie = 0; ie < 4; ++ie) { const int i = 4 * i4 + ie;
#pragma unroll
                    for (int e = 0; e < 4; ++e) { const int j = 4 * jg + e; rank[e] += (v[ie] > sc4[e] || (v[ie] == sc4[e] && i < j)) ? 1 : 0; } } }
            unsigned bits = 0u;
#pragma unroll
            for (int e = 0; e < 4; ++e) { const int j = 4 * jg + e; if (rank[e] < 16 && j <= qt) bits |= 1u << j; }
            bits |= __shfl_xor(bits, 1); bits |= __shfl_xor(bits, 2); bits |= __shfl_xor(bits, 4);
            if (jg == 0) Z.SEL[tok] = bits;
        }
        __syncthreads();
        selm = Z.SEL[tokl];
        unsigned u = Z.SEL[lane];
#pragma unroll
        for (int ofs = 1; ofs < 64; ofs <<= 1) u |= __shfl_xor(u, ofs);
        uni = u;
    } else { selm = (2u << qt) - 1u; uni = selm; }
    uni = __builtin_amdgcn_readfirstlane(uni);
    {
        const bf16_t* kb = PROJ + (size_t)b * SEQ * LDP + C_KS + hk * 64; const bf16_t* vb = PROJ + (size_t)b * SEQ * LDP + C_VS + hk * 64;
        m = -1e30f; l = 0.f; o[0] = zero16; o[1] = zero16;
        unsigned rem = uni;
        auto popb = [&]() -> int { if (!rem) return -1; const int q = __builtin_ctz(rem); rem &= rem - 1u; return q; };
        int j = popb(), jn = popb();
        kreg = *(const u32x4*)(kb + (size_t)(64 * j + srow) * LDP + schn * 8); vreg = *(const u32x4*)(vb + (size_t)(64 * j + srow) * LDP + schn * 8);
        attn_stage(ZBf(0), kreg, vreg, tid); __syncthreads();
        if (jn >= 0) { kreg = *(const u32x4*)(kb + (size_t)(64 * jn + srow) * LDP + schn * 8); vreg = *(const u32x4*)(vb + (size_t)(64 * jn + srow) * LDP + schn * 8); }
        int pb = 0;
        for (;;) {
            const int jnn = (jn >= 0) ? popb() : -1;
            if (jn >= 0) attn_stage(ZBf(pb ^ 1), kreg, vreg, tid);
            if (jnn >= 0) { kreg = *(const u32x4*)(kb + (size_t)(64 * jnn + srow) * LDP + schn * 8); vreg = *(const u32x4*)(vb + (size_t)(64 * jnn + srow) * LDP + schn * 8); }
            const bool sel = (selm >> j) & 1u; const int kv0 = 64 * j;
            if (j < qt) { if (__any(sel)) attn_step<false>(ZBf(pb), qf, o, m, l, [&](int) { return true; }, sel, r32, hi); }
            else attn_step<true>(ZBf(pb), qf, o, m, l, [&](int kvl) { return kv0 + kvl <= spos; }, sel, r32, hi);
            __syncthreads();
            if (jn < 0) break;
            j = jn; jn = jnn; pb ^= 1;
        }
        finish(gate[1]);
    }
    {
        const bf16_t* kb = PROJ + (size_t)b * SEQ * LDP + C_KW + hk * 64; const bf16_t* vb = PROJ + (size_t)b * SEQ * LDP + C_VW + hk * 64;
        m = -1e30f; l = 0.f; o[0] = zero16; o[1] = zero16;
        const int j0 = qt >= 8 ? qt - 8 : 0;
        kreg = *(const u32x4*)(kb + (size_t)(64 * j0 + srow) * LDP + schn * 8); vreg = *(const u32x4*)(vb + (size_t)(64 * j0 + srow) * LDP + schn * 8);
        attn_stage(ZBf(0), kreg, vreg, tid); __syncthreads();
        if (j0 < qt) { kreg = *(const u32x4*)(kb + (size_t)(64 * (j0 + 1) + srow) * LDP + schn * 8); vreg = *(const u32x4*)(vb + (size_t)(64 * (j0 + 1) + srow) * LDP + schn * 8); }
        for (int j = j0; j <= qt; ++j) {
            const int pb = (j - j0) & 1;
            if (j < qt) attn_stage(ZBf(pb ^ 1), kreg, vreg, tid);
            if (j + 2 <= qt) { kreg = *(const u32x4*)(kb + (size_t)(64 * (j + 2) + srow) * LDP + schn * 8); vreg = *(const u32x4*)(vb + (size_t)(64 * (j + 2) + srow) * LDP + schn * 8); }
            const int kv0 = 64 * j;
            if (j == qt || (qt >= 8 && j == qt - 8)) attn_step<true>(ZBf(pb), qf, o, m, l, [&](int kvl) { const int kp = kv0 + kvl; return (kp <= spos) && (kp > spos - 512); }, true, r32, hi);
            else attn_step<false>(ZBf(pb), qf, o, m, l, [&](int) { return true; }, true, r32, hi);
            __syncthreads();
        }
        finish(gate[2]);
    }
    bf16_t* yb = YB + trow * 512 + head * 64;
#pragma unroll
    for (int dh = 0; dh < 2; ++dh)
#pragma unroll
        for (int gq = 0; gq < 4; ++gq) {
            u32x2 wv; wv.x = cvt_pk_bf16(out[dh][4 * gq + 0], out[dh][4 * gq + 1]); wv.y = cvt_pk_bf16(out[dh][4 * gq + 2], out[dh][4 * gq + 3]);
            *(u32x2*)(yb + 32 * dh + 8 * gq + 4 * hi) = wv;
        }
    __syncthreads();
}

#define XB_TMO      128
#define XB_XCNT(j)  (256  + 64 * (j))
#define XB_XSUB(j)  (1280 + 64 * (j))
#define XB_XGEN(j)  (2304 + 64 * (j))
#define XB_TOP      3328
#define XB_TOPGEN   3392
#define XCD_BAR_WORDS 3456
#define XB_SPIN_CAP (1u << 18)

__device__ __forceinline__ unsigned xb_ld(unsigned* p)              { return __hip_atomic_load(p, __ATOMIC_RELAXED, __HIP_MEMORY_SCOPE_AGENT); }
__device__ __forceinline__ unsigned xb_add(unsigned* p, unsigned v) { return __hip_atomic_fetch_add(p, v, __ATOMIC_RELAXED, __HIP_MEMORY_SCOPE_AGENT); }
__device__ __forceinline__ unsigned xb_xcc_id() { return (unsigned)__builtin_amdgcn_s_getreg((3 << 11) | 20) & 0xFu; }
#define XB_SPIN(cond, bar) do { unsigned _sp = 0; while (cond) { __builtin_amdgcn_s_sleep(1); \
    if ((++_sp & 255u) == 0u) { if (xb_ld(&(bar)[XB_TMO])) break; if (_sp > XB_SPIN_CAP) { atomicAdd(&(bar)[XB_TMO], 1u); break; } } } } while (0)

struct XcdBarrier {
    unsigned* bar; unsigned x;
    volatile LAS unsigned* st;
};

__device__ __forceinline__ XcdBarrier xcd_barrier_post(unsigned* bar, volatile LAS unsigned* st) {
    XcdBarrier b; b.bar = bar; b.x = xb_xcc_id(); b.st = st;
    if (threadIdx.x == 0) (void)xb_add(&bar[XB_XCNT(b.x)], 1u);
    return b;
}
__device__ __forceinline__ void xcd_barrier_complete(unsigned* bar, unsigned x, unsigned& nloc, unsigned& nx) {
    const unsigned G = gridDim.x * gridDim.y * gridDim.z;
    unsigned sum, cnt, mine, sp = 0u;
    for (;;) {
        sum = 0u; cnt = 0u; mine = 0u;
#pragma unroll
        for (unsigned j = 0; j < 16; ++j) { const unsigned c = xb_ld(&bar[XB_XCNT(j)]); sum += c; cnt += (c > 0u) ? 1u : 0u; mine = (j == x) ? c : mine; }
        if (sum == G) break;
        __builtin_amdgcn_s_sleep(1);
        if ((++sp & 255u) == 0u) { if (xb_ld(&bar[XB_TMO])) break; if (sp > XB_SPIN_CAP) { atomicAdd(&bar[XB_TMO], 1u); break; } }
    }
    nloc = mine > 0u ? mine : 1u; nx = cnt > 0u ? cnt : 1u;
}

__device__ __forceinline__ void xcd_barrier(const XcdBarrier& b) {
    asm volatile("s_waitcnt vmcnt(0)" ::: "memory");
    __syncthreads();
    if (threadIdx.x == 0) {
        unsigned* bar = b.bar;
        __builtin_amdgcn_s_waitcnt(0);
        unsigned nloc = b.st[0], nx = b.st[1];
        if (nloc == 0u) { xcd_barrier_complete(bar, b.x, nloc, nx); b.st[0] = nloc; b.st[1] = nx; }
        const unsigned old = xb_add(&bar[XB_XSUB(b.x)], 1u);
        const unsigned gen = old / nloc;
        if (old + 1u == (gen + 1u) * nloc) {
            __builtin_amdgcn_fence(__ATOMIC_RELEASE, "agent");
            asm volatile("s_waitcnt vmcnt(0)" ::: "memory");
            const unsigned og = xb_add(&bar[XB_TOP], 1u);
            const unsigned tg = og / nx;
            if (og + 1u == (tg + 1u) * nx) xb_add(&bar[XB_TOPGEN], 1u);
            else XB_SPIN(xb_ld(&bar[XB_TOPGEN]) == tg, bar);
            __builtin_amdgcn_fence(__ATOMIC_ACQUIRE, "agent");
            xb_add(&bar[XB_XGEN(b.x)], 1u);
            asm volatile("s_waitcnt vmcnt(0)" ::: "memory");
        } else {
            XB_SPIN(xb_ld(&bar[XB_XGEN(b.x)]) == gen, bar);
            __builtin_amdgcn_fence(__ATOMIC_ACQUIRE, "agent");
            asm volatile("s_waitcnt vmcnt(0)" ::: "memory");
        }
    }
    __syncthreads();
}

__global__ void __launch_bounds__(NTHREADS) fwd_kernel(Args A) {
    extern __shared__ __attribute__((aligned(16))) unsigned char lds[];
    cg::grid_group grid = cg::this_grid();
    const int G = gridDim.x, bid = blockIdx.x;
    const int NGW = G * NWAVES, NGT = G * NTHREADS;
    LAS unsigned char* ldsl = (LAS unsigned char*)lds;
    volatile LAS unsigned* xst = (volatile LAS unsigned*)(ldsl + LDS_BYTES - 64);
    if (threadIdx.x < 16) xst[threadIdx.x] = 0u;
    __syncthreads();
    XcdBarrier xbar = xcd_barrier_post((unsigned*)(A.ws + WS_CTL) + 1024, xst);
    grid.sync();
#define GSYNC_CG() do { __threadfence(); grid.sync(); } while (0)
#define GSYNC() xcd_barrier(xbar)

#define WSP(name, off) bf16_t* name = (bf16_t*)(wsq + (off))
#define PHASE_BEGIN() unsigned char* wsq = A.ws; asm volatile("" : "+s"(wsq)); int tid = threadIdx.x; asm volatile("" : "+v"(tid)); const int lane = tid & 63, wave = __builtin_amdgcn_readfirstlane(tid >> 6); const int gw = bid * NWAVES + wave, gtid = bid * NTHREADS + tid; (void)lane; (void)gw; (void)gtid;
#define ALLPTRS() WSP(Win_t, WS_WIN); WSP(Wg_t, WS_WG); WSP(Wup_t, WS_WUP); WSP(Wdn_t, WS_WDN); WSP(Wo_t, WS_WO); WSP(Wpg_t, WS_WPG); WSP(Woa_t, WS_WOA); WSP(Wob_t, WS_WOB); \
    WSP(Wpp_t, WS_WPP); WSP(Wl2_t, WS_WL2); WSP(Wc1k_t, WS_WC1K); WSP(Wc1v_t, WS_WC1V); float* CB = (float*)(wsq + WS_CB); WSP(KCB, WS_KCB); WSP(VCB, WS_VCB); WSP(H12K, WS_H12K); WSP(H12V, WS_H12V); \
    WSP(PB, WS_PB); WSP(PROJ, WS_PROJ); WSP(LO, WS_LO); WSP(A2, WS_A2); WSP(YA, WS_YA); WSP(YB, WS_YB); WSP(SG, WS_SG); WSP(MB, WS_M); WSP(U2, WS_U2); WSP(ACT, WS_ACT); WSP(PP, WS_PP); \
    bf16_t* U = (bf16_t*)A.out; float* H = A.out; \
    (void)Win_t; (void)Wg_t; (void)Wup_t; (void)Wdn_t; (void)Wo_t; (void)Wpg_t; (void)Woa_t; (void)Wob_t; (void)Wpp_t; (void)Wl2_t; (void)Wc1k_t; (void)Wc1v_t; (void)CB; (void)KCB; (void)VCB; (void)H12K; (void)H12V; \
    (void)PB; (void)PROJ; (void)LO; (void)A2; (void)YA; (void)YB; (void)SG; (void)MB; (void)U2; (void)ACT; (void)PP; (void)U; (void)H;
    {
        PHASE_BEGIN(); ALLPTRS();
        float* scr = (float*)(lds + wave * 16384);
        { const float* w_in = A.in[I_WIN]; const float* w1 = A.in[I_W1]; const float* a1 = A.in[I_A1]; const float* g1 = A.in[I_G1]; const float* mu = A.in[I_MUWAG];
          tr_matrix([=](int k, int n) -> float {
              if (n < C_L1) { const float v = __builtin_nontemporal_load(w_in + (size_t)k * WIN_LD + n); return (n >= C_Q && n < C_KC) ? v * QSCALE : v; }
              if (n >= LDP) return 0.f;
              const bool second = n >= C_L2; const int i = n - (second ? C_L2 : C_L1);
              float v, mm;
              if (i < 64) { v = w1[k * 64 + i]; mm = mu[k]; } else if (i < 128) { v = a1[k * 64 + i - 64]; mm = mu[1024 + k]; } else { v = g1[k * 160 + i - 128]; mm = mu[2048 + k]; }
              return second ? v * mm : v * (1.f - mm);
          }, 1024, 3424, Win_t, scr, gw, NGW, lane);
          tr_matrix([=](int k, int n) -> float { return __builtin_nontemporal_load(w_in + (size_t)k * WIN_LD + C_L1 + n); }, 1024, 2048, Wg_t, scr, gw, NGW, lane); }
        { const float* w = A.in[I_WUP]; const float* g2 = A.in[I_LN2]; tr_matrix([=](int k, int n) -> float { const int pn = n >> 8, wq = n & 255; const int src = wq < 128 ? pn * 128 + wq : DFF + pn * 128 + (wq - 128); return __builtin_nontemporal_load(w + (size_t)k * 5632 + src) * g2[k]; }, 1024, 5632, Wup_t, scr, gw, NGW, lane); }
        { const float* w = A.in[I_WDN]; tr_matrix([=](int k, int n) -> float { return __builtin_nontemporal_load(w + (size_t)k * 1024 + n); }, 2816, 1024, Wdn_t, scr, gw, NGW, lane); }
        { const float* w = A.in[I_WO]; tr_matrix([=](int k, int n) -> float { return __builtin_nontemporal_load(w + (size_t)k * 1024 + n); }, 1024, 1024, Wo_t, scr, gw, NGW, lane); }
        { const float* w = A.in[I_WPG]; const float* g3 = A.in[I_LN3]; tr_matrix([=](int k, int n) -> float { return __builtin_nontemporal_load(w + (size_t)k * 1024 + n) * g3[k]; }, 1024, 1024, Wpg_t, scr, gw, NGW, lane); }
        { const float* w = A.in[I_WOA]; tr_matrix([=](int k, int n) -> float { return __builtin_nontemporal_load(w + (size_t)k * 1024 + n); }, 512, 1024, Woa_t, scr, gw, NGW, lane); }
        { const float* w = A.in[I_WOB]; tr_matrix([=](int k, int n) -> float { return __builtin_nontemporal_load(w + (size_t)k * 1024 + n); }, 512, 1024, Wob_t, scr, gw, NGW, lane); }
        { const float* w = A.in[I_WPP]; tr_matrix([=](int k, int n) -> float { return __builtin_nontemporal_load(w + (size_t)k * 1024 + n); }, 256, 1024, Wpp_t, scr, gw, NGW, lane); }
        { const float* w2 = A.in[I_W2]; const float* a2 = A.in[I_A2]; const float* g2 = A.in[I_G2];
          tr_matrix([=](int k, int n) -> float {
              if (n < 512) return k < 64 ? w2[k * 512 + n] : 0.f;
              if (n < 1024) return (k >= 64 && k < 128) ? a2[(k - 64) * 512 + n - 512] : 0.f;
              return (k >= 128 && k < 288) ? g2[(k - 128) * 512 + n - 1024] : 0.f;
          }, 384, 1536, Wl2_t, scr, gw, NGW, lane); }
        { const float* c1 = A.in[I_CW1];
          tr_matrix([=](int k, int n) -> float { return n < 128 ? c1[(size_t)k * 128 + n] : c1[(size_t)(1024 + k) * 128 + n - 128]; }, 1024, 256, Wc1k_t, scr, gw, NGW, lane);
          tr_matrix([=](int k, int n) -> float { return n < 128 ? c1[(size_t)(2048 + k) * 128 + n] : c1[(size_t)(2048 + 1024 + k) * 128 + n - 128]; }, 1024, 256, Wc1v_t, scr, gw, NGW, lane); }
        rms_rows<true, true>((float*)A.in[I_X], A.in[I_LN1], U, gw, NGW, lane);
        { const f32x4* p4 = (const f32x4*)A.in[I_P]; u32x2* o = (u32x2*)PB;
          for (int i0 = gtid; i0 < T * PLE / 4; i0 += 8 * NGT) { f32x4 v[8];
#pragma unroll
              for (int u = 0; u < 8; ++u) { const int i = i0 + u * NGT; if (i < T * PLE / 4) v[u] = __builtin_nontemporal_load(p4 + i); }
#pragma unroll
              for (int u = 0; u < 8; ++u) { const int i = i0 + u * NGT; if (i < T * PLE / 4) { u32x2 w; w.x = cvt_pk_bf16(v[u].x, v[u].y); w.y = cvt_pk_bf16(v[u].z, v[u].w); o[i] = w; } } } }
        {
            for (int it = gw; it < 2048; it += NGW) {
                const int o = it & 255, part = it >> 8, kv = o >> 7, n = o & 127; const float* pos = A.in[I_CPOS] + kv * 2048 + part * 256; const float* c1 = A.in[I_CW1] + ((size_t)kv * 2048 + part * 256) * 128;
                float s = 0.f;
#pragma unroll
                for (int q = 0; q < 4; ++q) { const int i = lane + 64 * q; s += pos[i] * c1[(size_t)i * 128 + n]; }
                s = wave_sum(s);
                if (lane == 0) CB[part * 256 + o] = s;
            }
        }
    }
    GSYNC();
    {
        PHASE_BEGIN(); ALLPTRS();
        pg8::Gemm g = pg8::mk_gemm(U, DM, Win_t, T, 5632, DM); pg8::StaticOrder S; S.init(T, 5632, G, bid);
        pg8::EpiProj E{PROJ, (unsigned char*)A.out + 64 * MiB};
        pg8::gemm_phase<pg8::EpiProj, true>(ldsl, g, S, E);
    }
    GSYNC();
    {
        PHASE_BEGIN(); ALLPTRS();
        {
            const int gt2 = gtid, NG2 = NGT;
            for (int i0 = gt2; i0 < T * 48; i0 += 4 * NG2) {
                u32x4 la[4], lb[4];
#pragma unroll
                for (int u = 0; u < 4; ++u) { const int i = i0 + u * NG2; la[u] = (u32x4){0u, 0u, 0u, 0u}; lb[u] = la[u];
                    if (i < T * 48) { const int t = i / 48, cg8 = (i % 48) * 8;
                        if (cg8 < 288) { la[u] = *(const u32x4*)(PROJ + (size_t)t * LDP + C_L1 + cg8); if ((t & (SEQ - 1)) != 0) lb[u] = *(const u32x4*)(PROJ + (size_t)(t - 1) * LDP + C_L2 + cg8); } } }
#pragma unroll
                for (int u = 0; u < 4; ++u) { const int i = i0 + u * NG2;
                    if (i < T * 48) { const int t = i / 48, cg8 = (i % 48) * 8;
                        u32x4 w = (u32x4){0u, 0u, 0u, 0u};
                        if (cg8 < 288) {
                            float a[8], bq[8]; unpack8(la[u], a); unpack8(lb[u], bq);
#pragma unroll
                            for (int e = 0; e < 8; ++e) a[e] += bq[e];
                            if (cg8 < 64) {
#pragma unroll
                                for (int e = 0; e < 8; ++e) a[e] = tanhf_(a[e]);
                            } else if (cg8 >= 128) {
#pragma unroll
                                for (int e = 0; e < 8; ++e) a[e] = sigmoidf_(a[e]);
                            }
                            w.x = cvt_pk_bf16(a[0], a[1]); w.y = cvt_pk_bf16(a[2], a[3]); w.z = cvt_pk_bf16(a[4], a[5]); w.w = cvt_pk_bf16(a[6], a[7]);
                        }
                        *(u32x4*)(A2 + (size_t)t * 384 + cg8) = w; } }
            }
        }
        __syncthreads();
        if (bid < 128) {
            const int isv = bid >> 6, sq = (bid >> 4) & 3;
            pg8::Gemm g; g.M = 4096; g.N = 256; g.K = 256; g.ldb = 1024; g.a_row = 16u * LDP * 2u; g.a_kstep = (size_t)LDP * 2; g.a_hstep = 128; g.a_tstep = (size_t)SEQ * LDP * 2;
            pg8::StaticOrder S; S.init(4096, 256, 16, bid & 15);
            g.A = PROJ + (isv ? C_VC : C_KC) + (size_t)(4 * sq) * LDP; g.Bt = (isv ? Wc1v_t : Wc1k_t) + 256 * sq;
            bf16_t* hdst = (bf16_t*)(wsq + WS_H12P) + (size_t)(isv * 4 + sq) * 4096 * 256;
            pg8::EpiB<0> E{hdst, 256, 256, nullptr, nullptr, nullptr, 0, nullptr}; pg8::gemm_phase<pg8::EpiB<0>, true>(ldsl, g, S, E);
        }
    }
    GSYNC();
    {
        PHASE_BEGIN(); ALLPTRS();
        {
            pg8::Gemm g = pg8::mk_gemm(A2, 384, Wl2_t, T, 1536, 384); pg8::StaticOrder S; S.init(T, 1536, G, bid);
            pg8::EpiB<2> E{LO, 1536, 1536, A.in[I_W0], A.in[I_A0], nullptr, 0, nullptr};
            pg8::gemm_phase<pg8::EpiB<2>, true>(ldsl, g, S, E);
        }
        const float* cw2 = A.in[I_CW2];
        for (int it = gw; it < 2 * 32 * 128; it += NGW) {
            const int kv = it >> 12, rowi = it & 4095, c = rowi & 127;
            bf16_t* dst = (kv ? VCB : KCB) + (size_t)rowi * 64;
            if (c == 127) { dst[lane] = 0; continue; }
            const bf16_t* Hm = (const bf16_t*)(wsq + WS_H12P) + (size_t)(kv * 4) * 4096 * 256;
            float cb0 = 0.f, cb1 = 0.f;
#pragma unroll
            for (int part = 0; part < 8; ++part) { cb0 += CB[part * 256 + kv * 128 + lane]; cb1 += CB[part * 256 + kv * 128 + 64 + lane]; }
            float h0 = cb0, h1 = cb1;
#pragma unroll
            for (int sq = 0; sq < 4; ++sq) { const bf16_t* Hs = Hm + (size_t)sq * 4096 * 256;
                h0 += bf2f(Hs[(size_t)rowi * 256 + lane]) + bf2f(Hs[(size_t)(rowi + 1) * 256 + 128 + lane]);
                h1 += bf2f(Hs[(size_t)rowi * 256 + 64 + lane]) + bf2f(Hs[(size_t)(rowi + 1) * 256 + 192 + lane]); }
            h0 = h0 * sigmoidf_(h0); h1 = h1 * sigmoidf_(h1);
            const float* w2 = cw2 + kv * 128 * 64;
            float acc = 0.f;
#pragma unroll 16
            for (int i = 0; i < 64; ++i) acc += __shfl(h0, i) * w2[i * 64 + lane];
#pragma unroll 16
            for (int i = 0; i < 64; ++i) acc += __shfl(h1, i) * w2[(64 + i) * 64 + lane];
            dst[lane] = (bf16_t)(cvt_pk_bf16(acc, 0.f) & 0xffffu);
        }
    }
    GSYNC();
    {
        PHASE_BEGIN(); ALLPTRS();
        if (bid < 128) scan_unit(A, bid, lds);
        unsigned* qheads = (unsigned*)(wsq + WS_CTL) + 6144;
        unsigned* slot = (unsigned*)(lds + 35840 + 32768 + 8192 + 512);
        const int myx = (int)(xb_xcc_id() & 7u);
        for (int qq = 0; qq < 8; ++qq) {
            const int q = (myx + qq) & 7;
            for (;;) {
                __syncthreads();
                if (tid == 0) *slot = atomicAdd(qheads + 64 * q, 1u);
                __syncthreads();
                const unsigned v = *slot;
                if (v >= 128u) break;
                const int qt = 31 - (int)(v >> 2), bh = 4 * q + (int)(v & 3);
                attn_unit(A, bh >> 1, bh & 1, qt, lds);
            }
        }
    }
    GSYNC();
    {
        PHASE_BEGIN(); ALLPTRS();
        pg8::StaticOrder S; S.init(T, 1024, G, bid);
        { pg8::Gemm g = pg8::mk_gemm(YA, 512, Woa_t, T, 1024, 512); pg8::EpiB<3> E{MB, 1024, 1024, nullptr, nullptr, (const bf16_t*)((const unsigned char*)A.out + 64 * MiB), 2048, nullptr}; pg8::gemm_phase<pg8::EpiB<3>, true>(ldsl, g, S, E); }
        asm volatile("s_waitcnt vmcnt(0)" ::: "memory"); __syncthreads();
        { pg8::Gemm g = pg8::mk_gemm(YB, 512, Wob_t, T, 1024, 512); pg8::EpiB<3> E{MB, 1024, 1024, nullptr, nullptr, (const bf16_t*)((const unsigned char*)A.out + 64 * MiB + 1024), 2048, MB}; pg8::gemm_phase<pg8::EpiB<3>, true>(ldsl, g, S, E); }
    }
    GSYNC();
    {
        PHASE_BEGIN(); ALLPTRS();
        pg8::Gemm g = pg8::mk_gemm(MB, 1024, Wo_t, T, 1024, 1024); pg8::StaticOrder S; S.init(T, 1024, G, bid);
        pg8::EpiFN<false> E{A.in[I_X], U2, 1024, (float*)(wsq + WS_PART)};
        pg8::gemm_phase<pg8::EpiFN<false>, true>(ldsl, g, S, E);
    }
    GSYNC();
    {
        PHASE_BEGIN(); ALLPTRS();
        pg8::Gemm g = pg8::mk_gemm(U2, DM, Wup_t, T, 5632, DM); pg8::StaticOrder S; S.init(T, 5632, G, bid);
        {
            const float* part = (const float*)(wsq + WS_PART); float* RS = (float*)(wsq + WS_RS); pg8::Unit uu; int lastpm = -1;
            for (int ui = 0; S.next(ui, uu); ++ui) { if (uu.pm == lastpm) continue; lastpm = uu.pm;
                if (tid < 256) { const int r = uu.pm * 256 + tid; float sum = 0.f;
#pragma unroll
                    for (int q = 0; q < 16; ++q) sum += part[(size_t)q * T + r];
                    RS[r] = 1.f / sqrtf(sum * (1.f / 1024.f) + 1e-6f); } }
            asm volatile("s_waitcnt vmcnt(0)" ::: "memory"); __syncthreads();
        }
        pg8::EpiGlu E{ACT, A.in[I_CONVW], A.in[I_CONVB], (float*)(wsq + WS_GH), (LAS float*)(ldsl + 131072), (const float*)(wsq + WS_RS)};
        pg8::gemm_phase<pg8::EpiGlu, true, true>(ldsl, g, S, E);
        {
            pg8::Gemm g2 = pg8::mk_gemm(PB, 256, Wpp_t, T, 1024, 256); pg8::StaticOrder S2; S2.init(T, 1024, G, bid);
            pg8::EpiB<0> E2{PP, 1024, 1024, nullptr, nullptr, nullptr, 0, nullptr};
            pg8::gemm_phase<pg8::EpiB<0>, true>(ldsl, g2, S2, E2);
        }
    }
    GSYNC();
    {
        PHASE_BEGIN(); ALLPTRS();
        pg8::Gemm g = pg8::mk_gemm(ACT, DFF, Wdn_t, T, 1024, DFF); pg8::StaticOrder S; S.init(T, 1024, G, bid);
        {
            const float* cw = A.in[I_CONVW]; const float* cb = A.in[I_CONVB]; const float* GH = (const float*)(wsq + WS_GH);
            pg8::Unit uu;
            for (int ui = 0; S.next(ui, uu); ++ui) {
                const int pm = uu.pm; if ((pm & 7) == 0) continue;
                for (int idx = tid; idx < 2 * DFF; idx += NTHREADS) {
                    const int row = idx / DFF, col = idx - row * DFF;
                    float xa[4], xb[4];
#pragma unroll
                    for (int q = 0; q < 4; ++q) { const int tp = q < 2 ? pm - 1 : pm, rr = q < 2 ? 2 + q : q - 2; xa[q] = GH[((size_t)(tp * 4 + rr) * 2 + 0) * DFF + col]; xb[q] = GH[((size_t)(tp * 4 + rr) * 2 + 1) * DFF + col]; }
                    const float a0 = row ? xa[1] : xa[0], a1 = row ? xa[2] : xa[1], a2 = row ? xa[3] : xa[2], b0 = row ? xb[1] : xb[0], b1 = row ? xb[2] : xb[1], b2 = row ? xb[3] : xb[2];
                    const float ha = cb[col] + cw[col] * a0 + cw[5632 + col] * a1 + cw[2 * 5632 + col] * a2;
                    const float hb = cb[DFF + col] + cw[DFF + col] * b0 + cw[5632 + DFF + col] * b1 + cw[2 * 5632 + DFF + col] * b2;
                    ACT[((size_t)pm * 256 + row) * DFF + col] = (bf16_t)(cvt_pk_bf16(ha * sigmoidf_(ha) * hb, 0.f) & 0xffffu);
                }
            }
            asm volatile("s_waitcnt vmcnt(0)" ::: "memory"); __syncthreads();
        }
        pg8::EpiFN<true> E{U2, U2, 1024, (float*)(wsq + WS_PART)};
        pg8::gemm_phase<pg8::EpiFN<true>, true>(ldsl, g, S, E);
    }
    GSYNC();
    {
        PHASE_BEGIN(); ALLPTRS();
        pg8::Gemm g = pg8::mk_gemm(U2, DM, Wpg_t, T, 1024, DM); pg8::StaticOrder S; S.init(T, 1024, G, bid);
        {
            const float* part = (const float*)(wsq + WS_PART); float* RS = (float*)(wsq + WS_RS); pg8::Unit uu; int lastpm = -1;
            for (int ui = 0; S.next(ui, uu); ++ui) { if (uu.pm == lastpm) continue; lastpm = uu.pm;
                if (tid < 256) { const int r = uu.pm * 256 + tid; float sum = 0.f;
#pragma unroll
                    for (int q = 0; q < 16; ++q) sum += part[(size_t)q * T + r];
                    RS[r] = 1.f / sqrtf(sum * (1.f / 1024.f) + 1e-6f); } }
            asm volatile("s_waitcnt vmcnt(0)" ::: "memory"); __syncthreads();
        }
        pg8::EpiFinal E{U2, H, 1024, PP, (const float*)(wsq + WS_RS), A.in[I_LNF], (float*)(wsq + WS_PART + 2 * MiB), (unsigned*)(wsq + WS_CTL + 32768), (LAS float*)(ldsl + 131072)};
        pg8::gemm_phase<pg8::EpiFinal, true>(ldsl, g, S, E);
    }
}

extern "C" void kernel_launch(void* const* d_in, const int* in_sizes, int n_in, void* d_out, int out_size, void* d_ws, size_t ws_size, hipStream_t stream) {
    static int grid = 0;
    if (grid == 0) {
        if (n_in != 34 || ws_size < WS_END) { fprintf(stderr, "kernel_launch: unexpected n_in %d / ws_size %zu\n", n_in, ws_size); grid = -1; return; }
        int dev = 0, cus = 0, per_cu = 0;
        hipGetDevice(&dev); hipDeviceGetAttribute(&cus, hipDeviceAttributeMultiprocessorCount, dev);
        hipFuncSetAttribute((const void*)fwd_kernel, hipFuncAttributeMaxDynamicSharedMemorySize, LDS_BYTES);
        hipOccupancyMaxActiveBlocksPerMultiprocessor(&per_cu, (const void*)fwd_kernel, NTHREADS, LDS_BYTES);
        if (per_cu < 1) { fprintf(stderr, "kernel_launch: occupancy query says %d\n", per_cu); per_cu = 1; }
        (void)hipGetLastError();
        grid = cus * 1;
        if (grid > 256) grid = 256;
    }
    if (grid < 0) return;
    hipMemsetAsync((char*)d_ws + WS_CTL, 0, 65536, stream);
    Args a{};
    for (int i = 0; i < 34; ++i) a.in[i] = (const float*)d_in[i];
    a.out = (float*)d_out; a.ws = (unsigned char*)d_ws;
    void* args[] = {&a};
    hipError_t e = hipLaunchCooperativeKernel((const void*)fwd_kernel, dim3(grid), dim3(NTHREADS), args, LDS_BYTES, stream);
    if (e != hipSuccess) fprintf(stderr, "cooperative launch failed: %s (grid %d)\n", hipGetErrorString(e), grid);
}
```

```cpp
#include <hip/hip_runtime.h>
#include <hip/hip_cooperative_groups.h>
#include <cstdio>
#include <cstdint>
namespace cg = cooperative_groups;

#define LAS __attribute__((address_space(3)))
typedef unsigned short bf16_t;
typedef short bf16x8 __attribute__((ext_vector_type(8)));
typedef short s16x4 __attribute__((ext_vector_type(4)));
typedef float f32x4 __attribute__((ext_vector_type(4)));
typedef float f32x2 __attribute__((ext_vector_type(2)));
typedef float f32x16 __attribute__((ext_vector_type(16)));
typedef unsigned u32x4 __attribute__((ext_vector_type(4)));
typedef unsigned u32x2 __attribute__((ext_vector_type(2)));

constexpr int T = 32768, SEQ = 2048, NBATCH = 16, DM = 1024, DFF = 2816, PLE = 256;
constexpr int LDP = 3416;
constexpr int C_R = 0, C_K = 512, C_V = 1024, C_Q = 1536, C_KC = 2048, C_VC = 2176, C_KS = 2304, C_VS = 2432, C_KW = 2560, C_VW = 2688, C_NG = 2816, C_L1 = 2840, C_L2 = 3128;
constexpr int WIN_LD = 4888;
constexpr float QSCALE = 0.125f * 1.4426950408889634f;
constexpr int NTHREADS = 512, NWAVES = 8;
constexpr int LDS_BYTES = 160768;

constexpr size_t MiB = 1u << 20, KiB = 1u << 10;
constexpr size_t WS_CTL = 0;
constexpr size_t WS_WIN = 1 * MiB, WS_WG = 8 * MiB, WS_WUP = 12 * MiB, WS_WDN = 23 * MiB, WS_WO = 29 * MiB, WS_WPG = 31 * MiB, WS_WOA = 33 * MiB, WS_WOB = 34 * MiB;
constexpr size_t WS_WPP = 35 * MiB, WS_WL2 = 35 * MiB + 512 * KiB, WS_WC1K = 36 * MiB + 768 * KiB, WS_WC1V = 37 * MiB + 256 * KiB, WS_CB = 37 * MiB + 768 * KiB;
constexpr size_t WS_KCB = 38 * MiB, WS_VCB = 38 * MiB + 512 * KiB, WS_H12K = 39 * MiB, WS_H12V = 41 * MiB, WS_PB = 43 * MiB;
constexpr size_t WS_PROJ = 59 * MiB, WS_LO = 273 * MiB, WS_A2 = 369 * MiB, WS_YA = 393 * MiB, WS_YB = 425 * MiB;
constexpr size_t WS_SG = 59 * MiB, WS_M = 187 * MiB, WS_U2 = 251 * MiB, WS_ACT = 59 * MiB, WS_PP = 315 * MiB, WS_H12P = 457 * MiB, WS_GH = 393 * MiB, WS_PART = 425 * MiB, WS_RS = 428 * MiB;
constexpr size_t WS_END = 491 * MiB;

__device__ __forceinline__ float bf2f(unsigned v) { return __uint_as_float(v << 16); }
typedef __bf16 bf16x2_t __attribute__((ext_vector_type(2)));
__device__ __forceinline__ unsigned cvt_pk_bf16(float lo, float hi) { const f32x2 v = {lo, hi}; const bf16x2_t b = __builtin_convertvector(v, bf16x2_t); return __builtin_bit_cast(unsigned, b); }
__device__ __forceinline__ float sigmoidf_(float x) { return __builtin_amdgcn_rcpf(1.f + __expf(-x)); }
__device__ __forceinline__ float tanhf_(float x) { return 1.f - 2.f * __builtin_amdgcn_rcpf(__expf(2.f * x) + 1.f); }
__device__ __forceinline__ void unpack8(const u32x4 w, float* f) {
    f[0] = bf2f(w.x & 0xffffu); f[1] = __uint_as_float(w.x & 0xffff0000u); f[2] = bf2f(w.y & 0xffffu); f[3] = __uint_as_float(w.y & 0xffff0000u);
    f[4] = bf2f(w.z & 0xffffu); f[5] = __uint_as_float(w.z & 0xffff0000u); f[6] = bf2f(w.w & 0xffffu); f[7] = __uint_as_float(w.w & 0xffff0000u);
}
__device__ __forceinline__ void unpack4(const u32x2 w, float* f) {
    f[0] = bf2f(w.x & 0xffffu); f[1] = __uint_as_float(w.x & 0xffff0000u); f[2] = bf2f(w.y & 0xffffu); f[3] = __uint_as_float(w.y & 0xffff0000u);
}
template <int CTRL> __device__ __forceinline__ float dpp_f(float x) { return __builtin_bit_cast(float, __builtin_amdgcn_update_dpp(0, __builtin_bit_cast(int, x), CTRL, 0xf, 0xf, true)); }
__device__ __forceinline__ float red8(float x) { x += dpp_f<0xB1>(x); x += dpp_f<0x4E>(x); x += dpp_f<0x141>(x); return x; }
__device__ __forceinline__ float red16(float x) { x = red8(x); x += dpp_f<0x140>(x); return x; }
__device__ __forceinline__ float wave_sum(float v) {
#pragma unroll
    for (int o = 1; o < 64; o <<= 1) v += __shfl_xor(v, o);
    return v;
}

namespace pg8 {
constexpr int BM = 256, BK = 64, HALF = 128, HTB = HALF * BK * 2, STAGE_BYTES = 8 * HTB, NXCD = 8, WGM = 4;
__host__ __device__ __forceinline__ int lds_byte(int r, int c) { const int st = (r >> 4) * 2 + (c >> 5), rr = r & 15, cc = c & 31, ob = rr * 64 + cc * 2; return st * 1024 + (ob ^ (((ob >> 9) & 1) << 5)); }
__host__ __device__ __forceinline__ void stage_rc(int b, int& R, int& C) { const int st = b / 1024, sb = b % 1024, swz = sb ^ (((sb >> 9) & 1) << 5); R = (st >> 1) * 16 + swz / 64; C = (st & 1) * 32 + (swz % 64) / 2; }
__host__ __device__ __forceinline__ int perm32(int rho) { const int n = rho >> 4, i = rho & 15; return 8 * (i >> 2) + 4 * n + (i & 3); }
struct Unit { int pm, pn; };
struct Gemm { const bf16_t* A; const bf16_t* Bt; int M, N, K; unsigned a_row; size_t a_kstep, a_hstep, a_tstep; int ldb; };
__device__ __forceinline__ Gemm mk_gemm(const bf16_t* A, int lda, const bf16_t* Bt, int M, int N, int K) {
    Gemm g; g.A = A; g.Bt = Bt; g.M = M; g.N = N; g.K = K; g.a_row = (unsigned)lda * 2u; g.a_kstep = 128; g.a_hstep = (size_t)HALF * lda * 2; g.a_tstep = 2 * g.a_hstep; g.ldb = K; return g;
}
struct StaticOrder {
    int nM, nN, nwg, G, c;
    __device__ __forceinline__ void init(int M, int N, int G_, int c_) { nM = M / BM; nN = N / BM; nwg = nM * nN; G = G_; c = c_; }
    __device__ __forceinline__ bool next(int i, Unit& u) const {
        const long L = (long)i * G + c; if (L >= nwg) return false;
        int wgid = (int)L; { const int q = nwg / NXCD, r = nwg % NXCD, xcd = wgid % NXCD, off = wgid / NXCD; wgid = (xcd < r ? xcd * (q + 1) : r * (q + 1) + (xcd - r) * q) + off; }
        const int nig = WGM * nN, gid = wgid / nig, fm = gid * WGM, gsz = (nM - fm) < WGM ? (nM - fm) : WGM;
        u.pm = fm + ((wgid % nig) % gsz); u.pn = (wgid % nig) / gsz; return true;
    }
};

template <int MODE> struct EpiB {
    static constexpr bool PERM = true;
    bf16_t* O; int ldc; int ncols; const float* bias; const float* bias2; const bf16_t* mul; int ldm; const bf16_t* add;
    __device__ __forceinline__ void operator()(const f32x4 (&acc)[2][2][4][2], const Unit& u, int wr, int wc, int fr, int fq) const {
        const int row0 = u.pm * BM + wr * 64 + fr, col0 = u.pn * BM + wc * 32 + 8 * fq;
#pragma unroll
        for (int ai = 0; ai < 2; ++ai)
#pragma unroll
            for (int m = 0; m < 4; ++m) {
                const size_t row = (size_t)(row0 + ai * HALF + m * 16);
#pragma unroll
                for (int bj = 0; bj < 2; ++bj) {
                    const int col = col0 + bj * HALF;
                    if (col < ncols) {
                        f32x4 v0 = acc[ai][bj][m][0], v1 = acc[ai][bj][m][1];
                        if (MODE == 1) {
                            unsigned q[8];
#pragma unroll
                            for (int e = 0; e < 4; ++e) { q[e] = (unsigned)(sigmoidf_(v0[e]) * 255.f + 0.5f); q[4 + e] = (unsigned)(sigmoidf_(v1[e]) * 255.f + 0.5f); }
                            u32x2 wq; wq.x = q[0] | (q[1] << 8) | (q[2] << 16) | (q[3] << 24); wq.y = q[4] | (q[5] << 8) | (q[6] << 16) | (q[7] << 24);
                            *(u32x2*)((unsigned char*)O + row * ldc + col) = wq;
                            continue;
                        }
                        if (MODE == 2) {
                            if (col < 1024) {
                                const float* bp = col < 512 ? bias + col : bias2 + (col - 512); const f32x4 b0 = *(const f32x4*)bp, b1 = *(const f32x4*)(bp + 4);
                                const float sc = col < 512 ? 0.6065306597f : 1.f;
#pragma unroll
                                for (int e = 0; e < 4; ++e) { v0[e] = sigmoidf_(v0[e] + b0[e]) * sc; v1[e] = sigmoidf_(v1[e] + b1[e]) * sc; }
                            }
                        }
                        if (MODE == 3) {
                            float mf[8]; { const u32x2 mq = *(const u32x2*)((const unsigned char*)mul + row * ldm + col);
#pragma unroll
                                for (int e = 0; e < 4; ++e) { mf[e] = (float)((mq.x >> (8 * e)) & 0xffu) * (1.f / 255.f); mf[4 + e] = (float)((mq.y >> (8 * e)) & 0xffu) * (1.f / 255.f); } }
#pragma unroll
                            for (int e = 0; e < 4; ++e) { v0[e] *= mf[e]; v1[e] *= mf[4 + e]; }
                            if (add) { float af[8]; unpack8(*(const u32x4*)(add + row * ldc + col), af);
#pragma unroll
                                for (int e = 0; e < 4; ++e) { v0[e] += af[e]; v1[e] += af[4 + e]; } }
                        }
                        u32x4 w; w.x = cvt_pk_bf16(v0[0], v0[1]); w.y = cvt_pk_bf16(v0[2], v0[3]); w.z = cvt_pk_bf16(v1[0], v1[1]); w.w = cvt_pk_bf16(v1[2], v1[3]);
                        *(u32x4*)(O + row * ldc + col) = w;
                    }
                }
            }
    }
};
struct EpiProj {
    static constexpr bool PERM = true;
    bf16_t* P; unsigned char* SG8;
    __device__ __forceinline__ void operator()(const f32x4 (&acc)[2][2][4][2], const Unit& u, int wr, int wc, int fr, int fq) const {
        const int row0 = u.pm * BM + wr * 64 + fr, col0 = u.pn * BM + wc * 32 + 8 * fq;
        const bool gates = u.pn >= 14;
#pragma unroll
        for (int ai = 0; ai < 2; ++ai)
#pragma unroll
            for (int m = 0; m < 4; ++m) {
                const size_t row = (size_t)(row0 + ai * HALF + m * 16);
#pragma unroll
                for (int bj = 0; bj < 2; ++bj) {
                    const int col = col0 + bj * HALF;
                    const f32x4 v0 = acc[ai][bj][m][0], v1 = acc[ai][bj][m][1];
                    if (gates) {
                        unsigned q[8];
#pragma unroll
                        for (int e = 0; e < 4; ++e) { q[e] = (unsigned)(sigmoidf_(v0[e]) * 255.f + 0.5f); q[4 + e] = (unsigned)(sigmoidf_(v1[e]) * 255.f + 0.5f); }
                        u32x2 wq; wq.x = q[0] | (q[1] << 8) | (q[2] << 16) | (q[3] << 24); wq.y = q[4] | (q[5] << 8) | (q[6] << 16) | (q[7] << 24);
                        *(u32x2*)(SG8 + row * 2048 + (col - 3584)) = wq;
                    } else if (col < LDP) {
                        u32x4 w; w.x = cvt_pk_bf16(v0[0], v0[1]); w.y = cvt_pk_bf16(v0[2], v0[3]); w.z = cvt_pk_bf16(v1[0], v1[1]); w.w = cvt_pk_bf16(v1[2], v1[3]);
                        *(u32x4*)(P + row * LDP + col) = w;
                    }
                }
            }
    }
};
template <int MODE> struct EpiF {
    static constexpr bool PERM = true;
    const float* base; float* out; int ldc; const bf16_t* pp; const float* rs;
    __device__ __forceinline__ void operator()(const f32x4 (&acc)[2][2][4][2], const Unit& u, int wr, int wc, int fr, int fq) const {
        const int row0 = u.pm * BM + wr * 64 + fr, col0 = u.pn * BM + wc * 32 + 8 * fq;
#pragma unroll
        for (int ai = 0; ai < 2; ++ai)
#pragma unroll
            for (int m = 0; m < 4; ++m) {
                const size_t row = (size_t)(row0 + ai * HALF + m * 16);
#pragma unroll
                for (int bj = 0; bj < 2; ++bj) {
                    const size_t off = row * ldc + col0 + bj * HALF;
                    f32x4 v0 = acc[ai][bj][m][0], v1 = acc[ai][bj][m][1];
                    if (MODE == 1) {
                        float pf[8]; unpack8(*(const u32x4*)(pp + off), pf); const float rr = rs[row];
#pragma unroll
                        for (int e = 0; e < 4; ++e) { v0[e] = sigmoidf_(v0[e] * rr) * pf[e]; v1[e] = sigmoidf_(v1[e] * rr) * pf[4 + e]; }
                    }
                    const f32x4 b0 = *(const f32x4*)(base + off), b1 = *(const f32x4*)(base + off + 4);
                    *(f32x4*)(out + off) = b0 + v0; *(f32x4*)(out + off + 4) = b1 + v1;
                }
                asm volatile("" ::: "memory");
            }
    }
};

template <bool BASEBF> struct EpiFN {
    static constexpr bool PERM = true;
    const void* base; bf16_t* hb; int ldc; float* part;
    __device__ __forceinline__ void operator()(const f32x4 (&acc)[2][2][4][2], const Unit& u, int wr, int wc, int fr, int fq) const {
        const int row0 = u.pm * BM + wr * 64 + fr, col0 = u.pn * BM + wc * 32 + 8 * fq;
        f32x4 bv[4][2][2]; u32x4 bw[4][2];
        auto fetch = [&](int gi) { const size_t row = (size_t)(row0 + (gi >> 2) * HALF + (gi & 3) * 16);
#pragma unroll
            for (int bj = 0; bj < 2; ++bj) { const size_t off = row * ldc + col0 + bj * HALF;
                if (BASEBF) bw[gi & 3][bj] = *(const u32x4*)((const bf16_t*)base + off);
                else { bv[gi & 3][bj][0] = *(const f32x4*)((const float*)base + off); bv[gi & 3][bj][1] = *(const f32x4*)((const float*)base + off + 4); } } };
        fetch(0); fetch(1); fetch(2);
#pragma unroll
        for (int gi = 0; gi < 8; ++gi) {
            const int ai = gi >> 2, m = gi & 3;
            if (gi + 3 < 8) fetch(gi + 3);
            const size_t row = (size_t)(row0 + ai * HALF + m * 16);
            float ss = 0.f;
#pragma unroll
            for (int bj = 0; bj < 2; ++bj) {
                const size_t off = row * ldc + col0 + bj * HALF;
                f32x4 o0, o1;
                if (BASEBF) { float bf[8]; unpack8(bw[gi & 3][bj], bf); o0 = (f32x4){bf[0], bf[1], bf[2], bf[3]} + acc[ai][bj][m][0]; o1 = (f32x4){bf[4], bf[5], bf[6], bf[7]} + acc[ai][bj][m][1]; }
                else { o0 = bv[gi & 3][bj][0] + acc[ai][bj][m][0]; o1 = bv[gi & 3][bj][1] + acc[ai][bj][m][1]; }
                ss += (o0[0] * o0[0] + o0[1] * o0[1]) + (o0[2] * o0[2] + o0[3] * o0[3]) + (o1[0] * o1[0] + o1[1] * o1[1]) + (o1[2] * o1[2] + o1[3] * o1[3]);
                u32x4 w; w.x = cvt_pk_bf16(o0[0], o0[1]); w.y = cvt_pk_bf16(o0[2], o0[3]); w.z = cvt_pk_bf16(o1[0], o1[1]); w.w = cvt_pk_bf16(o1[2], o1[3]);
                *(u32x4*)(hb + off) = w;
            }
            ss += __shfl_xor(ss, 16); ss += __shfl_xor(ss, 32);
            if (fq == 0) part[(size_t)(u.pn * 4 + wc) * T + row] = ss;
        }
    }
};
struct EpiFinal {
    static constexpr bool PERM = true;
    const bf16_t* base; float* out; int ldc; const bf16_t* pp; const float* rs; const float* gf; float* xch; unsigned* cnt; LAS float* lds;
    __device__ __forceinline__ void operator()(f32x4 (&acc)[2][2][4][2], const Unit& u, int wr, int wc, int fr, int fq) const {
        const int row0 = u.pm * BM + wr * 64 + fr, col0 = u.pn * BM + wc * 32 + 8 * fq;
        const int tid = threadIdx.x;
        LAS float* P = lds;
        LAS float* S = lds + 1024;
        u32x4 bv[2][2]; u32x4 pv[2][2]; float rrv[2];
        auto fetch = [&](int gi) { const int rl = (gi >> 2) * HALF + wr * 64 + (gi & 3) * 16 + fr; const size_t row = (size_t)u.pm * BM + rl; rrv[gi & 1] = rs[row];
#pragma unroll
            for (int bj = 0; bj < 2; ++bj) { const size_t off = row * ldc + col0 + bj * HALF; bv[gi & 1][bj] = *(const u32x4*)(base + off); pv[gi & 1][bj] = *(const u32x4*)(pp + off); } };
        fetch(0);
#pragma unroll
        for (int gi = 0; gi < 8; ++gi) {
            const int ai = gi >> 2, m = gi & 3;
            if (gi + 1 < 8) fetch(gi + 1);
            const int rl = ai * HALF + wr * 64 + m * 16 + fr;
            const float rr = rrv[gi & 1];
            float ss = 0.f;
#pragma unroll
            for (int bj = 0; bj < 2; ++bj) {
                float pf[8]; unpack8(pv[gi & 1][bj], pf);
                float bfv[8]; unpack8(bv[gi & 1][bj], bfv); const f32x4 b0 = (f32x4){bfv[0], bfv[1], bfv[2], bfv[3]}, b1 = (f32x4){bfv[4], bfv[5], bfv[6], bfv[7]};
                f32x4 v0 = acc[ai][bj][m][0], v1 = acc[ai][bj][m][1];
#pragma unroll
                for (int e = 0; e < 4; ++e) { v0[e] = b0[e] + sigmoidf_(v0[e] * rr) * pf[e]; v1[e] = b1[e] + sigmoidf_(v1[e] * rr) * pf[4 + e]; }
                acc[ai][bj][m][0] = v0; acc[ai][bj][m][1] = v1;
                ss += (v0[0] * v0[0] + v0[1] * v0[1]) + (v0[2] * v0[2] + v0[3] * v0[3]) + (v1[0] * v1[0] + v1[1] * v1[1]) + (v1[2] * v1[2] + v1[3] * v1[3]);
            }
            ss += __shfl_xor(ss, 16); ss += __shfl_xor(ss, 32);
            if (fq == 0) P[rl * 4 + wc] = ss;
        }
        (void)row0;
        asm volatile("s_waitcnt lgkmcnt(0)" ::: "memory"); __builtin_amdgcn_s_barrier(); asm volatile("" ::: "memory");
        if (tid < 256) { const float sp = (P[tid * 4] + P[tid * 4 + 1]) + (P[tid * 4 + 2] + P[tid * 4 + 3]);
            __hip_atomic_store(xch + ((size_t)(u.pm * 4 + u.pn) * 256 + tid), sp, __ATOMIC_RELAXED, __HIP_MEMORY_SCOPE_AGENT); }
        asm volatile("s_waitcnt vmcnt(0)" ::: "memory"); __builtin_amdgcn_s_barrier(); asm volatile("" ::: "memory");
        if (tid == 0) {
            unsigned* c = cnt + 64 * u.pm;
            __hip_atomic_fetch_add(c, 1u, __ATOMIC_RELEASE, __HIP_MEMORY_SCOPE_AGENT);
            unsigned spin = 0;
            while (__hip_atomic_load(c, __ATOMIC_RELAXED, __HIP_MEMORY_SCOPE_AGENT) < 4u) { __builtin_amdgcn_s_sleep(2); if (++spin > (1u << 22)) break; }
            __builtin_amdgcn_fence(__ATOMIC_ACQUIRE, "agent");
            asm volatile("s_waitcnt vmcnt(0)" ::: "memory");
        }
        __builtin_amdgcn_s_barrier(); asm volatile("" ::: "memory");
        if (tid < 256) { float tot = 0.f;
#pragma unroll
            for (int q = 0; q < 4; ++q) tot += __hip_atomic_load(xch + ((size_t)(u.pm * 4 + q) * 256 + tid), __ATOMIC_RELAXED, __HIP_MEMORY_SCOPE_AGENT);
            S[tid] = 1.f / sqrtf(tot * (1.f / 1024.f) + 1e-6f); }
        asm volatile("s_waitcnt vmcnt(0) lgkmcnt(0)" ::: "memory"); __builtin_amdgcn_s_barrier(); asm volatile("" ::: "memory");
        f32x4 gv[2][2];
#pragma unroll
        for (int bj = 0; bj < 2; ++bj) { gv[bj][0] = *(const f32x4*)(gf + col0 + bj * HALF); gv[bj][1] = *(const f32x4*)(gf + col0 + bj * HALF + 4); }
#pragma unroll
        for (int ai = 0; ai < 2; ++ai)
#pragma unroll
            for (int m = 0; m < 4; ++m) {
                const int rl = ai * HALF + wr * 64 + m * 16 + fr;
                const size_t row = (size_t)u.pm * BM + rl;
                const float sr = S[rl];
#pragma unroll
                for (int bj = 0; bj < 2; ++bj) { const size_t off = row * ldc + col0 + bj * HALF;
                    *(f32x4*)(out + off) = acc[ai][bj][m][0] * sr * gv[bj][0]; *(f32x4*)(out + off + 4) = acc[ai][bj][m][1] * sr * gv[bj][1]; }
            }
        asm volatile("s_waitcnt lgkmcnt(0)" ::: "memory"); __builtin_amdgcn_s_barrier(); asm volatile("" ::: "memory");
    }
};
struct EpiGlu {
    static constexpr bool PERM = true;
    bf16_t* ACT; const float* cw; const float* cb; float* GH; LAS float* halo; const float* rs;
    __device__ __forceinline__ void operator()(const f32x4 (&accr)[2][2][4][2], const Unit& u, int wr, int wc, int fr, int fq) const {
        const int colp = u.pn * 128 + wc * 32 + fq * 8;
        f32x4 acc[2][2][4][2];
        { const size_t tk = (size_t)u.pm * BM + 8 * (16 * wr + fr); const f32x4 r0 = *(const f32x4*)(rs + tk), r1 = *(const f32x4*)(rs + tk + 4);
#pragma unroll
          for (int ai = 0; ai < 2; ++ai)
#pragma unroll
              for (int m = 0; m < 4; ++m) { const float rr = ai ? r1[m] : r0[m];
#pragma unroll
                  for (int bj = 0; bj < 2; ++bj) { acc[ai][bj][m][0] = accr[ai][bj][m][0] * rr; acc[ai][bj][m][1] = accr[ai][bj][m][1] * rr; } } }
        if (wr == 0 && fr == 15) {
#pragma unroll
            for (int bj = 0; bj < 2; ++bj)
#pragma unroll
                for (int jj = 0; jj < 2; ++jj) { LAS float* h = halo + (((wc * 4 + fq) * 2 + bj) * 2 + jj) * 8; *(LAS f32x4*)h = acc[1][bj][2 + jj][0]; *(LAS f32x4*)(h + 4) = acc[1][bj][2 + jj][1]; }
        }
        if (wr == 0 && fr == 0) {
#pragma unroll
            for (int bj = 0; bj < 2; ++bj)
#pragma unroll
                for (int jj = 0; jj < 2; ++jj) { float* gp = GH + ((size_t)(u.pm * 4 + jj) * 2 + bj) * DFF + colp; *(f32x4*)gp = acc[0][bj][jj][0]; *(f32x4*)(gp + 4) = acc[0][bj][jj][1]; }
        }
        if (wr == 1 && fr == 15) {
#pragma unroll
            for (int bj = 0; bj < 2; ++bj)
#pragma unroll
                for (int jj = 0; jj < 2; ++jj) { float* gp = GH + ((size_t)(u.pm * 4 + 2 + jj) * 2 + bj) * DFF + colp; *(f32x4*)gp = acc[1][bj][2 + jj][0]; *(f32x4*)(gp + 4) = acc[1][bj][2 + jj][1]; }
        }
        asm volatile("s_waitcnt lgkmcnt(0)" ::: "memory"); __builtin_amdgcn_s_barrier(); asm volatile("" ::: "memory");
        const size_t tok0 = (size_t)u.pm * BM + 8 * (16 * wr + fr);
#pragma unroll
        for (int n = 0; n < 2; ++n) {
            f32x4 xm1[2], xm2[2];
#pragma unroll
            for (int bj = 0; bj < 2; ++bj) {
#pragma unroll
                for (int e = 0; e < 4; ++e) { xm1[bj][e] = dpp_f<0x111>(acc[1][bj][3][n][e]); xm2[bj][e] = dpp_f<0x111>(acc[1][bj][2][n][e]); }
                if (fr == 0) {
                    if (wr == 1) { const LAS float* h = halo + (((wc * 4 + fq) * 2 + bj) * 2) * 8 + 4 * n; xm2[bj] = *(const LAS f32x4*)h; xm1[bj] = *(const LAS f32x4*)(h + 8); }
                    else { xm1[bj] = (f32x4){0.f, 0.f, 0.f, 0.f}; xm2[bj] = xm1[bj]; }
                }
            }
            const int c0 = colp + 4 * n;
            const f32x4 wa0 = *(const f32x4*)(cw + c0), wa1 = *(const f32x4*)(cw + 5632 + c0), wa2 = *(const f32x4*)(cw + 2 * 5632 + c0), ba = *(const f32x4*)(cb + c0);
            const f32x4 wb0 = *(const f32x4*)(cw + DFF + c0), wb1 = *(const f32x4*)(cw + 5632 + DFF + c0), wb2 = *(const f32x4*)(cw + 2 * 5632 + DFF + c0), bb = *(const f32x4*)(cb + DFF + c0);
#pragma unroll
            for (int j = 0; j < 8; ++j) {
                const f32x4 xa = acc[j >> 2][0][j & 3][n], xb = acc[j >> 2][1][j & 3][n];
                const f32x4 ha = ba + wa0 * xm2[0] + wa1 * xm1[0] + wa2 * xa, hb = bb + wb0 * xm2[1] + wb1 * xm1[1] + wb2 * xb;
                float o[4];
#pragma unroll
                for (int e = 0; e < 4; ++e) o[e] = ha[e] * sigmoidf_(ha[e]) * hb[e];
                u32x2 w; w.x = cvt_pk_bf16(o[0], o[1]); w.y = cvt_pk_bf16(o[2], o[3]);
                *(u32x2*)(ACT + (tok0 + j) * DFF + c0) = w;
                xm2[0] = xm1[0]; xm1[0] = xa; xm2[1] = xm1[1]; xm1[1] = xb;
            }
        }
    }
};

template <class Epi, bool ALIGN_EPI, bool ROWPERM = false>
__device__ __forceinline__ void gemm_phase(LAS unsigned char* lds, const Gemm g, const StaticOrder& S, const Epi& E) {
    int tid = threadIdx.x; asm volatile("" : "+v"(tid));
    const int wid = __builtin_amdgcn_readfirstlane(tid >> 6), lane = tid & 63, wr = wid >> 2, wc = wid & 3, fr = lane & 15, fq = lane >> 4;
    const int K = g.K, nt = K / BK;
    unsigned voffA[2], voffA1[2], voffB[2];
#pragma unroll
    for (int i = 0; i < 2; ++i) { int R, C; stage_rc(tid * 16 + i * 8192, R, C); const int Rb = Epi::PERM ? ((R & ~31) + perm32(R & 31)) : R;
        if constexpr (ROWPERM) { const int tau0 = 8 * (16 * (R >> 6) + (R & 15)) + ((R >> 4) & 3);
            voffA[i] = (unsigned)tau0 * g.a_row + (unsigned)C * 2u; voffA1[i] = (unsigned)(tau0 + 4) * g.a_row + (unsigned)C * 2u; }
        else { voffA[i] = (unsigned)R * g.a_row + (unsigned)C * 2u; voffA1[i] = 0u; }
        voffB[i] = (unsigned)(Rb * g.ldb + C) * 2u; }
#define PG8_STAGE_A1(bufoff, gbase) do { if constexpr (ROWPERM) { PG8_STAGE(bufoff, gbase, voffA1); } else { PG8_STAGE(bufoff, (gbase) + ahstep, voffA); } } while (0)
    const size_t akstep = g.a_kstep, ahstep = g.a_hstep, atstep = g.a_tstep;
    const size_t bkstep = (size_t)(BK * 2), bhstep = (size_t)HALF * g.ldb * 2, btstep = 2 * bhstep;
    const unsigned ldsw = (unsigned)wid * 1024u;
    const int aoff = lds_byte(wr * 64 + fr, fq * 8), boff = lds_byte(wc * 32 + fr, fq * 8);
#define PG8_SA(b, h) (((b) * 2 + (h)) * HTB)
#define PG8_SB(b, h) ((4 + (b) * 2 + (h)) * HTB)
#define PG8_STAGE(bufoff, gbase, voff) do { _Pragma("unroll") for (int _i = 0; _i < 2; ++_i) \
        __builtin_amdgcn_global_load_lds((const unsigned*)((const char*)(gbase) + (voff)[_i]), (LAS unsigned*)(lds + (bufoff) + ldsw + _i * 8192), 16, 0, 0); } while (0)
#define PG8_LDA(dst, b, h) do { _Pragma("unroll") for (int m = 0; m < 4; ++m) _Pragma("unroll") for (int k = 0; k < 2; ++k) dst[m][k] = *(const LAS bf16x8*)(lds + PG8_SA(b, h) + aoff + m * 2048 + k * 1024); } while (0)
#define PG8_LDB(dst, b, h) do { _Pragma("unroll") for (int n = 0; n < 2; ++n) _Pragma("unroll") for (int k = 0; k < 2; ++k) dst[n][k] = *(const LAS bf16x8*)(lds + PG8_SB(b, h) + boff + n * 2048 + k * 1024); } while (0)
#define PG8_MMA(ai, bj, At, Bt) do { __builtin_amdgcn_s_setprio(1); _Pragma("unroll") for (int m = 0; m < 4; ++m) _Pragma("unroll") for (int n = 0; n < 2; ++n) _Pragma("unroll") for (int k = 0; k < 2; ++k) \
        acc[ai][bj][m][n] = __builtin_amdgcn_mfma_f32_16x16x32_bf16(Bt[n][k], At[m][k], acc[ai][bj][m][n], 0, 0, 0); __builtin_amdgcn_s_setprio(0); } while (0)
#define PG8_WAIT_V(n) asm volatile("s_waitcnt vmcnt(" #n ")" ::: "memory")
#define PG8_WAIT_L(n) asm volatile("s_waitcnt lgkmcnt(" #n ")" ::: "memory")
#define PG8_BAR __builtin_amdgcn_s_barrier()
#define PG8_SCHED __builtin_amdgcn_sched_barrier(0)
    Unit cur, nxt; int ui = 0;
    if (!S.next(0, cur)) return;
    f32x4 acc[2][2][4][2];
#pragma unroll
    for (int a = 0; a < 2; ++a)
#pragma unroll
        for (int b = 0; b < 2; ++b)
#pragma unroll
            for (int m = 0; m < 4; ++m)
#pragma unroll
                for (int n = 0; n < 2; ++n) acc[a][b][m][n] = (f32x4){0.f, 0.f, 0.f, 0.f};
    bf16x8 At[4][2], B0[2][2], B1[2][2];
    const char* cA = (const char*)g.A + (size_t)cur.pm * atstep; const char* cB = (const char*)g.Bt + (size_t)cur.pn * btstep;
    PG8_STAGE(PG8_SB(0, 0), cB, voffB); PG8_STAGE(PG8_SB(0, 1), cB + bhstep, voffB); PG8_STAGE(PG8_SA(0, 0), cA, voffA); PG8_STAGE_A1(PG8_SA(0, 1), cA);
    if (wr == 1) PG8_BAR;
    PG8_WAIT_V(2); PG8_BAR;
    PG8_STAGE(PG8_SB(1, 0), cB + bkstep, voffB); PG8_STAGE(PG8_SA(1, 0), cA + akstep, voffA); PG8_STAGE(PG8_SB(1, 1), cB + bhstep + bkstep, voffB);
    PG8_WAIT_V(6); PG8_BAR;
    for (;;) {
        const bool has_next = S.next(ui + 1, nxt);
        const char* nA = has_next ? (const char*)g.A + (size_t)nxt.pm * atstep : cA; const char* nB = has_next ? (const char*)g.Bt + (size_t)nxt.pn * btstep : cB;
        for (int t = 0; t < nt; t += 2) {
            const bool last = (t == nt - 2);
            const char* a1 = cA + (size_t)(t + 1) * akstep;
            const char* a2 = last ? nA : cA + (size_t)(t + 2) * akstep; const char* b2 = last ? nB : cB + (size_t)(t + 2) * bkstep;
            const char* a3 = a2 + akstep; const char* b3 = b2 + bkstep;
            PG8_LDB(B0, 0, 0); PG8_LDB(B1, 0, 1); PG8_SCHED; PG8_LDA(At, 0, 0); PG8_STAGE_A1(PG8_SA(1, 1), a1);
            PG8_WAIT_V(8); PG8_WAIT_L(0); PG8_BAR; PG8_MMA(0, 0, At, B0); PG8_MMA(0, 1, At, B1); PG8_BAR; PG8_SCHED;
            PG8_LDA(At, 0, 1); PG8_STAGE(PG8_SB(0, 0), b2, voffB); PG8_STAGE(PG8_SB(0, 1), b2 + bhstep, voffB); PG8_STAGE(PG8_SA(0, 0), a2, voffA);
            PG8_WAIT_V(8); PG8_WAIT_L(0); PG8_BAR; PG8_MMA(1, 0, At, B0); PG8_MMA(1, 1, At, B1); PG8_BAR; PG8_SCHED;
            PG8_LDB(B0, 1, 0); PG8_LDB(B1, 1, 1); PG8_SCHED; PG8_LDA(At, 1, 0); PG8_STAGE_A1(PG8_SA(0, 1), a2);
            PG8_WAIT_V(8); PG8_WAIT_L(0); PG8_BAR; PG8_MMA(0, 0, At, B0); PG8_MMA(0, 1, At, B1); PG8_BAR; PG8_SCHED;
            PG8_LDA(At, 1, 1); PG8_STAGE(PG8_SB(1, 0), b3, voffB); PG8_STAGE(PG8_SB(1, 1), b3 + bhstep, voffB); PG8_STAGE(PG8_SA(1, 0), a3, voffA);
            PG8_WAIT_V(8); PG8_WAIT_L(0); PG8_BAR; PG8_MMA(1, 0, At, B0); PG8_MMA(1, 1, At, B1); PG8_BAR; PG8_SCHED;
        }
        if constexpr (ALIGN_EPI) { if (wr == 0) PG8_BAR; }
        E(acc, cur, wr, wc, fr, fq);
        if (!has_next) break;
#pragma unroll
        for (int a = 0; a < 2; ++a)
#pragma unroll
            for (int b = 0; b < 2; ++b)
#pragma unroll
                for (int m = 0; m < 4; ++m)
#pragma unroll
                    for (int n = 0; n < 2; ++n) acc[a][b][m][n] = (f32x4){0.f, 0.f, 0.f, 0.f};
        cur = nxt; cA = nA; cB = nB; ++ui;
        if constexpr (ALIGN_EPI) { if (wr == 1) PG8_BAR; }
    }
    PG8_WAIT_V(0);
    if constexpr (!ALIGN_EPI) { if (wr == 0) PG8_BAR; }
    PG8_BAR;
#undef PG8_SA
#undef PG8_SB
#undef PG8_STAGE
#undef PG8_STAGE_A1
#undef PG8_LDA
#undef PG8_LDB
#undef PG8_MMA
#undef PG8_WAIT_V
#undef PG8_WAIT_L
#undef PG8_BAR
#undef PG8_SCHED
}
}

struct Args {
    const float* in[34];
    float* out; unsigned char* ws;
};
enum { I_X = 0, I_P, I_LN1, I_WIN, I_MURKV, I_MUWAG, I_W0, I_W1, I_W2, I_A0, I_A1, I_A2, I_G1, I_G2, I_KK, I_KA, I_RK, I_LNXG, I_LNXB, I_CPOS, I_CW1, I_CW2,
       I_WOA, I_WOB, I_WO, I_LN2, I_WUP, I_CONVW, I_CONVB, I_WDN, I_LN3, I_WPG, I_WPP, I_LNF };

template <class F> __device__ __forceinline__ void tr_matrix(F f, int Kd, int Nd, bf16_t* WT, float* scr, int gw, int NGW, int lane) {
    const int nblk = Nd / 32, nitems = (Kd / 64) * nblk;
    for (int item = gw; item < nitems; item += NGW) {
        const int kb = item / nblk, nb = item % nblk, k0 = 64 * kb, n0 = 32 * nb;
#pragma unroll 16
        for (int i = 0; i < 32; ++i) { const int kk = 2 * i + (lane >> 5); scr[kk * 33 + (lane & 31)] = f(k0 + kk, n0 + (lane & 31)); }
        asm volatile("s_waitcnt lgkmcnt(0)" ::: "memory");
        const int c = lane & 7;
#pragma unroll
        for (int j = 0; j < 4; ++j) { const int n = (lane >> 3) + 8 * j; const float* s = scr + (8 * c) * 33 + n;
            u32x4 o; o.x = cvt_pk_bf16(s[0 * 33], s[1 * 33]); o.y = cvt_pk_bf16(s[2 * 33], s[3 * 33]); o.z = cvt_pk_bf16(s[4 * 33], s[5 * 33]); o.w = cvt_pk_bf16(s[6 * 33], s[7 * 33]);
            *(u32x4*)(WT + (size_t)(n0 + n) * Kd + k0 + 8 * c) = o; }
        asm volatile("s_waitcnt lgkmcnt(0)" ::: "memory");
    }
}
template <bool OUT_BF16, bool NT = false> __device__ __forceinline__ void rms_rows(float* x, const float* g, bf16_t* ob, int gw, int NGW, int lane) {
    const f32x4* gr = (const f32x4*)g + lane;
    f32x4 gg[4];
#pragma unroll
    for (int j = 0; j < 4; ++j) gg[j] = gr[64 * j];
    for (int r0 = gw; r0 < T; r0 += 4 * NGW) {
        f32x4 v[4][4];
#pragma unroll
        for (int u = 0; u < 4; ++u) { const int r = r0 + u * NGW; if (r < T) { const f32x4* xr = (const f32x4*)(x + (size_t)r * DM) + lane;
#pragma unroll
            for (int j = 0; j < 4; ++j) v[u][j] = NT ? __builtin_nontemporal_load(xr + 64 * j) : xr[64 * j]; } }
#pragma unroll
        for (int u = 0; u < 4; ++u) { const int r = r0 + u * NGW; if (r < T) {
            float s = 0.f;
#pragma unroll
            for (int j = 0; j < 4; ++j) s += (v[u][j].x * v[u][j].x + v[u][j].y * v[u][j].y) + (v[u][j].z * v[u][j].z + v[u][j].w * v[u][j].w);
            const float rs = 1.f / sqrtf(wave_sum(s) * (1.f / 1024.f) + 1e-6f);
            if (OUT_BF16) { u32x2* o8 = (u32x2*)(ob + (size_t)r * DM) + lane;
#pragma unroll
                for (int j = 0; j < 4; ++j) { u32x2 w; w.x = cvt_pk_bf16(v[u][j].x * rs * gg[j].x, v[u][j].y * rs * gg[j].y); w.y = cvt_pk_bf16(v[u][j].z * rs * gg[j].z, v[u][j].w * rs * gg[j].w); o8[64 * j] = w; }
            } else { f32x4* xr = (f32x4*)(x + (size_t)r * DM) + lane;
#pragma unroll
                for (int j = 0; j < 4; ++j) xr[64 * j] = v[u][j] * rs * gg[j]; }
        } }
    }
}

__device__ __forceinline__ bf16x8 afrag(const bf16_t* base, int pitch, int row, int kofs, int hi) {
    const bf16_t* p = base + row * pitch + kofs + 4 * hi;
    const s16x4 lo = *(const s16x4*)p, hh = *(const s16x4*)(p + 8);
    return (bf16x8){lo[0], lo[1], lo[2], lo[3], hh[0], hh[1], hh[2], hh[3]};
}
__device__ __forceinline__ bf16x8 pack8(const f32x16& a, int b) {
    u32x4 w; w.x = cvt_pk_bf16(a[b + 0], a[b + 1]); w.y = cvt_pk_bf16(a[b + 2], a[b + 3]); w.z = cvt_pk_bf16(a[b + 4], a[b + 5]); w.w = cvt_pk_bf16(a[b + 6], a[b + 7]);
    return __builtin_bit_cast(bf16x8, w);
}
#define LBAR() asm volatile("s_waitcnt lgkmcnt(0)\n\ts_barrier" ::: "memory")
constexpr int SC_KK = 0, SC_WW = 8192, SC_BB = 16384, SC_K2 = 24576, SC_RR = 32768, SC_YY = 40960, SC_VV = 49152  , SC_BON = 73728  ;
constexpr int SC_KBT = 74240  , SC_CT = 82944  , SC_OPS = 93440  , SC_OPB = 15616;
constexpr int SC_TAB = 155904;
constexpr int OP_XT = 0, OP_KB = 4352, OP_VT = 8960, OP_WL = 11520, OP_A3 = 11776, OP_A4 = 13056, OP_A5 = 14336;
static_assert(SC_OPS + 4 * SC_OPB <= SC_TAB && SC_TAB + 2048 <= LDS_BYTES - 64, "scan LDS map");
__device__ __forceinline__ void scan_unit(const Args& A, int bh, unsigned char* L) {
    int tid = threadIdx.x; asm volatile("" : "+v"(tid));
    const int b = bh >> 3, h = bh & 7;
    const bf16_t* PROJ = (const bf16_t*)(A.ws + WS_PROJ); const bf16_t* LO = (const bf16_t*)(A.ws + WS_LO); bf16_t* YA = (bf16_t*)(A.ws + WS_YA);
    float* KK = (float*)(L + SC_KK); float* WW = (float*)(L + SC_WW); float* BB = (float*)(L + SC_BB); float* K2 = (float*)(L + SC_K2); float* RR = (float*)(L + SC_RR); float* YY = (float*)(L + SC_YY);
    const int tt = tid >> 4, c4 = (tid & 15) * 4, ch = h * 64 + c4;
    const int lane = tid & 63, wv = __builtin_amdgcn_readfirstlane(tid >> 6), r32 = lane & 31, hi = lane >> 5;
    float* TAB = (float*)(L + SC_TAB);
    if (tid < 64) { const int cc = h * 64 + tid;
        TAB[tid] = A.in[I_MURKV][cc]; TAB[64 + tid] = A.in[I_MURKV][512 + cc]; TAB[128 + tid] = A.in[I_MURKV][1024 + cc]; TAB[192 + tid] = A.in[I_KK][cc];
        TAB[256 + tid] = A.in[I_KA][cc]; TAB[320 + tid] = A.in[I_RK][cc]; TAB[384 + tid] = A.in[I_LNXG][cc]; TAB[448 + tid] = A.in[I_LNXB][cc]; }
    LBAR();
    const f32x16 zero16s = (f32x16){0.f,0.f,0.f,0.f,0.f,0.f,0.f,0.f,0.f,0.f,0.f,0.f,0.f,0.f,0.f,0.f};
    f32x16 St[2]; St[0] = zero16s; St[1] = zero16s;
    u32x2 raw[9];
    float gq_prev[4] = {0.f, 0.f, 0.f, 0.f}, gq_cur[4] = {0.f, 0.f, 0.f, 0.f}, gq_next[4];
    auto load_raw = [&](int chunk) {
        const size_t t = (size_t)b * SEQ + chunk * 32 + tt;
        const bf16_t* p = PROJ + t * LDP + ch;
        raw[0] = *(const u32x2*)(p + C_R); raw[1] = *(const u32x2*)(p + C_K); raw[2] = *(const u32x2*)(p + C_V);
        if (chunk == 0 && tt == 0) { raw[3] = (u32x2){0u, 0u}; raw[4] = raw[3]; raw[5] = raw[3]; }
        else { raw[3] = *(const u32x2*)(p - LDP + C_R); raw[4] = *(const u32x2*)(p - LDP + C_K); raw[5] = *(const u32x2*)(p - LDP + C_V); }
        const bf16_t* q = LO + t * 1536 + ch;
        raw[6] = *(const u32x2*)(q); raw[7] = *(const u32x2*)(q + 512); raw[8] = *(const u32x2*)(q + 1024);
    };
    auto prep = [&](int c) {
        float* VV = (float*)(L + SC_VV + (c % 3) * 8192); float* BON = (float*)(L + SC_BON + (c % 3) * 128);
        float r[4], k[4], v[4], rp[4], kp[4], vp[4], ew[4], a[4];
        unpack4(raw[0], r); unpack4(raw[1], k); unpack4(raw[2], v); unpack4(raw[3], rp); unpack4(raw[4], kp); unpack4(raw[5], vp); unpack4(raw[6], ew); unpack4(raw[7], a); unpack4(raw[8], gq_next);
        const f32x4 mu_r = *(const f32x4*)(TAB + c4), mu_k = *(const f32x4*)(TAB + 64 + c4), mu_v = *(const f32x4*)(TAB + 128 + c4), k_k = *(const f32x4*)(TAB + 192 + c4), k_a = *(const f32x4*)(TAB + 256 + c4), r_k = *(const f32x4*)(TAB + 320 + c4);
        float kku[4], k2[4], ss = 0.f, bon = 0.f;
#pragma unroll
        for (int e = 0; e < 4; ++e) { r[e] += (rp[e] - r[e]) * mu_r[e]; k[e] += (kp[e] - k[e]) * mu_k[e]; v[e] += (vp[e] - v[e]) * mu_v[e];
            kku[e] = k[e] * k_k[e]; ss += kku[e] * kku[e]; k2[e] = k[e] * (1.f + (a[e] - 1.f) * k_a[e]); bon += r[e] * k2[e] * r_k[e]; }
        ss = red16(ss); bon = red16(bon);
        const float inv = fminf(__builtin_amdgcn_rsqf(ss), 1e12f);
        f32x4 kk4, w4, b4, k24, r4, v4;
#pragma unroll
        for (int e = 0; e < 4; ++e) { const float kk = kku[e] * inv; kk4[e] = kk; w4[e] = __expf(-ew[e]); b4[e] = kk * a[e]; k24[e] = k2[e]; r4[e] = r[e]; v4[e] = v[e]; }
        const int o = tt * 64 + c4;
        *(f32x4*)(KK + o) = kk4; *(f32x4*)(WW + o) = w4; *(f32x4*)(BB + o) = b4; *(f32x4*)(K2 + o) = k24; *(f32x4*)(RR + o) = r4; *(f32x4*)(VV + o) = v4;
        if ((tid & 15) == 0) BON[tt] = bon;
    };
    auto stageB = [&](int c) {
        const float* VV = (const float*)(L + SC_VV + (c % 3) * 8192);
        const int sc = wv >> 2, tq = wv & 3, k = lane;
        unsigned char* blk = L + SC_OPS + ((c & 1) * 2 + sc) * SC_OPB;
        bf16_t* XT = (bf16_t*)(blk + OP_XT); bf16_t* KB = (bf16_t*)(blk + OP_KB); bf16_t* VTt = (bf16_t*)(blk + OP_VT); float* WL = (float*)(blk + OP_WL); bf16_t* KBT = (bf16_t*)(L + SC_KBT + sc * 4352);
        float W = 1.f;
#pragma unroll
        for (int t = 0; t < 12; ++t) { const float wq = WW[(16 * sc + t) * 64 + k]; W *= (t < 4 * tq) ? wq : 1.f; }
#pragma unroll
        for (int t4 = 0; t4 < 4; ++t4) {
            const int t = 4 * tq + t4;
            const int o = (16 * sc + t) * 64 + k;
            const float w = WW[o], kk = KK[o], bq = BB[o], k2 = K2[o], r = RR[o], vv = VV[o];
            const float alpha = W * kk; W *= w; const float invW = __builtin_amdgcn_rcpf(W);
            const float beta = bq * invW, kappa = k2 * invW, rho = W * r;
            const unsigned pa = cvt_pk_bf16(alpha, rho), pk = cvt_pk_bf16(kappa, beta), pn = cvt_pk_bf16(-beta, vv);
            XT[t * 68 + k] = (bf16_t)(pa & 0xffffu); XT[(16 + t) * 68 + k] = (bf16_t)(pa >> 16);
            KBT[t * 68 + k] = (bf16_t)(pk & 0xffffu); KBT[(16 + t) * 68 + k] = (bf16_t)(pk >> 16);
            KB[k * 36 + t] = (bf16_t)(pk & 0xffffu); KB[k * 36 + 16 + t] = (bf16_t)(pn & 0xffffu);
            VTt[k * 20 + t] = (bf16_t)(pn >> 16);
        }
        if (tq == 3) WL[k] = W;
    };
    auto stageC = [&](int c) {
        const int sc = wv - 2;
        unsigned char* blk = L + SC_OPS + ((c & 1) * 2 + sc) * SC_OPB;
        const bf16_t* XT = (const bf16_t*)(blk + OP_XT); const bf16_t* KBT = (const bf16_t*)(L + SC_KBT + sc * 4352);
        float* SM = (float*)(L + SC_CT + sc * 5248); float* QT = SM + 1056; bf16_t* A3 = (bf16_t*)(blk + OP_A3); bf16_t* A4 = (bf16_t*)(blk + OP_A4); bf16_t* A5 = (bf16_t*)(blk + OP_A5);
        f32x16 sm = zero16s;
#pragma unroll
        for (int cc = 0; cc < 4; ++cc) sm = __builtin_amdgcn_mfma_f32_32x32x16_bf16(afrag(KBT, 68, r32, 16 * cc, hi), afrag(XT, 68, r32, 16 * cc, hi), sm, 0, 0, 0);
#pragma unroll
        for (int r = 0; r < 16; ++r) SM[((r & 3) + 8 * (r >> 2) + 4 * hi) * 33 + r32] = sm[r];
        if (r32 < 16) { *(f32x4*)(QT + r32 * 16 + 4 * hi) = (f32x4){sm[8], sm[9], sm[10], sm[11]}; *(f32x4*)(QT + r32 * 16 + 8 + 4 * hi) = (f32x4){sm[12], sm[13], sm[14], sm[15]}; }
        asm volatile("s_waitcnt lgkmcnt(0)" ::: "memory");
        {
            const int rr = lane & 15;
            f32x4 q[16][4];
#pragma unroll
            for (int t = 1; t < 16; ++t)
#pragma unroll
                for (int v4 = 0; v4 < 4; ++v4) if (4 * v4 < t) q[t][v4] = *(const f32x4*)(QT + t * 16 + 4 * v4);
            float N[16];
#pragma unroll
            for (int t = 0; t < 16; ++t) {
                float acc0 = (rr == t) ? 1.f : 0.f, acc1 = 0.f;
#pragma unroll
                for (int i = 0; i < t; ++i) { if (i & 1) acc1 -= N[i] * q[t][i >> 2][i & 3]; else acc0 -= N[i] * q[t][i >> 2][i & 3]; }
                N[t] = acc0 + acc1;
            }
            if (lane < 16) {
#pragma unroll
                for (int t = 0; t < 16; ++t) A4[t * 20 + rr] = (bf16_t)(cvt_pk_bf16(N[t], 0.f) & 0xffffu);
            } else if (lane < 32) {
#pragma unroll
                for (int i = 0; i < 16; ++i) A4[lane * 20 + i] = 0;
            }
        }
        {
            const int m = lane & 31, i0 = (lane >> 5) * 8;
#pragma unroll
            for (int e = 0; e < 8; ++e) { const int i = i0 + e;
                float a3, a5;
                if (m < 16) { a3 = (i < m) ? SM[i * 33 + m] : 0.f; a5 = 0.f; }
                else { const int t = m - 16; a3 = (i <= t) ? SM[i * 33 + 16 + t] : 0.f; a5 = (i <= t) ? -SM[(16 + i) * 33 + 16 + t] : 0.f; }
                const unsigned pk = cvt_pk_bf16(a3, a5);
                A3[m * 20 + i] = (bf16_t)(pk & 0xffffu); A5[m * 20 + i] = (bf16_t)(pk >> 16); }
        }
    };
    auto stageD = [&](int c) {
        bf16x8 fXT[2][4], fKB[2][4], fV[2], fA3[2], fA4[2], fA5[2];
#pragma unroll
        for (int sc = 0; sc < 2; ++sc) {
            const unsigned char* blk = L + SC_OPS + ((c & 1) * 2 + sc) * SC_OPB;
            const bf16_t* XT = (const bf16_t*)(blk + OP_XT); const bf16_t* KB = (const bf16_t*)(blk + OP_KB); const bf16_t* VTt = (const bf16_t*)(blk + OP_VT);
#pragma unroll
            for (int q4 = 0; q4 < 4; ++q4) fXT[sc][q4] = afrag(XT, 68, r32, 16 * q4, hi);
            fV[sc] = afrag(VTt, 20, 32 * wv + r32, 0, hi);
            fA3[sc] = afrag((const bf16_t*)(blk + OP_A3), 20, r32, 0, hi); fA4[sc] = afrag((const bf16_t*)(blk + OP_A4), 20, r32, 0, hi); fA5[sc] = afrag((const bf16_t*)(blk + OP_A5), 20, r32, 0, hi);
#pragma unroll
            for (int t2 = 0; t2 < 2; ++t2) { fKB[sc][2 * t2] = afrag(KB, 36, 32 * t2 + r32, 0, hi); fKB[sc][2 * t2 + 1] = afrag(KB, 36, 32 * t2 + r32, 16, hi); }
        }
#pragma unroll
        for (int sc = 0; sc < 2; ++sc) {
            const float* WL = (const float*)(L + SC_OPS + ((c & 1) * 2 + sc) * SC_OPB + OP_WL);
            f32x4 wl[2][4];
#pragma unroll
            for (int t2 = 0; t2 < 2; ++t2)
#pragma unroll
                for (int g4 = 0; g4 < 4; ++g4) wl[t2][g4] = *(const f32x4*)(WL + 32 * t2 + 8 * g4 + 4 * hi);
            f32x16 Gm = zero16s;
#pragma unroll
            for (int t2 = 0; t2 < 2; ++t2)
#pragma unroll
                for (int cc = 0; cc < 2; ++cc) Gm = __builtin_amdgcn_mfma_f32_32x32x16_bf16(fXT[sc][2 * t2 + cc], pack8(St[t2], 8 * cc), Gm, 0, 0, 0);
            Gm = __builtin_amdgcn_mfma_f32_32x32x16_bf16(fA3[sc], fV[sc], Gm, 0, 0, 0);
            const f32x16 Um = __builtin_amdgcn_mfma_f32_32x32x16_bf16(fA4[sc], pack8(Gm, 0), zero16s, 0, 0, 0);
            const bf16x8 ub = pack8(Um, 0);
#pragma unroll
            for (int t2 = 0; t2 < 2; ++t2) {
                St[t2] = __builtin_amdgcn_mfma_f32_32x32x16_bf16(fKB[sc][2 * t2], fV[sc], St[t2], 0, 0, 0);
                St[t2] = __builtin_amdgcn_mfma_f32_32x32x16_bf16(fKB[sc][2 * t2 + 1], ub, St[t2], 0, 0, 0);
            }
            Gm = __builtin_amdgcn_mfma_f32_32x32x16_bf16(fA5[sc], ub, Gm, 0, 0, 0);
#pragma unroll
            for (int t2 = 0; t2 < 2; ++t2)
#pragma unroll
                for (int g4 = 0; g4 < 4; ++g4)
#pragma unroll
                    for (int e = 0; e < 4; ++e) St[t2][4 * g4 + e] *= wl[t2][g4][e];
#pragma unroll
            for (int e = 0; e < 4; ++e) { YY[(16 * sc + 4 * hi + e) * 64 + 32 * wv + r32] = Gm[8 + e]; YY[(16 * sc + 8 + 4 * hi + e) * 64 + 32 * wv + r32] = Gm[12 + e]; }
        }
    };
    auto outst = [&](int c, const float (&gq)[4]) {
        const float* VV = (const float*)(L + SC_VV + (c % 3) * 8192); const float* BON = (const float*)(L + SC_BON + (c % 3) * 128);
        const int o = tt * 64 + c4;
        const f32x4 y4 = *(const f32x4*)(YY + o), v4 = *(const f32x4*)(VV + o);
        const float mean = red16((y4[0] + y4[1]) + (y4[2] + y4[3])) * (1.f / 64.f);
        float q = 0.f;
#pragma unroll
        for (int e = 0; e < 4; ++e) { const float d = y4[e] - mean; q += d * d; }
        const float rstd = __builtin_amdgcn_rsqf(red16(q) * (1.f / 64.f) + 64e-5f);
        const float bon = BON[tt];
        const f32x4 lg = *(const f32x4*)(TAB + 384 + c4), lb = *(const f32x4*)(TAB + 448 + c4);
        float o4[4];
#pragma unroll
        for (int e = 0; e < 4; ++e) o4[e] = ((y4[e] - mean) * rstd * lg[e] + lb[e] + bon * v4[e]) * gq[e];
        u32x2 w; w.x = cvt_pk_bf16(o4[0], o4[1]); w.y = cvt_pk_bf16(o4[2], o4[3]);
        *(u32x2*)(YA + ((size_t)b * SEQ + c * 32 + tt) * 512 + ch) = w;
    };
    load_raw(0);
    prep(0);
#pragma unroll
    for (int e = 0; e < 4; ++e) gq_cur[e] = gq_next[e];
    load_raw(1);
    LBAR();
    stageB(0);
    LBAR();
    if (wv == 2 || wv == 3) stageC(0);
    LBAR();
    for (int c = 0; c < 64; ++c) {
        if (c >= 1) outst(c - 1, gq_prev);
        if (c + 1 < 64) prep(c + 1);
#pragma unroll
        for (int e = 0; e < 4; ++e) { gq_prev[e] = gq_cur[e]; gq_cur[e] = gq_next[e]; }
        if (c + 2 < 64) load_raw(c + 2);
        LBAR();
        if (c + 1 < 64) stageB(c + 1);
        LBAR();
        if (wv < 2) stageD(c);
        else if (wv < 4) { if (c + 1 < 64) stageC(c + 1); }
        LBAR();
    }
    outst(63, gq_prev);
    LBAR();
}

__device__ __forceinline__ float other_half(float x) {
    const auto rr = __builtin_amdgcn_permlane32_swap(__float_as_uint(x), __float_as_uint(x), false, false);
    const float a = __uint_as_float(rr[0]), b = __uint_as_float(rr[1]);
    return (threadIdx.x & 32) ? a : b;
}
__device__ __forceinline__ float halves_max(float x) { const auto rr = __builtin_amdgcn_permlane32_swap(__float_as_uint(x), __float_as_uint(x), false, false); return fmaxf(__uint_as_float(rr[0]), __uint_as_float(rr[1])); }
__device__ __forceinline__ float halves_sum(float x) { const auto rr = __builtin_amdgcn_permlane32_swap(__float_as_uint(x), __float_as_uint(x), false, false); return __uint_as_float(rr[0]) + __uint_as_float(rr[1]); }
typedef short v4i16_t __attribute__((ext_vector_type(4)));
__device__ __forceinline__ s16x4 lds_tr16(const void* p) { return __builtin_bit_cast(s16x4, __builtin_amdgcn_ds_read_tr16_b64_v4i16((LAS v4i16_t*)p)); }
constexpr int KS_PITCH = 72;
struct AttnLds { bf16_t* Ks; bf16_t* Vt; float* IMP; float* SC; unsigned* SEL; };

template <bool MASKED, class VF> __device__ __forceinline__ void attn_step(const AttnLds& Z, const bf16x8 (&qf)[4], f32x16 (&o)[2], float& m, float& l, VF valid, bool lanesel, int r32, int hi) {
    f32x16 s[2];
#pragma unroll
    for (int hv = 0; hv < 2; ++hv) {
        s[hv] = (f32x16){0.f,0.f,0.f,0.f,0.f,0.f,0.f,0.f,0.f,0.f,0.f,0.f,0.f,0.f,0.f,0.f};
#pragma unroll
        for (int c = 0; c < 4; ++c) { const bf16x8 kf = *(const bf16x8*)(Z.Ks + (32 * hv + r32) * KS_PITCH + 16 * c + 8 * hi); s[hv] = __builtin_amdgcn_mfma_f32_32x32x16_bf16(kf, qf[c], s[hv], 0, 0, 0); }
    }
    if (MASKED) {
#pragma unroll
        for (int hv = 0; hv < 2; ++hv)
#pragma unroll
            for (int r = 0; r < 16; ++r) { const int kvl = 32 * hv + (r & 3) + 8 * (r >> 2) + 4 * hi; s[hv][r] = valid(kvl) ? s[hv][r] : -1e30f; }
    }
    float mx0 = fmaxf(s[0][0], s[1][0]), mx1 = fmaxf(s[0][1], s[1][1]);
#pragma unroll
    for (int r = 2; r < 16; r += 2) { mx0 = fmaxf(fmaxf(mx0, s[0][r]), s[1][r]); mx1 = fmaxf(fmaxf(mx1, s[0][r + 1]), s[1][r + 1]); }
    float mx = fmaxf(mx0, mx1);
    mx = halves_max(mx);
    if (__any(mx > m + 8.f)) { const float mn = fmaxf(m, mx); const float alpha = __builtin_amdgcn_exp2f(m - mn); l *= alpha; o[0] = o[0] * alpha; o[1] = o[1] * alpha; m = mn; }
    const float nb = lanesel ? -m : -__builtin_inff();
    f32x2 ps2 = (f32x2){0.f, 0.f};
#pragma unroll
    for (int hv = 0; hv < 2; ++hv) {
#pragma unroll
        for (int r = 0; r < 16; r += 2) {
            const f32x2 d = (f32x2){s[hv][r], s[hv][r + 1]} + (f32x2){nb, nb};
            float p0 = __builtin_amdgcn_exp2f(d.x), p1 = __builtin_amdgcn_exp2f(d.y);
            if (MASKED) { p0 = s[hv][r] > -1e29f ? p0 : 0.f; p1 = s[hv][r + 1] > -1e29f ? p1 : 0.f; }
            s[hv][r] = p0; s[hv][r + 1] = p1; ps2 += (f32x2){p0, p1};
        }
#pragma unroll
        for (int cc = 0; cc < 2; ++cc) {
            const int c = 2 * hv + cc, rb = 8 * cc;
            u32x4 pw; pw.x = cvt_pk_bf16(s[hv][rb + 0], s[hv][rb + 1]); pw.y = cvt_pk_bf16(s[hv][rb + 2], s[hv][rb + 3]); pw.z = cvt_pk_bf16(s[hv][rb + 4], s[hv][rb + 5]); pw.w = cvt_pk_bf16(s[hv][rb + 6], s[hv][rb + 7]);
            const bf16x8 pb = __builtin_bit_cast(bf16x8, pw);
#pragma unroll
            for (int dh = 0; dh < 2; ++dh) {
                const unsigned char* vp = (const unsigned char*)Z.Vt + dh * 4096 + (16 * c + 4 * hi + ((r32 & 15) >> 2)) * 64 + (r32 >> 4) * 32 + (r32 & 3) * 8;
                const s16x4 lo = lds_tr16(vp), hh = lds_tr16(vp + 8 * 64);
                const bf16x8 va = (bf16x8){lo[0], lo[1], lo[2], lo[3], hh[0], hh[1], hh[2], hh[3]};
                o[dh] = __builtin_amdgcn_mfma_f32_32x32x16_bf16(va, pb, o[dh], 0, 0, 0);
            }
        }
    }
    l += ps2.x + ps2.y;
}
__device__ __forceinline__ void attn_stage(const AttnLds& Z, const u32x4 kreg, const u32x4 vreg, int tid) {
    const int row = tid >> 3, chn = tid & 7;
    *(u32x4*)(Z.Ks + row * KS_PITCH + chn * 8) = kreg;
    *(u32x4*)((unsigned char*)Z.Vt + (chn >> 2) * 4096 + row * 64 + (chn & 3) * 16) = vreg;
}

__device__ __forceinline__ void attn_unit(const Args& A, int b, int hk, int qt, unsigned char* lds) {
    int tid = threadIdx.x; asm volatile("" : "+v"(tid));
    const int lane = tid & 63, w = tid >> 6, r32 = lane & 31, hi = lane >> 5, g = w >> 1, th = w & 1;
    AttnLds Z; Z.Ks = (bf16_t*)lds; Z.Vt = (bf16_t*)(lds + 9216); Z.IMP = (float*)(lds + 35840); Z.SC = (float*)(lds + 35840 + 32768); Z.SEL = (unsigned*)(lds + 35840 + 32768 + 8192);
    auto ZBf = [&](int q) -> AttnLds { AttnLds z = Z; z.Ks = (bf16_t*)(lds + q * 17920); z.Vt = (bf16_t*)(lds + q * 17920 + 9216); return z; };
    const bf16_t* PROJ = (const bf16_t*)(A.ws + WS_PROJ);
    const bf16_t* KCB = (const bf16_t*)(A.ws + WS_KCB); const bf16_t* VCB = (const bf16_t*)(A.ws + WS_VCB);
    bf16_t* YB = (bf16_t*)(A.ws + WS_YB);
    const int tokl = 32 * th + r32, spos = 64 * qt + tokl;
    const size_t trow = (size_t)b * SEQ + spos;
    const int head = hk * 4 + g;
    bf16x8 qf[4];
#pragma unroll
    for (int c = 0; c < 4; ++c) qf[c] = *(const bf16x8*)(PROJ + trow * LDP + C_Q + head * 64 + 16 * c + 8 * hi);
    float gate[3];
#pragma unroll
    for (int e = 0; e < 3; ++e) gate[e] = sigmoidf_(bf2f(PROJ[trow * LDP + C_NG + head * 3 + e]));
    f32x16 out[2], o[2];
    const f32x16 zero16 = (f32x16){0.f,0.f,0.f,0.f,0.f,0.f,0.f,0.f,0.f,0.f,0.f,0.f,0.f,0.f,0.f,0.f};
    out[0] = zero16; out[1] = zero16;
    const int srow = tid >> 3, schn = tid & 7;
    u32x4 kreg, vreg;
    float m, l;
    auto finish = [&](float gt) {
        const float lt = halves_sum(l);
        const float sc = lt > 0.f ? gt / lt : 0.f;
        out[0] += o[0] * sc; out[1] += o[1] * sc;
    };
    const int ncmp = 4 * qt + 3 < 127 ? 4 * qt + 3 : 127;
    const int ntl = (ncmp + 63) / 64;
    const bf16_t* kcb = KCB + (size_t)((b * 2 + hk) * 128) * 64; const bf16_t* vcb = VCB + (size_t)((b * 2 + hk) * 128) * 64;
    m = -1e30f; l = 0.f; o[0] = zero16; o[1] = zero16;
    kreg = *(const u32x4*)(kcb + srow * 64 + schn * 8); vreg = *(const u32x4*)(vcb + srow * 64 + schn * 8);
    attn_stage(ZBf(0), kreg, vreg, tid); __syncthreads();
    if (ntl > 1) { kreg = *(const u32x4*)(kcb + (64 + srow) * 64 + schn * 8); vreg = *(const u32x4*)(vcb + (64 + srow) * 64 + schn * 8); }
    for (int tl = 0; tl < ntl; ++tl) {
        if (tl + 1 < ntl) attn_stage(ZBf((tl + 1) & 1), kreg, vreg, tid);
        const int cb0 = 64 * tl;
        if (tl == 0 && qt >= 17) attn_step<false>(ZBf(tl & 1), qf, o, m, l, [&](int) { return true; }, true, r32, hi);
        else attn_step<true>(ZBf(tl & 1), qf, o, m, l, [&](int kvl) { const int c = cb0 + kvl; return (16 * c + 31 <= spos) && (c < 127); }, true, r32, hi);
        __syncthreads();
    }
    finish(gate[0]);
    unsigned selm, uni;
    if (qt >= 16) {
        const float lt = l + __shfl_xor(l, 32);
        const float linv = lt > 0.f ? 1.f / lt : 0.f;
        float carry = 0.f;
        kreg = *(const u32x4*)(kcb + srow * 64 + schn * 8);
        for (int tl = 0; tl < 2; ++tl) {
            __syncthreads(); *(u32x4*)(Z.Ks + srow * KS_PITCH + schn * 8) = kreg; __syncthreads();
            if (tl == 0) kreg = *(const u32x4*)(kcb + (64 + srow) * 64 + schn * 8);
#pragma unroll
            for (int hv = 0; hv < 2; ++hv) {
                f32x16 s = zero16;
#pragma unroll
                for (int c = 0; c < 4; ++c) { const bf16x8 kf = *(const bf16x8*)(Z.Ks + (32 * hv + r32) * KS_PITCH + 16 * c + 8 * hi); s = __builtin_amdgcn_mfma_f32_32x32x16_bf16(kf, qf[c], s, 0, 0, 0); }
#pragma unroll
                for (int gq = 0; gq < 4; ++gq) {
                    float pn[4];
#pragma unroll
                    for (int e = 0; e < 4; ++e) { const int c = 64 * tl + 32 * hv + 8 * gq + 4 * hi + e; const bool ok = (16 * c + 31 <= spos) && (c < 127); pn[e] = ok ? __builtin_amdgcn_exp2f(s[4 * gq + e] - m) * linv : 0.f; }
                    const float qsum = (pn[0] + pn[1]) + (pn[2] + pn[3]);
                    const float other_last = __shfl_xor(pn[3], 32);
                    const float extra = hi ? other_last : carry;
                    carry = other_last;
                    const int j = 16 * tl + 8 * hv + 2 * gq + hi;
                    Z.IMP[(g * 64 + tokl) * 32 + j] = qsum + extra;
                }
            }
        }
        __syncthreads();
        {
            const int tok = tid >> 3, jg = tid & 7;
            float sc4[4];
#pragma unroll
            for (int e = 0; e < 4; ++e) { const int j = 4 * jg + e;
                const float imp = (Z.IMP[(0 * 64 + tok) * 32 + j] + Z.IMP[(1 * 64 + tok) * 32 + j]) + (Z.IMP[(2 * 64 + tok) * 32 + j] + Z.IMP[(3 * 64 + tok) * 32 + j]);
                const bool forced = (j == 0) || (j == qt) || (j == qt - 1);
                sc4[e] = forced ? 1e4f : (j <= qt ? imp : -1.f); }
            *(f32x4*)(Z.SC + tok * 32 + 4 * jg) = (f32x4){sc4[0], sc4[1], sc4[2], sc4[3]};
            __syncthreads();
            int rank[4] = {0, 0, 0, 0};
#pragma unroll
            for (int i4 = 0; i4 < 8; ++i4) { const f32x4 v = *(const f32x4*)(Z.SC + tok * 32 + 4 * i4);
#pragma unroll
                for (int ie = 0; ie < 4; ++ie) { const int i = 4 * i4 + ie;
#pragma unroll
                    for (int e = 0; e < 4; ++e) { const int j = 4 * jg + e; rank[e] += (v[ie] > sc4[e] || (v[ie] == sc4[e] && i < j)) ? 1 : 0; } } }
            unsigned bits = 0u;
#pragma unroll
            for (int e = 0; e < 4; ++e) { const int j = 4 * jg + e; if (rank[e] < 16 && j <= qt) bits |= 1u << j; }
            bits |= __shfl_xor(bits, 1); bits |= __shfl_xor(bits, 2); bits |= __shfl_xor(bits, 4);
            if (jg == 0) Z.SEL[tok] = bits;
        }
        __syncthreads();
        selm = Z.SEL[tokl];
        unsigned u = Z.SEL[lane];
#pragma unroll
        for (int ofs = 1; ofs < 64; ofs <<= 1) u |= __shfl_xor(u, ofs);
        uni = u;
    } else { selm = (2u << qt) - 1u; uni = selm; }
    uni = __builtin_amdgcn_readfirstlane(uni);
    {
        const bf16_t* kb = PROJ + (size_t)b * SEQ * LDP + C_KS + hk * 64; const bf16_t* vb = PROJ + (size_t)b * SEQ * LDP + C_VS + hk * 64;
        m = -1e30f; l = 0.f; o[0] = zero16; o[1] = zero16;
        unsigned rem = uni;
        auto popb = [&]() -> int { if (!rem) return -1; const int q = __builtin_ctz(rem); rem &= rem - 1u; return q; };
        int j = popb(), jn = popb();
        kreg = *(const u32x4*)(kb + (size_t)(64 * j + srow) * LDP + schn * 8); vreg = *(const u32x4*)(vb + (size_t)(64 * j + srow) * LDP + schn * 8);
        attn_stage(ZBf(0), kreg, vreg, tid); __syncthreads();
        if (jn >= 0) { kreg = *(const u32x4*)(kb + (size_t)(64 * jn + srow) * LDP + schn * 8); vreg = *(const u32x4*)(vb + (size_t)(64 * jn + srow) * LDP + schn * 8); }
        int pb = 0;
        for (;;) {
            const int jnn = (jn >= 0) ? popb() : -1;
            if (jn >= 0) attn_stage(ZBf(pb ^ 1), kreg, vreg, tid);
            if (jnn >= 0) { kreg = *(const u32x4*)(kb + (size_t)(64 * jnn + srow) * LDP + schn * 8); vreg = *(const u32x4*)(vb + (size_t)(64 * jnn + srow) * LDP + schn * 8); }
            const bool sel = (selm >> j) & 1u; const int kv0 = 64 * j;
            if (j < qt) { if (__any(sel)) attn_step<false>(ZBf(pb), qf, o, m, l, [&](int) { return true; }, sel, r32, hi); }
            else attn_step<true>(ZBf(pb), qf, o, m, l, [&](int kvl) { return kv0 + kvl <= spos; }, sel, r32, hi);
            __syncthreads();
            if (jn < 0) break;
            j = jn; jn = jnn; pb ^= 1;
        }
        finish(gate[1]);
    }
    {
        const bf16_t* kb = PROJ + (size_t)b * SEQ * LDP + C_KW + hk * 64; const bf16_t* vb = PROJ + (size_t)b * SEQ * LDP + C_VW + hk * 64;
        m = -1e30f; l = 0.f; o[0] = zero16; o[1] = zero16;
        const int j0 = qt >= 8 ? qt - 8 : 0;
        kreg = *(const u32x4*)(kb + (size_t)(64 * j0 + srow) * LDP + schn * 8); vreg = *(const u32x4*)(vb + (size_t)(64 * j0 + srow) * LDP + schn * 8);
        attn_stage(ZBf(0), kreg, vreg, tid); __syncthreads();
        if (j0 < qt) { kreg = *(const u32x4*)(kb + (size_t)(64 * (j0 + 1) + srow) * LDP + schn * 8); vreg = *(const u32x4*)(vb + (size_t)(64 * (j0 + 1) + srow) * LDP + schn * 8); }
        for (int j = j0; j <= qt; ++j) {
            const int pb = (j - j0) & 1;
            if (j < qt) attn_stage(ZBf(pb ^ 1), kreg, vreg, tid);
            if (j + 2 <= qt) { kreg = *(const u32x4*)(kb + (size_t)(64 * (j + 2) + srow) * LDP + schn * 8); vreg = *(const u32x4*)(vb + (size_t)(64 * (j + 2) + srow) * LDP + schn * 8); }
            const int kv0 = 64 * j;
            if (j == qt || (qt >= 8 && j == qt - 8)) attn_step<true>(ZBf(pb), qf, o, m, l, [&](int kvl) { const int kp = kv0 + kvl; return (kp <= spos) && (kp > spos - 512); }, true, r32, hi);
            else attn_step<false>(ZBf(pb), qf, o, m, l, [&](int) { return true; }, true, r32, hi);
            __syncthreads();
        }
        finish(gate[2]);
    }
    bf16_t* yb = YB + trow * 512 + head * 64;
#pragma unroll
    for (int dh = 0; dh < 2; ++dh)
#pragma unroll
        for (int gq = 0; gq < 4; ++gq) {
            u32x2 wv; wv.x = cvt_pk_bf16(out[dh][4 * gq + 0], out[dh][4 * gq + 1]); wv.y = cvt_pk_bf16(out[dh][4 * gq + 2], out[dh][4 * gq + 3]);
            *(u32x2*)(yb + 32 * dh + 8 * gq + 4 * hi) = wv;
        }
    __syncthreads();
}

#define XB_TMO      128
#define XB_XCNT(j)  (256  + 64 * (j))
#define XB_XSUB(j)  (1280 + 64 * (j))
#define XB_XGEN(j)  (2304 + 64 * (j))
#define XB_TOP      3328
#define XB_TOPGEN   3392
#define XCD_BAR_WORDS 3456
#define XB_SPIN_CAP (1u << 18)

__device__ __forceinline__ unsigned xb_ld(unsigned* p)              { return __hip_atomic_load(p, __ATOMIC_RELAXED, __HIP_MEMORY_SCOPE_AGENT); }
__device__ __forceinline__ unsigned xb_add(unsigned* p, unsigned v) { return __hip_atomic_fetch_add(p, v, __ATOMIC_RELAXED, __HIP_MEMORY_SCOPE_AGENT); }
__device__ __forceinline__ unsigned xb_xcc_id() { return (unsigned)__builtin_amdgcn_s_getreg((3 << 11) | 20) & 0xFu; }
#define XB_SPIN(cond, bar) do { unsigned _sp = 0; while (cond) { __builtin_amdgcn_s_sleep(1); \
    if ((++_sp & 255u) == 0u) { if (xb_ld(&(bar)[XB_TMO])) break; if (_sp > XB_SPIN_CAP) { atomicAdd(&(bar)[XB_TMO], 1u); break; } } } } while (0)

struct XcdBarrier {
    unsigned* bar; unsigned x;
    volatile LAS unsigned* st;
};

__device__ __forceinline__ XcdBarrier xcd_barrier_post(unsigned* bar, volatile LAS unsigned* st) {
    XcdBarrier b; b.bar = bar; b.x = xb_xcc_id(); b.st = st;
    if (threadIdx.x == 0) (void)xb_add(&bar[XB_XCNT(b.x)], 1u);
    return b;
}
__device__ __forceinline__ void xcd_barrier_complete(unsigned* bar, unsigned x, unsigned& nloc, unsigned& nx) {
    const unsigned G = gridDim.x * gridDim.y * gridDim.z;
    unsigned sum, cnt, mine, sp = 0u;
    for (;;) {
        sum = 0u; cnt = 0u; mine = 0u;
#pragma unroll
        for (unsigned j = 0; j < 16; ++j) { const unsigned c = xb_ld(&bar[XB_XCNT(j)]); sum += c; cnt += (c > 0u) ? 1u : 0u; mine = (j == x) ? c : mine; }
        if (sum == G) break;
        __builtin_amdgcn_s_sleep(1);
        if ((++sp & 255u) == 0u) { if (xb_ld(&bar[XB_TMO])) break; if (sp > XB_SPIN_CAP) { atomicAdd(&bar[XB_TMO], 1u); break; } }
    }
    nloc = mine > 0u ? mine : 1u; nx = cnt > 0u ? cnt : 1u;
}

__device__ __forceinline__ void xcd_barrier(const XcdBarrier& b) {
    asm volatile("s_waitcnt vmcnt(0)" ::: "memory");
    __syncthreads();
    if (threadIdx.x == 0) {
        unsigned* bar = b.bar;
        __builtin_amdgcn_s_waitcnt(0);
        unsigned nloc = b.st[0], nx = b.st[1];
        if (nloc == 0u) { xcd_barrier_complete(bar, b.x, nloc, nx); b.st[0] = nloc; b.st[1] = nx; }
        const unsigned old = xb_add(&bar[XB_XSUB(b.x)], 1u);
        const unsigned gen = old / nloc;
        if (old + 1u == (gen + 1u) * nloc) {
            __builtin_amdgcn_fence(__ATOMIC_RELEASE, "agent");
            asm volatile("s_waitcnt vmcnt(0)" ::: "memory");
            const unsigned og = xb_add(&bar[XB_TOP], 1u);
            const unsigned tg = og / nx;
            if (og + 1u == (tg + 1u) * nx) xb_add(&bar[XB_TOPGEN], 1u);
            else XB_SPIN(xb_ld(&bar[XB_TOPGEN]) == tg, bar);
            __builtin_amdgcn_fence(__ATOMIC_ACQUIRE, "agent");
            xb_add(&bar[XB_XGEN(b.x)], 1u);
            asm volatile("s_waitcnt vmcnt(0)" ::: "memory");
        } else {
            XB_SPIN(xb_ld(&bar[XB_XGEN(b.x)]) == gen, bar);
            __builtin_amdgcn_fence(__ATOMIC_ACQUIRE, "agent");
            asm volatile("s_waitcnt vmcnt(0)" ::: "memory");
        }
    }
    __syncthreads();
}

__global__ void __launch_bounds__(NTHREADS) fwd_kernel(Args A) {
    extern __shared__ __attribute__((aligned(16))) unsigned char lds[];
    cg::grid_group grid = cg::this_grid();
    const int G = gridDim.x, bid = blockIdx.x;
    const int NGW = G * NWAVES, NGT = G * NTHREADS;
    LAS unsigned char* ldsl = (LAS unsigned char*)lds;
    volatile LAS unsigned* xst = (volatile LAS unsigned*)(ldsl + LDS_BYTES - 64);
    if (threadIdx.x < 16) xst[threadIdx.x] = 0u;
    __syncthreads();
    XcdBarrier xbar = xcd_barrier_post((unsigned*)(A.ws + WS_CTL) + 1024, xst);
    grid.sync();
#define GSYNC_CG() do { __threadfence(); grid.sync(); } while (0)
#define GSYNC() xcd_barrier(xbar)

#define WSP(name, off) bf16_t* name = (bf16_t*)(wsq + (off))
#define PHASE_BEGIN() unsigned char* wsq = A.ws; asm volatile("" : "+s"(wsq)); int tid = threadIdx.x; asm volatile("" : "+v"(tid)); const int lane = tid & 63, wave = __builtin_amdgcn_readfirstlane(tid >> 6); const int gw = bid * NWAVES + wave, gtid = bid * NTHREADS + tid; (void)lane; (void)gw; (void)gtid;
#define ALLPTRS() WSP(Win_t, WS_WIN); WSP(Wg_t, WS_WG); WSP(Wup_t, WS_WUP); WSP(Wdn_t, WS_WDN); WSP(Wo_t, WS_WO); WSP(Wpg_t, WS_WPG); WSP(Woa_t, WS_WOA); WSP(Wob_t, WS_WOB); \
    WSP(Wpp_t, WS_WPP); WSP(Wl2_t, WS_WL2); WSP(Wc1k_t, WS_WC1K); WSP(Wc1v_t, WS_WC1V); float* CB = (float*)(wsq + WS_CB); WSP(KCB, WS_KCB); WSP(VCB, WS_VCB); WSP(H12K, WS_H12K); WSP(H12V, WS_H12V); \
    WSP(PB, WS_PB); WSP(PROJ, WS_PROJ); WSP(LO, WS_LO); WSP(A2, WS_A2); WSP(YA, WS_YA); WSP(YB, WS_YB); WSP(SG, WS_SG); WSP(MB, WS_M); WSP(U2, WS_U2); WSP(ACT, WS_ACT); WSP(PP, WS_PP); \
    bf16_t* U = (bf16_t*)A.out; float* H = A.out; \
    (void)Win_t; (void)Wg_t; (void)Wup_t; (void)Wdn_t; (void)Wo_t; (void)Wpg_t; (void)Woa_t; (void)Wob_t; (void)Wpp_t; (void)Wl2_t; (void)Wc1k_t; (void)Wc1v_t; (void)CB; (void)KCB; (void)VCB; (void)H12K; (void)H12V; \
    (void)PB; (void)PROJ; (void)LO; (void)A2; (void)YA; (void)YB; (void)SG; (void)MB; (void)U2; (void)ACT; (void)PP; (void)U; (void)H;
    {
        PHASE_BEGIN(); ALLPTRS();
        float* scr = (float*)(lds + wave * 16384);
        { const float* w_in = A.in[I_WIN]; const float* w1 = A.in[I_W1]; const float* a1 = A.in[I_A1]; const float* g1 = A.in[I_G1]; const float* mu = A.in[I_MUWAG];
          tr_matrix([=](int k, int n) -> float {
              if (n < C_L1) { const float v = __builtin_nontemporal_load(w_in + (size_t)k * WIN_LD + n); return (n >= C_Q && n < C_KC) ? v * QSCALE : v; }
              if (n >= LDP) return 0.f;
              const bool second = n >= C_L2; const int i = n - (second ? C_L2 : C_L1);
              float v, mm;
              if (i < 64) { v = w1[k * 64 + i]; mm = mu[k]; } else if (i < 128) { v = a1[k * 64 + i - 64]; mm = mu[1024 + k]; } else { v = g1[k * 160 + i - 128]; mm = mu[2048 + k]; }
              return second ? v * mm : v * (1.f - mm);
          }, 1024, 3424, Win_t, scr, gw, NGW, lane);
          tr_matrix([=](int k, int n) -> float { return __builtin_nontemporal_load(w_in + (size_t)k * WIN_LD + C_L1 + n); }, 1024, 2048, Wg_t, scr, gw, NGW, lane); }
        { const float* w = A.in[I_WUP]; const float* g2 = A.in[I_LN2]; tr_matrix([=](int k, int n) -> float { const int pn = n >> 8, wq = n & 255; const int src = wq < 128 ? pn * 128 + wq : DFF + pn * 128 + (wq - 128); return __builtin_nontemporal_load(w + (size_t)k * 5632 + src) * g2[k]; }, 1024, 5632, Wup_t, scr, gw, NGW, lane); }
        { const float* w = A.in[I_WDN]; tr_matrix([=](int k, int n) -> float { return __builtin_nontemporal_load(w + (size_t)k * 1024 + n); }, 2816, 1024, Wdn_t, scr, gw, NGW, lane); }
        { const float* w = A.in[I_WO]; tr_matrix([=](int k, int n) -> float { return __builtin_nontemporal_load(w + (size_t)k * 1024 + n); }, 1024, 1024, Wo_t, scr, gw, NGW, lane); }
        { const float* w = A.in[I_WPG]; const float* g3 = A.in[I_LN3]; tr_matrix([=](int k, int n) -> float { return __builtin_nontemporal_load(w + (size_t)k * 1024 + n) * g3[k]; }, 1024, 1024, Wpg_t, scr, gw, NGW, lane); }
        { const float* w = A.in[I_WOA]; tr_matrix([=](int k, int n) -> float { return __builtin_nontemporal_load(w + (size_t)k * 1024 + n); }, 512, 1024, Woa_t, scr, gw, NGW, lane); }
        { const float* w = A.in[I_WOB]; tr_matrix([=](int k, int n) -> float { return __builtin_nontemporal_load(w + (size_t)k * 1024 + n); }, 512, 1024, Wob_t, scr, gw, NGW, lane); }
        { const float* w = A.in[I_WPP]; tr_matrix([=](int k, int n) -> float { return __builtin_nontemporal_load(w + (size_t)k * 1024 + n); }, 256, 1024, Wpp_t, scr, gw, NGW, lane); }
        { const float* w2 = A.in[I_W2]; const float* a2 = A.in[I_A2]; const float* g2 = A.in[I_G2];
          tr_matrix([=](int k, int n) -> float {
              if (n < 512) return k < 64 ? w2[k * 512 + n] : 0.f;
              if (n < 1024) return (k >= 64 && k < 128) ? a2[(k - 64) * 512 + n - 512] : 0.f;
              return (k >= 128 && k < 288) ? g2[(k - 128) * 512 + n - 1024] : 0.f;
          }, 384, 1536, Wl2_t, scr, gw, NGW, lane); }
        { const float* c1 = A.in[I_CW1];
          tr_matrix([=](int k, int n) -> float { return n < 128 ? c1[(size_t)k * 128 + n] : c1[(size_t)(1024 + k) * 128 + n - 128]; }, 1024, 256, Wc1k_t, scr, gw, NGW, lane);
          tr_matrix([=](int k, int n) -> float { return n < 128 ? c1[(size_t)(2048 + k) * 128 + n] : c1[(size_t)(2048 + 1024 + k) * 128 + n - 128]; }, 1024, 256, Wc1v_t, scr, gw, NGW, lane); }
        rms_rows<true, true>((float*)A.in[I_X], A.in[I_LN1], U, gw, NGW, lane);
        { const f32x4* p4 = (const f32x4*)A.in[I_P]; u32x2* o = (u32x2*)PB;
          for (int i0 = gtid; i0 < T * PLE / 4; i0 += 8 * NGT) { f32x4 v[8];
#pragma unroll
              for (int u = 0; u < 8; ++u) { const int i = i0 + u * NGT; if (i < T * PLE / 4) v[u] = __builtin_nontemporal_load(p4 + i); }
#pragma unroll
              for (int u = 0; u < 8; ++u) { const int i = i0 + u * NGT; if (i < T * PLE / 4) { u32x2 w; w.x = cvt_pk_bf16(v[u].x, v[u].y); w.y = cvt_pk_bf16(v[u].z, v[u].w); o[i] = w; } } } }
        {
            for (int it = gw; it < 2048; it += NGW) {
                const int o = it & 255, part = it >> 8, kv = o >> 7, n = o & 127; const float* pos = A.in[I_CPOS] + kv * 2048 + part * 256; const float* c1 = A.in[I_CW1] + ((size_t)kv * 2048 + part * 256) * 128;
                float s = 0.f;
#pragma unroll
                for (int q = 0; q < 4; ++q) { const int i = lane + 64 * q; s += pos[i] * c1[(size_t)i * 128 + n]; }
                s = wave_sum(s);
                if (lane == 0) CB[part * 256 + o] = s;
            }
        }
    }
    GSYNC();
    {
        PHASE_BEGIN(); ALLPTRS();
        pg8::Gemm g = pg8::mk_gemm(U, DM, Win_t, T, 5632, DM); pg8::StaticOrder S; S.init(T, 5632, G, bid);
        pg8::EpiProj E{PROJ, (unsigned char*)A.out + 64 * MiB};
        pg8::gemm_phase<pg8::EpiProj, true>(ldsl, g, S, E);
    }
    GSYNC();
    {
        PHASE_BEGIN(); ALLPTRS();
        {
            const int gt2 = gtid, NG2 = NGT;
            for (int i0 = gt2; i0 < T * 48; i0 += 4 * NG2) {
                u32x4 la[4], lb[4];
#pragma unroll
                for (int u = 0; u < 4; ++u) { const int i = i0 + u * NG2; la[u] = (u32x4){0u, 0u, 0u, 0u}; lb[u] = la[u];
                    if (i < T * 48) { const int t = i / 48, cg8 = (i % 48) * 8;
                        if (cg8 < 288) { la[u] = *(const u32x4*)(PROJ + (size_t)t * LDP + C_L1 + cg8); if ((t & (SEQ - 1)) != 0) lb[u] = *(const u32x4*)(PROJ + (size_t)(t - 1) * LDP + C_L2 + cg8); } } }
#pragma unroll
                for (int u = 0; u < 4; ++u) { const int i = i0 + u * NG2;
                    if (i < T * 48) { const int t = i / 48, cg8 = (i % 48) * 8;
                        u32x4 w = (u32x4){0u, 0u, 0u, 0u};
                        if (cg8 < 288) {
                            float a[8], bq[8]; unpack8(la[u], a); unpack8(lb[u], bq);
#pragma unroll
                            for (int e = 0; e < 8; ++e) a[e] += bq[e];
                            if (cg8 < 64) {
#pragma unroll
                                for (int e = 0; e < 8; ++e) a[e] = tanhf_(a[e]);
                            } else if (cg8 >= 128) {
#pragma unroll
                                for (int e = 0; e < 8; ++e) a[e] = sigmoidf_(a[e]);
                            }
                            w.x = cvt_pk_bf16(a[0], a[1]); w.y = cvt_pk_bf16(a[2], a[3]); w.z = cvt_pk_bf16(a[4], a[5]); w.w = cvt_pk_bf16(a[6], a[7]);
                        }
                        *(u32x4*)(A2 + (size_t)t * 384 + cg8) = w; } }
            }
        }
        __syncthreads();
        if (bid < 128) {
            const int isv = bid >> 6, sq = (bid >> 4) & 3;
            pg8::Gemm g; g.M = 4096; g.N = 256; g.K = 256; g.ldb = 1024; g.a_row = 16u * LDP * 2u; g.a_kstep = (size_t)LDP * 2; g.a_hstep = 128; g.a_tstep = (size_t)SEQ * LDP * 2;
            pg8::StaticOrder S; S.init(4096, 256, 16, bid & 15);
            g.A = PROJ + (isv ? C_VC : C_KC) + (size_t)(4 * sq) * LDP; g.Bt = (isv ? Wc1v_t : Wc1k_t) + 256 * sq;
            bf16_t* hdst = (bf16_t*)(wsq + WS_H12P) + (size_t)(isv * 4 + sq) * 4096 * 256;
            pg8::EpiB<0> E{hdst, 256, 256, nullptr, nullptr, nullptr, 0, nullptr}; pg8::gemm_phase<pg8::EpiB<0>, true>(ldsl, g, S, E);
        }
    }
    GSYNC();
    {
        PHASE_BEGIN(); ALLPTRS();
        {
            pg8::Gemm g = pg8::mk_gemm(A2, 384, Wl2_t, T, 1536, 384); pg8::StaticOrder S; S.init(T, 1536, G, bid);
            pg8::EpiB<2> E{LO, 1536, 1536, A.in[I_W0], A.in[I_A0], nullptr, 0, nullptr};
            pg8::gemm_phase<pg8::EpiB<2>, true>(ldsl, g, S, E);
        }
        const float* cw2 = A.in[I_CW2];
        for (int it = gw; it < 2 * 32 * 128; it += NGW) {
            const int kv = it >> 12, rowi = it & 4095, c = rowi & 127;
            bf16_t* dst = (kv ? VCB : KCB) + (size_t)rowi * 64;
            if (c == 127) { dst[lane] = 0; continue; }
            const bf16_t* Hm = (const bf16_t*)(wsq + WS_H12P) + (size_t)(kv * 4) * 4096 * 256;
            float cb0 = 0.f, cb1 = 0.f;
#pragma unroll
            for (int part = 0; part < 8; ++part) { cb0 += CB[part * 256 + kv * 128 + lane]; cb1 += CB[part * 256 + kv * 128 + 64 + lane]; }
            float h0 = cb0, h1 = cb1;
#pragma unroll
            for (int sq = 0; sq < 4; ++sq) { const bf16_t* Hs = Hm + (size_t)sq * 4096 * 256;
                h0 += bf2f(Hs[(size_t)rowi * 256 + lane]) + bf2f(Hs[(size_t)(rowi + 1) * 256 + 128 + lane]);
                h1 += bf2f(Hs[(size_t)rowi * 256 + 64 + lane]) + bf2f(Hs[(size_t)(rowi + 1) * 256 + 192 + lane]); }
            h0 = h0 * sigmoidf_(h0); h1 = h1 * sigmoidf_(h1);
            const float* w2 = cw2 + kv * 128 * 64;
            float acc = 0.f;
#pragma unroll 16
            for (int i = 0; i < 64; ++i) acc += __shfl(h0, i) * w2[i * 64 + lane];
#pragma unroll 16
            for (int i = 0; i < 64; ++i) acc += __shfl(h1, i) * w2[(64 + i) * 64 + lane];
            dst[lane] = (bf16_t)(cvt_pk_bf16(acc, 0.f) & 0xffffu);
        }
    }
    GSYNC();
    {
        PHASE_BEGIN(); ALLPTRS();
        if (bid < 128) scan_unit(A, bid, lds);
        unsigned* qheads = (unsigned*)(wsq + WS_CTL) + 6144;
        unsigned* slot = (unsigned*)(lds + 35840 + 32768 + 8192 + 512);
        const int myx = (int)(xb_xcc_id() & 7u);
        for (int qq = 0; qq < 8; ++qq) {
            const int q = (myx + qq) & 7;
            for (;;) {
                __syncthreads();
                if (tid == 0) *slot = atomicAdd(qheads + 64 * q, 1u);
                __syncthreads();
                const unsigned v = *slot;
                if (v >= 128u) break;
                const int qt = 31 - (int)(v >> 2), bh = 4 * q + (int)(v & 3);
                attn_unit(A, bh >> 1, bh & 1, qt, lds);
            }
        }
    }
    GSYNC();
    {
        PHASE_BEGIN(); ALLPTRS();
        pg8::StaticOrder S; S.init(T, 1024, G, bid);
        { pg8::Gemm g = pg8::mk_gemm(YA, 512, Woa_t, T, 1024, 512); pg8::EpiB<3> E{MB, 1024, 1024, nullptr, nullptr, (const bf16_t*)((const unsigned char*)A.out + 64 * MiB), 2048, nullptr}; pg8::gemm_phase<pg8::EpiB<3>, true>(ldsl, g, S, E); }
        asm volatile("s_waitcnt vmcnt(0)" ::: "memory"); __syncthreads();
        { pg8::Gemm g = pg8::mk_gemm(YB, 512, Wob_t, T, 1024, 512); pg8::EpiB<3> E{MB, 1024, 1024, nullptr, nullptr, (const bf16_t*)((const unsigned char*)A.out + 64 * MiB + 1024), 2048, MB}; pg8::gemm_phase<pg8::EpiB<3>, true>(ldsl, g, S, E); }
    }
    GSYNC();
    {
        PHASE_BEGIN(); ALLPTRS();
        pg8::Gemm g = pg8::mk_gemm(MB, 1024, Wo_t, T, 1024, 1024); pg8::StaticOrder S; S.init(T, 1024, G, bid);
        pg8::EpiFN<false> E{A.in[I_X], U2, 1024, (float*)(wsq + WS_PART)};
        pg8::gemm_phase<pg8::EpiFN<false>, true>(ldsl, g, S, E);
    }
    GSYNC();
    {
        PHASE_BEGIN(); ALLPTRS();
        { const float* part = (const float*)(wsq + WS_PART); float* RS = (float*)(wsq + WS_RS);
          for (int r = gtid; r < T; r += NGT) { float sum = 0.f;
#pragma unroll
              for (int q = 0; q < 16; ++q) sum += part[(size_t)q * T + r];
              RS[r] = 1.f / sqrtf(sum * (1.f / 1024.f) + 1e-6f); } }
        __syncthreads();
        pg8::Gemm g = pg8::mk_gemm(PB, 256, Wpp_t, T, 1024, 256); pg8::StaticOrder S; S.init(T, 1024, G, bid);
        pg8::EpiB<0> E{PP, 1024, 1024, nullptr, nullptr, nullptr, 0, nullptr};
        pg8::gemm_phase<pg8::EpiB<0>, true>(ldsl, g, S, E);
    }
    GSYNC();
    {
        PHASE_BEGIN(); ALLPTRS();
        pg8::Gemm g = pg8::mk_gemm(U2, DM, Wup_t, T, 5632, DM); pg8::StaticOrder S; S.init(T, 5632, G, bid);
        pg8::EpiGlu E{ACT, A.in[I_CONVW], A.in[I_CONVB], (float*)(wsq + WS_GH), (LAS float*)(ldsl + 131072), (const float*)(wsq + WS_RS)};
        pg8::gemm_phase<pg8::EpiGlu, true, true>(ldsl, g, S, E);
    }
    GSYNC();
    {
        PHASE_BEGIN(); ALLPTRS();
        pg8::Gemm g = pg8::mk_gemm(ACT, DFF, Wdn_t, T, 1024, DFF); pg8::StaticOrder S; S.init(T, 1024, G, bid);
        {
            const float* cw = A.in[I_CONVW]; const float* cb = A.in[I_CONVB]; const float* GH = (const float*)(wsq + WS_GH);
            pg8::Unit uu;
            for (int ui = 0; S.next(ui, uu); ++ui) {
                const int pm = uu.pm; if ((pm & 7) == 0) continue;
                for (int idx = tid; idx < 2 * DFF; idx += NTHREADS) {
                    const int row = idx / DFF, col = idx - row * DFF;
                    float xa[4], xb[4];
#pragma unroll
                    for (int q = 0; q < 4; ++q) { const int tp = q < 2 ? pm - 1 : pm, rr = q < 2 ? 2 + q : q - 2; xa[q] = GH[((size_t)(tp * 4 + rr) * 2 + 0) * DFF + col]; xb[q] = GH[((size_t)(tp * 4 + rr) * 2 + 1) * DFF + col]; }
                    const float a0 = row ? xa[1] : xa[0], a1 = row ? xa[2] : xa[1], a2 = row ? xa[3] : xa[2], b0 = row ? xb[1] : xb[0], b1 = row ? xb[2] : xb[1], b2 = row ? xb[3] : xb[2];
                    const float ha = cb[col] + cw[col] * a0 + cw[5632 + col] * a1 + cw[2 * 5632 + col] * a2;
                    const float hb = cb[DFF + col] + cw[DFF + col] * b0 + cw[5632 + DFF + col] * b1 + cw[2 * 5632 + DFF + col] * b2;
                    ACT[((size_t)pm * 256 + row) * DFF + col] = (bf16_t)(cvt_pk_bf16(ha * sigmoidf_(ha) * hb, 0.f) & 0xffffu);
                }
            }
            asm volatile("s_waitcnt vmcnt(0)" ::: "memory"); __syncthreads();
        }
        pg8::EpiFN<true> E{U2, U2, 1024, (float*)(wsq + WS_PART)};
        pg8::gemm_phase<pg8::EpiFN<true>, true>(ldsl, g, S, E);
    }
    GSYNC();
    {
        PHASE_BEGIN(); ALLPTRS();
        pg8::Gemm g = pg8::mk_gemm(U2, DM, Wpg_t, T, 1024, DM); pg8::StaticOrder S; S.init(T, 1024, G, bid);
        {
            const float* part = (const float*)(wsq + WS_PART); float* RS = (float*)(wsq + WS_RS); pg8::Unit uu; int lastpm = -1;
            for (int ui = 0; S.next(ui, uu); ++ui) { if (uu.pm == lastpm) continue; lastpm = uu.pm;
                if (tid < 256) { const int r = uu.pm * 256 + tid; float sum = 0.f;
#pragma unroll
                    for (int q = 0; q < 16; ++q) sum += part[(size_t)q * T + r];
                    RS[r] = 1.f / sqrtf(sum * (1.f / 1024.f) + 1e-6f); } }
            asm volatile("s_waitcnt vmcnt(0)" ::: "memory"); __syncthreads();
        }
        pg8::EpiFinal E{U2, H, 1024, PP, (const float*)(wsq + WS_RS), A.in[I_LNF], (float*)(wsq + WS_PART + 2 * MiB), (unsigned*)(wsq + WS_CTL + 32768), (LAS float*)(ldsl + 131072)};
        pg8::gemm_phase<pg8::EpiFinal, true>(ldsl, g, S, E);
    }
}

extern "C" void kernel_launch(void* const* d_in, const int* in_sizes, int n_in, void* d_out, int out_size, void* d_ws, size_t ws_size, hipStream_t stream) {
    static int grid = 0;
    if (grid == 0) {
        if (n_in != 34 || ws_size < WS_END) { fprintf(stderr, "kernel_launch: unexpected n_in %d / ws_size %zu\n", n_in, ws_size); grid = -1; return; }
        int dev = 0, cus = 0, per_cu = 0;
        hipGetDevice(&dev); hipDeviceGetAttribute(&cus, hipDeviceAttributeMultiprocessorCount, dev);
        hipFuncSetAttribute((const void*)fwd_kernel, hipFuncAttributeMaxDynamicSharedMemorySize, LDS_BYTES);
        hipOccupancyMaxActiveBlocksPerMultiprocessor(&per_cu, (const void*)fwd_kernel, NTHREADS, LDS_BYTES);
        if (per_cu < 1) { fprintf(stderr, "kernel_launch: occupancy query says %d\n", per_cu); per_cu = 1; }
        (void)hipGetLastError();
        grid = cus * 1;
        if (grid > 256) grid = 256;
    }
    if (grid < 0) return;
    hipMemsetAsync((char*)d_ws + WS_CTL, 0, 65536, stream);
    Args a{};
    for (int i = 0; i < 34; ++i) a.in[i] = (const float*)d_in[i];
    a.out = (float*)d_out; a.ws = (unsigned char*)d_ws;
    void* args[] = {&a};
    hipError_t e = hipLaunchCooperativeKernel((const void*)fwd_kernel, dim3(grid), dim3(NTHREADS), args, LDS_BYTES, stream);
    if (e != hipSuccess) fprintf(stderr, "cooperative launch failed: %s (grid %d)\n", hipGetErrorString(e), grid);
}
```

```cpp
#include <hip/hip_runtime.h>
#include <hip/hip_cooperative_groups.h>
#include <cstdio>
#include <cstdint>
namespace cg = cooperative_groups;

#define LAS __attribute__((address_space(3)))
typedef unsigned short bf16_t;
typedef short bf16x8 __attribute__((ext_vector_type(8)));
typedef short s16x4 __attribute__((ext_vector_type(4)));
typedef float f32x4 __attribute__((ext_vector_type(4)));
typedef float f32x2 __attribute__((ext_vector_type(2)));
typedef float f32x16 __attribute__((ext_vector_type(16)));
typedef unsigned u32x4 __attribute__((ext_vector_type(4)));
typedef unsigned u32x2 __attribute__((ext_vector_type(2)));

constexpr int T = 32768, SEQ = 2048, NBATCH = 16, DM = 1024, DFF = 2816, PLE = 256;
constexpr int LDP = 3416;
constexpr int C_R = 0, C_K = 512, C_V = 1024, C_Q = 1536, C_KC = 2048, C_VC = 2176, C_KS = 2304, C_VS = 2432, C_KW = 2560, C_VW = 2688, C_NG = 2816, C_L1 = 2840, C_L2 = 3128;
constexpr int WIN_LD = 4888;
constexpr float QSCALE = 0.125f * 1.4426950408889634f;
constexpr int NTHREADS = 512, NWAVES = 8;
constexpr int LDS_BYTES = 160768;

constexpr size_t MiB = 1u << 20, KiB = 1u << 10;
constexpr size_t WS_CTL = 0;
constexpr size_t WS_WIN = 1 * MiB, WS_WG = 8 * MiB, WS_WUP = 12 * MiB, WS_WDN = 23 * MiB, WS_WO = 29 * MiB, WS_WPG = 31 * MiB, WS_WOA = 33 * MiB, WS_WOB = 34 * MiB;
constexpr size_t WS_WPP = 35 * MiB, WS_WL2 = 35 * MiB + 512 * KiB, WS_WC1K = 36 * MiB + 768 * KiB, WS_WC1V = 37 * MiB + 256 * KiB, WS_CB = 37 * MiB + 768 * KiB;
constexpr size_t WS_KCB = 38 * MiB, WS_VCB = 38 * MiB + 512 * KiB, WS_H12K = 39 * MiB, WS_H12V = 41 * MiB, WS_PB = 43 * MiB;
constexpr size_t WS_PROJ = 59 * MiB, WS_LO = 273 * MiB, WS_A2 = 369 * MiB, WS_YA = 393 * MiB, WS_YB = 425 * MiB;
constexpr size_t WS_SG = 59 * MiB, WS_M = 187 * MiB, WS_U2 = 251 * MiB, WS_ACT = 59 * MiB, WS_PP = 315 * MiB, WS_H12P = 457 * MiB, WS_GH = 393 * MiB, WS_PART = 425 * MiB, WS_RS = 428 * MiB;
constexpr size_t WS_END = 491 * MiB;

__device__ __forceinline__ float bf2f(unsigned v) { return __uint_as_float(v << 16); }
typedef __bf16 bf16x2_t __attribute__((ext_vector_type(2)));
__device__ __forceinline__ unsigned cvt_pk_bf16(float lo, float hi) { const f32x2 v = {lo, hi}; const bf16x2_t b = __builtin_convertvector(v, bf16x2_t); return __builtin_bit_cast(unsigned, b); }
__device__ __forceinline__ float sigmoidf_(float x) { return __builtin_amdgcn_rcpf(1.f + __expf(-x)); }
__device__ __forceinline__ float tanhf_(float x) { return 1.f - 2.f * __builtin_amdgcn_rcpf(__expf(2.f * x) + 1.f); }
__device__ __forceinline__ void unpack8(const u32x4 w, float* f) {
    f[0] = bf2f(w.x & 0xffffu); f[1] = __uint_as_float(w.x & 0xffff0000u); f[2] = bf2f(w.y & 0xffffu); f[3] = __uint_as_float(w.y & 0xffff0000u);
    f[4] = bf2f(w.z & 0xffffu); f[5] = __uint_as_float(w.z & 0xffff0000u); f[6] = bf2f(w.w & 0xffffu); f[7] = __uint_as_float(w.w & 0xffff0000u);
}
__device__ __forceinline__ void unpack4(const u32x2 w, float* f) {
    f[0] = bf2f(w.x & 0xffffu); f[1] = __uint_as_float(w.x & 0xffff0000u); f[2] = bf2f(w.y & 0xffffu); f[3] = __uint_as_float(w.y & 0xffff0000u);
}
template <int CTRL> __device__ __forceinline__ float dpp_f(float x) { return __builtin_bit_cast(float, __builtin_amdgcn_update_dpp(0, __builtin_bit_cast(int, x), CTRL, 0xf, 0xf, true)); }
__device__ __forceinline__ float red8(float x) { x += dpp_f<0xB1>(x); x += dpp_f<0x4E>(x); x += dpp_f<0x141>(x); return x; }
__device__ __forceinline__ float red16(float x) { x = red8(x); x += dpp_f<0x140>(x); return x; }
__device__ __forceinline__ float wave_sum(float v) {
#pragma unroll
    for (int o = 1; o < 64; o <<= 1) v += __shfl_xor(v, o);
    return v;
}

namespace pg8 {
constexpr int BM = 256, BK = 64, HALF = 128, HTB = HALF * BK * 2, STAGE_BYTES = 8 * HTB, NXCD = 8, WGM = 4;
__host__ __device__ __forceinline__ int lds_byte(int r, int c) { const int st = (r >> 4) * 2 + (c >> 5), rr = r & 15, cc = c & 31, ob = rr * 64 + cc * 2; return st * 1024 + (ob ^ (((ob >> 9) & 1) << 5)); }
__host__ __device__ __forceinline__ void stage_rc(int b, int& R, int& C) { const int st = b / 1024, sb = b % 1024, swz = sb ^ (((sb >> 9) & 1) << 5); R = (st >> 1) * 16 + swz / 64; C = (st & 1) * 32 + (swz % 64) / 2; }
__host__ __device__ __forceinline__ int perm32(int rho) { const int n = rho >> 4, i = rho & 15; return 8 * (i >> 2) + 4 * n + (i & 3); }
struct Unit { int pm, pn; };
struct Gemm { const bf16_t* A; const bf16_t* Bt; int M, N, K; unsigned a_row; size_t a_kstep, a_hstep, a_tstep; int ldb; };
__device__ __forceinline__ Gemm mk_gemm(const bf16_t* A, int lda, const bf16_t* Bt, int M, int N, int K) {
    Gemm g; g.A = A; g.Bt = Bt; g.M = M; g.N = N; g.K = K; g.a_row = (unsigned)lda * 2u; g.a_kstep = 128; g.a_hstep = (size_t)HALF * lda * 2; g.a_tstep = 2 * g.a_hstep; g.ldb = K; return g;
}
struct StaticOrder {
    int nM, nN, nwg, G, c;
    __device__ __forceinline__ void init(int M, int N, int G_, int c_) { nM = M / BM; nN = N / BM; nwg = nM * nN; G = G_; c = c_; }
    __device__ __forceinline__ bool next(int i, Unit& u) const {
        const long L = (long)i * G + c; if (L >= nwg) return false;
        int wgid = (int)L; { const int q = nwg / NXCD, r = nwg % NXCD, xcd = wgid % NXCD, off = wgid / NXCD; wgid = (xcd < r ? xcd * (q + 1) : r * (q + 1) + (xcd - r) * q) + off; }
        const int nig = WGM * nN, gid = wgid / nig, fm = gid * WGM, gsz = (nM - fm) < WGM ? (nM - fm) : WGM;
        u.pm = fm + ((wgid % nig) % gsz); u.pn = (wgid % nig) / gsz; return true;
    }
};

template <int MODE> struct EpiB {
    static constexpr bool PERM = true;
    bf16_t* O; int ldc; int ncols; const float* bias; const float* bias2; const bf16_t* mul; int ldm; const bf16_t* add;
    __device__ __forceinline__ void operator()(const f32x4 (&acc)[2][2][4][2], const Unit& u, int wr, int wc, int fr, int fq) const {
        const int row0 = u.pm * BM + wr * 64 + fr, col0 = u.pn * BM + wc * 32 + 8 * fq;
#pragma unroll
        for (int ai = 0; ai < 2; ++ai)
#pragma unroll
            for (int m = 0; m < 4; ++m) {
                const size_t row = (size_t)(row0 + ai * HALF + m * 16);
#pragma unroll
                for (int bj = 0; bj < 2; ++bj) {
                    const int col = col0 + bj * HALF;
                    if (col < ncols) {
                        f32x4 v0 = acc[ai][bj][m][0], v1 = acc[ai][bj][m][1];
                        if (MODE == 1) {
                            unsigned q[8];
#pragma unroll
                            for (int e = 0; e < 4; ++e) { q[e] = (unsigned)(sigmoidf_(v0[e]) * 255.f + 0.5f); q[4 + e] = (unsigned)(sigmoidf_(v1[e]) * 255.f + 0.5f); }
                            u32x2 wq; wq.x = q[0] | (q[1] << 8) | (q[2] << 16) | (q[3] << 24); wq.y = q[4] | (q[5] << 8) | (q[6] << 16) | (q[7] << 24);
                            *(u32x2*)((unsigned char*)O + row * ldc + col) = wq;
                            continue;
                        }
                        if (MODE == 2) {
                            if (col < 1024) {
                                const float* bp = col < 512 ? bias + col : bias2 + (col - 512); const f32x4 b0 = *(const f32x4*)bp, b1 = *(const f32x4*)(bp + 4);
                                const float sc = col < 512 ? 0.6065306597f : 1.f;
#pragma unroll
                                for (int e = 0; e < 4; ++e) { v0[e] = sigmoidf_(v0[e] + b0[e]) * sc; v1[e] = sigmoidf_(v1[e] + b1[e]) * sc; }
                            }
                        }
                        if (MODE == 3) {
                            float mf[8]; { const u32x2 mq = *(const u32x2*)((const unsigned char*)mul + row * ldm + col);
#pragma unroll
                                for (int e = 0; e < 4; ++e) { mf[e] = (float)((mq.x >> (8 * e)) & 0xffu) * (1.f / 255.f); mf[4 + e] = (float)((mq.y >> (8 * e)) & 0xffu) * (1.f / 255.f); } }
#pragma unroll
                            for (int e = 0; e < 4; ++e) { v0[e] *= mf[e]; v1[e] *= mf[4 + e]; }
                            if (add) { float af[8]; unpack8(*(const u32x4*)(add + row * ldc + col), af);
#pragma unroll
                                for (int e = 0; e < 4; ++e) { v0[e] += af[e]; v1[e] += af[4 + e]; } }
                        }
                        u32x4 w; w.x = cvt_pk_bf16(v0[0], v0[1]); w.y = cvt_pk_bf16(v0[2], v0[3]); w.z = cvt_pk_bf16(v1[0], v1[1]); w.w = cvt_pk_bf16(v1[2], v1[3]);
                        *(u32x4*)(O + row * ldc + col) = w;
                    }
                }
            }
    }
};
struct EpiProj {
    static constexpr bool PERM = true;
    bf16_t* P; unsigned char* SG8;
    __device__ __forceinline__ void operator()(const f32x4 (&acc)[2][2][4][2], const Unit& u, int wr, int wc, int fr, int fq) const {
        const int row0 = u.pm * BM + wr * 64 + fr, col0 = u.pn * BM + wc * 32 + 8 * fq;
        const bool gates = u.pn >= 14;
#pragma unroll
        for (int ai = 0; ai < 2; ++ai)
#pragma unroll
            for (int m = 0; m < 4; ++m) {
                const size_t row = (size_t)(row0 + ai * HALF + m * 16);
#pragma unroll
                for (int bj = 0; bj < 2; ++bj) {
                    const int col = col0 + bj * HALF;
                    const f32x4 v0 = acc[ai][bj][m][0], v1 = acc[ai][bj][m][1];
                    if (gates) {
                        unsigned q[8];
#pragma unroll
                        for (int e = 0; e < 4; ++e) { q[e] = (unsigned)(sigmoidf_(v0[e]) * 255.f + 0.5f); q[4 + e] = (unsigned)(sigmoidf_(v1[e]) * 255.f + 0.5f); }
                        u32x2 wq; wq.x = q[0] | (q[1] << 8) | (q[2] << 16) | (q[3] << 24); wq.y = q[4] | (q[5] << 8) | (q[6] << 16) | (q[7] << 24);
                        *(u32x2*)(SG8 + row * 2048 + (col - 3584)) = wq;
                    } else if (col < LDP) {
                        u32x4 w; w.x = cvt_pk_bf16(v0[0], v0[1]); w.y = cvt_pk_bf16(v0[2], v0[3]); w.z = cvt_pk_bf16(v1[0], v1[1]); w.w = cvt_pk_bf16(v1[2], v1[3]);
                        *(u32x4*)(P + row * LDP + col) = w;
                    }
                }
            }
    }
};
template <int MODE> struct EpiF {
    static constexpr bool PERM = true;
    const float* base; float* out; int ldc; const bf16_t* pp; const float* rs;
    __device__ __forceinline__ void operator()(const f32x4 (&acc)[2][2][4][2], const Unit& u, int wr, int wc, int fr, int fq) const {
        const int row0 = u.pm * BM + wr * 64 + fr, col0 = u.pn * BM + wc * 32 + 8 * fq;
#pragma unroll
        for (int ai = 0; ai < 2; ++ai)
#pragma unroll
            for (int m = 0; m < 4; ++m) {
                const size_t row = (size_t)(row0 + ai * HALF + m * 16);
#pragma unroll
                for (int bj = 0; bj < 2; ++bj) {
                    const size_t off = row * ldc + col0 + bj * HALF;
                    f32x4 v0 = acc[ai][bj][m][0], v1 = acc[ai][bj][m][1];
                    if (MODE == 1) {
                        float pf[8]; unpack8(*(const u32x4*)(pp + off), pf); const float rr = rs[row];
#pragma unroll
                        for (int e = 0; e < 4; ++e) { v0[e] = sigmoidf_(v0[e] * rr) * pf[e]; v1[e] = sigmoidf_(v1[e] * rr) * pf[4 + e]; }
                    }
                    const f32x4 b0 = *(const f32x4*)(base + off), b1 = *(const f32x4*)(base + off + 4);
                    *(f32x4*)(out + off) = b0 + v0; *(f32x4*)(out + off + 4) = b1 + v1;
                }
                asm volatile("" ::: "memory");
            }
    }
};

template <bool BASEBF> struct EpiFN {
    static constexpr bool PERM = true;
    const void* base; bf16_t* hb; int ldc; float* part;
    __device__ __forceinline__ void operator()(const f32x4 (&acc)[2][2][4][2], const Unit& u, int wr, int wc, int fr, int fq) const {
        const int row0 = u.pm * BM + wr * 64 + fr, col0 = u.pn * BM + wc * 32 + 8 * fq;
        f32x4 bv[4][2][2]; u32x4 bw[4][2];
        auto fetch = [&](int gi) { const size_t row = (size_t)(row0 + (gi >> 2) * HALF + (gi & 3) * 16);
#pragma unroll
            for (int bj = 0; bj < 2; ++bj) { const size_t off = row * ldc + col0 + bj * HALF;
                if (BASEBF) bw[gi & 3][bj] = *(const u32x4*)((const bf16_t*)base + off);
                else { bv[gi & 3][bj][0] = *(const f32x4*)((const float*)base + off); bv[gi & 3][bj][1] = *(const f32x4*)((const float*)base + off + 4); } } };
        fetch(0); fetch(1); fetch(2);
#pragma unroll
        for (int gi = 0; gi < 8; ++gi) {
            const int ai = gi >> 2, m = gi & 3;
            if (gi + 3 < 8) fetch(gi + 3);
            const size_t row = (size_t)(row0 + ai * HALF + m * 16);
            float ss = 0.f;
#pragma unroll
            for (int bj = 0; bj < 2; ++bj) {
                const size_t off = row * ldc + col0 + bj * HALF;
                f32x4 o0, o1;
                if (BASEBF) { float bf[8]; unpack8(bw[gi & 3][bj], bf); o0 = (f32x4){bf[0], bf[1], bf[2], bf[3]} + acc[ai][bj][m][0]; o1 = (f32x4){bf[4], bf[5], bf[6], bf[7]} + acc[ai][bj][m][1]; }
                else { o0 = bv[gi & 3][bj][0] + acc[ai][bj][m][0]; o1 = bv[gi & 3][bj][1] + acc[ai][bj][m][1]; }
                ss += (o0[0] * o0[0] + o0[1] * o0[1]) + (o0[2] * o0[2] + o0[3] * o0[3]) + (o1[0] * o1[0] + o1[1] * o1[1]) + (o1[2] * o1[2] + o1[3] * o1[3]);
                u32x4 w; w.x = cvt_pk_bf16(o0[0], o0[1]); w.y = cvt_pk_bf16(o0[2], o0[3]); w.z = cvt_pk_bf16(o1[0], o1[1]); w.w = cvt_pk_bf16(o1[2], o1[3]);
                *(u32x4*)(hb + off) = w;
            }
            ss += __shfl_xor(ss, 16); ss += __shfl_xor(ss, 32);
            if (fq == 0) part[(size_t)(u.pn * 4 + wc) * T + row] = ss;
        }
    }
};
struct EpiFinal {
    static constexpr bool PERM = true;
    const bf16_t* base; float* out; int ldc; const bf16_t* pp; const float* rs; const float* gf; float* xch; unsigned* cnt; LAS float* lds;
    __device__ __forceinline__ void operator()(f32x4 (&acc)[2][2][4][2], const Unit& u, int wr, int wc, int fr, int fq) const {
        const int row0 = u.pm * BM + wr * 64 + fr, col0 = u.pn * BM + wc * 32 + 8 * fq;
        const int tid = threadIdx.x;
        LAS float* P = lds;
        LAS float* S = lds + 1024;
        u32x4 bv[2][2]; u32x4 pv[2][2]; float rrv[2];
        auto fetch = [&](int gi) { const int rl = (gi >> 2) * HALF + wr * 64 + (gi & 3) * 16 + fr; const size_t row = (size_t)u.pm * BM + rl; rrv[gi & 1] = rs[row];
#pragma unroll
            for (int bj = 0; bj < 2; ++bj) { const size_t off = row * ldc + col0 + bj * HALF; bv[gi & 1][bj] = *(const u32x4*)(base + off); pv[gi & 1][bj] = *(const u32x4*)(pp + off); } };
        fetch(0);
#pragma unroll
        for (int gi = 0; gi < 8; ++gi) {
            const int ai = gi >> 2, m = gi & 3;
            if (gi + 1 < 8) fetch(gi + 1);
            const int rl = ai * HALF + wr * 64 + m * 16 + fr;
            const float rr = rrv[gi & 1];
            float ss = 0.f;
#pragma unroll
            for (int bj = 0; bj < 2; ++bj) {
                float pf[8]; unpack8(pv[gi & 1][bj], pf);
                float bfv[8]; unpack8(bv[gi & 1][bj], bfv); const f32x4 b0 = (f32x4){bfv[0], bfv[1], bfv[2], bfv[3]}, b1 = (f32x4){bfv[4], bfv[5], bfv[6], bfv[7]};
                f32x4 v0 = acc[ai][bj][m][0], v1 = acc[ai][bj][m][1];
#pragma unroll
                for (int e = 0; e < 4; ++e) { v0[e] = b0[e] + sigmoidf_(v0[e] * rr) * pf[e]; v1[e] = b1[e] + sigmoidf_(v1[e] * rr) * pf[4 + e]; }
                acc[ai][bj][m][0] = v0; acc[ai][bj][m][1] = v1;
                ss += (v0[0] * v0[0] + v0[1] * v0[1]) + (v0[2] * v0[2] + v0[3] * v0[3]) + (v1[0] * v1[0] + v1[1] * v1[1]) + (v1[2] * v1[2] + v1[3] * v1[3]);
            }
            ss += __shfl_xor(ss, 16); ss += __shfl_xor(ss, 32);
            if (fq == 0) P[rl * 4 + wc] = ss;
        }
        (void)row0;
        asm volatile("s_waitcnt lgkmcnt(0)" ::: "memory"); __builtin_amdgcn_s_barrier(); asm volatile("" ::: "memory");
        if (tid < 256) { const float sp = (P[tid * 4] + P[tid * 4 + 1]) + (P[tid * 4 + 2] + P[tid * 4 + 3]);
            __hip_atomic_store(xch + ((size_t)(u.pm * 4 + u.pn) * 256 + tid), sp, __ATOMIC_RELAXED, __HIP_MEMORY_SCOPE_AGENT); }
        asm volatile("s_waitcnt vmcnt(0)" ::: "memory"); __builtin_amdgcn_s_barrier(); asm volatile("" ::: "memory");
        if (tid == 0) {
            unsigned* c = cnt + 64 * u.pm;
            __hip_atomic_fetch_add(c, 1u, __ATOMIC_RELEASE, __HIP_MEMORY_SCOPE_AGENT);
            unsigned spin = 0;
            while (__hip_atomic_load(c, __ATOMIC_RELAXED, __HIP_MEMORY_SCOPE_AGENT) < 4u) { __builtin_amdgcn_s_sleep(2); if (++spin > (1u << 22)) break; }
            __builtin_amdgcn_fence(__ATOMIC_ACQUIRE, "agent");
            asm volatile("s_waitcnt vmcnt(0)" ::: "memory");
        }
        __builtin_amdgcn_s_barrier(); asm volatile("" ::: "memory");
        if (tid < 256) { float tot = 0.f;
#pragma unroll
            for (int q = 0; q < 4; ++q) tot += __hip_atomic_load(xch + ((size_t)(u.pm * 4 + q) * 256 + tid), __ATOMIC_RELAXED, __HIP_MEMORY_SCOPE_AGENT);
            S[tid] = 1.f / sqrtf(tot * (1.f / 1024.f) + 1e-6f); }
        asm volatile("s_waitcnt vmcnt(0) lgkmcnt(0)" ::: "memory"); __builtin_amdgcn_s_barrier(); asm volatile("" ::: "memory");
        f32x4 gv[2][2];
#pragma unroll
        for (int bj = 0; bj < 2; ++bj) { gv[bj][0] = *(const f32x4*)(gf + col0 + bj * HALF); gv[bj][1] = *(const f32x4*)(gf + col0 + bj * HALF + 4); }
#pragma unroll
        for (int ai = 0; ai < 2; ++ai)
#pragma unroll
            for (int m = 0; m < 4; ++m) {
                const int rl = ai * HALF + wr * 64 + m * 16 + fr;
                const size_t row = (size_t)u.pm * BM + rl;
                const float sr = S[rl];
#pragma unroll
                for (int bj = 0; bj < 2; ++bj) { const size_t off = row * ldc + col0 + bj * HALF;
                    *(f32x4*)(out + off) = acc[ai][bj][m][0] * sr * gv[bj][0]; *(f32x4*)(out + off + 4) = acc[ai][bj][m][1] * sr * gv[bj][1]; }
            }
        asm volatile("s_waitcnt lgkmcnt(0)" ::: "memory"); __builtin_amdgcn_s_barrier(); asm volatile("" ::: "memory");
    }
};
struct EpiGlu {
    static constexpr bool PERM = true;
    bf16_t* ACT; const float* cw; const float* cb; float* GH; LAS float* halo; const float* rs;
    __device__ __forceinline__ void operator()(const f32x4 (&accr)[2][2][4][2], const Unit& u, int wr, int wc, int fr, int fq) const {
        const int colp = u.pn * 128 + wc * 32 + fq * 8;
        f32x4 acc[2][2][4][2];
        { const size_t tk = (size_t)u.pm * BM + 8 * (16 * wr + fr); const f32x4 r0 = *(const f32x4*)(rs + tk), r1 = *(const f32x4*)(rs + tk + 4);
#pragma unroll
          for (int ai = 0; ai < 2; ++ai)
#pragma unroll
              for (int m = 0; m < 4; ++m) { const float rr = ai ? r1[m] : r0[m];
#pragma unroll
                  for (int bj = 0; bj < 2; ++bj) { acc[ai][bj][m][0] = accr[ai][bj][m][0] * rr; acc[ai][bj][m][1] = accr[ai][bj][m][1] * rr; } } }
        if (wr == 0 && fr == 15) {
#pragma unroll
            for (int bj = 0; bj < 2; ++bj)
#pragma unroll
                for (int jj = 0; jj < 2; ++jj) { LAS float* h = halo + (((wc * 4 + fq) * 2 + bj) * 2 + jj) * 8; *(LAS f32x4*)h = acc[1][bj][2 + jj][0]; *(LAS f32x4*)(h + 4) = acc[1][bj][2 + jj][1]; }
        }
        if (wr == 0 && fr == 0) {
#pragma unroll
            for (int bj = 0; bj < 2; ++bj)
#pragma unroll
                for (int jj = 0; jj < 2; ++jj) { float* gp = GH + ((size_t)(u.pm * 4 + jj) * 2 + bj) * DFF + colp; *(f32x4*)gp = acc[0][bj][jj][0]; *(f32x4*)(gp + 4) = acc[0][bj][jj][1]; }
        }
        if (wr == 1 && fr == 15) {
#pragma unroll
            for (int bj = 0; bj < 2; ++bj)
#pragma unroll
                for (int jj = 0; jj < 2; ++jj) { float* gp = GH + ((size_t)(u.pm * 4 + 2 + jj) * 2 + bj) * DFF + colp; *(f32x4*)gp = acc[1][bj][2 + jj][0]; *(f32x4*)(gp + 4) = acc[1][bj][2 + jj][1]; }
        }
        asm volatile("s_waitcnt lgkmcnt(0)" ::: "memory"); __builtin_amdgcn_s_barrier(); asm volatile("" ::: "memory");
        const size_t tok0 = (size_t)u.pm * BM + 8 * (16 * wr + fr);
#pragma unroll
        for (int n = 0; n < 2; ++n) {
            f32x4 xm1[2], xm2[2];
#pragma unroll
            for (int bj = 0; bj < 2; ++bj) {
#pragma unroll
                for (int e = 0; e < 4; ++e) { xm1[bj][e] = dpp_f<0x111>(acc[1][bj][3][n][e]); xm2[bj][e] = dpp_f<0x111>(acc[1][bj][2][n][e]); }
                if (fr == 0) {
                    if (wr == 1) { const LAS float* h = halo + (((wc * 4 + fq) * 2 + bj) * 2) * 8 + 4 * n; xm2[bj] = *(const LAS f32x4*)h; xm1[bj] = *(const LAS f32x4*)(h + 8); }
                    else { xm1[bj] = (f32x4){0.f, 0.f, 0.f, 0.f}; xm2[bj] = xm1[bj]; }
                }
            }
            const int c0 = colp + 4 * n;
            const f32x4 wa0 = *(const f32x4*)(cw + c0), wa1 = *(const f32x4*)(cw + 5632 + c0), wa2 = *(const f32x4*)(cw + 2 * 5632 + c0), ba = *(const f32x4*)(cb + c0);
            const f32x4 wb0 = *(const f32x4*)(cw + DFF + c0), wb1 = *(const f32x4*)(cw + 5632 + DFF + c0), wb2 = *(const f32x4*)(cw + 2 * 5632 + DFF + c0), bb = *(const f32x4*)(cb + DFF + c0);
#pragma unroll
            for (int j = 0; j < 8; ++j) {
                const f32x4 xa = acc[j >> 2][0][j & 3][n], xb = acc[j >> 2][1][j & 3][n];
                const f32x4 ha = ba + wa0 * xm2[0] + wa1 * xm1[0] + wa2 * xa, hb = bb + wb0 * xm2[1] + wb1 * xm1[1] + wb2 * xb;
                float o[4];
#pragma unroll
                for (int e = 0; e < 4; ++e) o[e] = ha[e] * sigmoidf_(ha[e]) * hb[e];
                u32x2 w; w.x = cvt_pk_bf16(o[0], o[1]); w.y = cvt_pk_bf16(o[2], o[3]);
                *(u32x2*)(ACT + (tok0 + j) * DFF + c0) = w;
                xm2[0] = xm1[0]; xm1[0] = xa; xm2[1] = xm1[1]; xm1[1] = xb;
            }
        }
    }
};

template <class Epi, bool ALIGN_EPI, bool ROWPERM = false>
__device__ __forceinline__ void gemm_phase(LAS unsigned char* lds, const Gemm g, const StaticOrder& S, const Epi& E) {
    int tid = threadIdx.x; asm volatile("" : "+v"(tid));
    const int wid = __builtin_amdgcn_readfirstlane(tid >> 6), lane = tid & 63, wr = wid >> 2, wc = wid & 3, fr = lane & 15, fq = lane >> 4;
    const int K = g.K, nt = K / BK;
    unsigned voffA[2], voffA1[2], voffB[2];
#pragma unroll
    for (int i = 0; i < 2; ++i) { int R, C; stage_rc(tid * 16 + i * 8192, R, C); const int Rb = Epi::PERM ? ((R & ~31) + perm32(R & 31)) : R;
        if constexpr (ROWPERM) { const int tau0 = 8 * (16 * (R >> 6) + (R & 15)) + ((R >> 4) & 3);
            voffA[i] = (unsigned)tau0 * g.a_row + (unsigned)C * 2u; voffA1[i] = (unsigned)(tau0 + 4) * g.a_row + (unsigned)C * 2u; }
        else { voffA[i] = (unsigned)R * g.a_row + (unsigned)C * 2u; voffA1[i] = 0u; }
        voffB[i] = (unsigned)(Rb * g.ldb + C) * 2u; }
#define PG8_STAGE_A1(bufoff, gbase) do { if constexpr (ROWPERM) { PG8_STAGE(bufoff, gbase, voffA1); } else { PG8_STAGE(bufoff, (gbase) + ahstep, voffA); } } while (0)
    const size_t akstep = g.a_kstep, ahstep = g.a_hstep, atstep = g.a_tstep;
    const size_t bkstep = (size_t)(BK * 2), bhstep = (size_t)HALF * g.ldb * 2, btstep = 2 * bhstep;
    const unsigned ldsw = (unsigned)wid * 1024u;
    const int aoff = lds_byte(wr * 64 + fr, fq * 8), boff = lds_byte(wc * 32 + fr, fq * 8);
#define PG8_SA(b, h) (((b) * 2 + (h)) * HTB)
#define PG8_SB(b, h) ((4 + (b) * 2 + (h)) * HTB)
#define PG8_STAGE(bufoff, gbase, voff) do { _Pragma("unroll") for (int _i = 0; _i < 2; ++_i) \
        __builtin_amdgcn_global_load_lds((const unsigned*)((const char*)(gbase) + (voff)[_i]), (LAS unsigned*)(lds + (bufoff) + ldsw + _i * 8192), 16, 0, 0); } while (0)
#define PG8_LDA(dst, b, h) do { _Pragma("unroll") for (int m = 0; m < 4; ++m) _Pragma("unroll") for (int k = 0; k < 2; ++k) dst[m][k] = *(const LAS bf16x8*)(lds + PG8_SA(b, h) + aoff + m * 2048 + k * 1024); } while (0)
#define PG8_LDB(dst, b, h) do { _Pragma("unroll") for (int n = 0; n < 2; ++n) _Pragma("unroll") for (int k = 0; k < 2; ++k) dst[n][k] = *(const LAS bf16x8*)(lds + PG8_SB(b, h) + boff + n * 2048 + k * 1024); } while (0)
#define PG8_MMA(ai, bj, At, Bt) do { __builtin_amdgcn_s_setprio(1); _Pragma("unroll") for (int m = 0; m < 4; ++m) _Pragma("unroll") for (int n = 0; n < 2; ++n) _Pragma("unroll") for (int k = 0; k < 2; ++k) \
        acc[ai][bj][m][n] = __builtin_amdgcn_mfma_f32_16x16x32_bf16(Bt[n][k], At[m][k], acc[ai][bj][m][n], 0, 0, 0); __builtin_amdgcn_s_setprio(0); } while (0)
#define PG8_WAIT_V(n) asm volatile("s_waitcnt vmcnt(" #n ")" ::: "memory")
#define PG8_WAIT_L(n) asm volatile("s_waitcnt lgkmcnt(" #n ")" ::: "memory")
#define PG8_BAR __builtin_amdgcn_s_barrier()
#define PG8_SCHED __builtin_amdgcn_sched_barrier(0)
    Unit cur, nxt; int ui = 0;
    if (!S.next(0, cur)) return;
    f32x4 acc[2][2][4][2];
#pragma unroll
    for (int a = 0; a < 2; ++a)
#pragma unroll
        for (int b = 0; b < 2; ++b)
#pragma unroll
            for (int m = 0; m < 4; ++m)
#pragma unroll
                for (int n = 0; n < 2; ++n) acc[a][b][m][n] = (f32x4){0.f, 0.f, 0.f, 0.f};
    bf16x8 At[4][2], B0[2][2], B1[2][2];
    const char* cA = (const char*)g.A + (size_t)cur.pm * atstep; const char* cB = (const char*)g.Bt + (size_t)cur.pn * btstep;
    PG8_STAGE(PG8_SB(0, 0), cB, voffB); PG8_STAGE(PG8_SB(0, 1), cB + bhstep, voffB); PG8_STAGE(PG8_SA(0, 0), cA, voffA); PG8_STAGE_A1(PG8_SA(0, 1), cA);
    if (wr == 1) PG8_BAR;
    PG8_WAIT_V(2); PG8_BAR;
    PG8_STAGE(PG8_SB(1, 0), cB + bkstep, voffB); PG8_STAGE(PG8_SA(1, 0), cA + akstep, voffA); PG8_STAGE(PG8_SB(1, 1), cB + bhstep + bkstep, voffB);
    PG8_WAIT_V(6); PG8_BAR;
    for (;;) {
        const bool has_next = S.next(ui + 1, nxt);
        const char* nA = has_next ? (const char*)g.A + (size_t)nxt.pm * atstep : cA; const char* nB = has_next ? (const char*)g.Bt + (size_t)nxt.pn * btstep : cB;
        for (int t = 0; t < nt; t += 2) {
            const bool last = (t == nt - 2);
            const char* a1 = cA + (size_t)(t + 1) * akstep;
            const char* a2 = last ? nA : cA + (size_t)(t + 2) * akstep; const char* b2 = last ? nB : cB + (size_t)(t + 2) * bkstep;
            const char* a3 = a2 + akstep; const char* b3 = b2 + bkstep;
            PG8_LDB(B0, 0, 0); PG8_LDB(B1, 0, 1); PG8_SCHED; PG8_LDA(At, 0, 0); PG8_STAGE_A1(PG8_SA(1, 1), a1);
            PG8_WAIT_V(8); PG8_WAIT_L(0); PG8_BAR; PG8_MMA(0, 0, At, B0); PG8_MMA(0, 1, At, B1); PG8_BAR; PG8_SCHED;
            PG8_LDA(At, 0, 1); PG8_STAGE(PG8_SB(0, 0), b2, voffB); PG8_STAGE(PG8_SB(0, 1), b2 + bhstep, voffB); PG8_STAGE(PG8_SA(0, 0), a2, voffA);
            PG8_WAIT_V(8); PG8_WAIT_L(0); PG8_BAR; PG8_MMA(1, 0, At, B0); PG8_MMA(1, 1, At, B1); PG8_BAR; PG8_SCHED;
            PG8_LDB(B0, 1, 0); PG8_LDB(B1, 1, 1); PG8_SCHED; PG8_LDA(At, 1, 0); PG8_STAGE_A1(PG8_SA(0, 1), a2);
            PG8_WAIT_V(8); PG8_WAIT_L(0); PG8_BAR; PG8_MMA(0, 0, At, B0); PG8_MMA(0, 1, At, B1); PG8_BAR; PG8_SCHED;
            PG8_LDA(At, 1, 1); PG8_STAGE(PG8_SB(1, 0), b3, voffB); PG8_STAGE(PG8_SB(1, 1), b3 + bhstep, voffB); PG8_STAGE(PG8_SA(1, 0), a3, voffA);
            PG8_WAIT_V(8); PG8_WAIT_L(0); PG8_BAR; PG8_MMA(1, 0, At, B0); PG8_MMA(1, 1, At, B1); PG8_BAR; PG8_SCHED;
        }
        if constexpr (ALIGN_EPI) { if (wr == 0) PG8_BAR; }
        E(acc, cur, wr, wc, fr, fq);
        if (!has_next) break;
#pragma unroll
        for (int a = 0; a < 2; ++a)
#pragma unroll
            for (int b = 0; b < 2; ++b)
#pragma unroll
                for (int m = 0; m < 4; ++m)
#pragma unroll
                    for (int n = 0; n < 2; ++n) acc[a][b][m][n] = (f32x4){0.f, 0.f, 0.f, 0.f};
        cur = nxt; cA = nA; cB = nB; ++ui;
        if constexpr (ALIGN_EPI) { if (wr == 1) PG8_BAR; }
    }
    PG8_WAIT_V(0);
    if constexpr (!ALIGN_EPI) { if (wr == 0) PG8_BAR; }
    PG8_BAR;
#undef PG8_SA
#undef PG8_SB
#undef PG8_STAGE
#undef PG8_STAGE_A1
#undef PG8_LDA
#undef PG8_LDB
#undef PG8_MMA
#undef PG8_WAIT_V
#undef PG8_WAIT_L
#undef PG8_BAR
#undef PG8_SCHED
}
}

struct Args {
    const float* in[34];
    float* out; unsigned char* ws;
};
enum { I_X = 0, I_P, I_LN1, I_WIN, I_MURKV, I_MUWAG, I_W0, I_W1, I_W2, I_A0, I_A1, I_A2, I_G1, I_G2, I_KK, I_KA, I_RK, I_LNXG, I_LNXB, I_CPOS, I_CW1, I_CW2,
       I_WOA, I_WOB, I_WO, I_LN2, I_WUP, I_CONVW, I_CONVB, I_WDN, I_LN3, I_WPG, I_WPP, I_LNF };

template <class F> __device__ __forceinline__ void tr_matrix(F f, int Kd, int Nd, bf16_t* WT, float* scr, int gw, int NGW, int lane) {
    const int nblk = Nd / 32, nitems = (Kd / 64) * nblk;
    for (int item = gw; item < nitems; item += NGW) {
        const int kb = item / nblk, nb = item % nblk, k0 = 64 * kb, n0 = 32 * nb;
#pragma unroll 16
        for (int i = 0; i < 32; ++i) { const int kk = 2 * i + (lane >> 5); scr[kk * 33 + (lane & 31)] = f(k0 + kk, n0 + (lane & 31)); }
        asm volatile("s_waitcnt lgkmcnt(0)" ::: "memory");
        const int c = lane & 7;
#pragma unroll
        for (int j = 0; j < 4; ++j) { const int n = (lane >> 3) + 8 * j; const float* s = scr + (8 * c) * 33 + n;
            u32x4 o; o.x = cvt_pk_bf16(s[0 * 33], s[1 * 33]); o.y = cvt_pk_bf16(s[2 * 33], s[3 * 33]); o.z = cvt_pk_bf16(s[4 * 33], s[5 * 33]); o.w = cvt_pk_bf16(s[6 * 33], s[7 * 33]);
            *(u32x4*)(WT + (size_t)(n0 + n) * Kd + k0 + 8 * c) = o; }
        asm volatile("s_waitcnt lgkmcnt(0)" ::: "memory");
    }
}
template <bool OUT_BF16, bool NT = false> __device__ __forceinline__ void rms_rows(float* x, const float* g, bf16_t* ob, int gw, int NGW, int lane) {
    const f32x4* gr = (const f32x4*)g + lane;
    f32x4 gg[4];
#pragma unroll
    for (int j = 0; j < 4; ++j) gg[j] = gr[64 * j];
    for (int r0 = gw; r0 < T; r0 += 4 * NGW) {
        f32x4 v[4][4];
#pragma unroll
        for (int u = 0; u < 4; ++u) { const int r = r0 + u * NGW; if (r < T) { const f32x4* xr = (const f32x4*)(x + (size_t)r * DM) + lane;
#pragma unroll
            for (int j = 0; j < 4; ++j) v[u][j] = NT ? __builtin_nontemporal_load(xr + 64 * j) : xr[64 * j]; } }
#pragma unroll
        for (int u = 0; u < 4; ++u) { const int r = r0 + u * NGW; if (r < T) {
            float s = 0.f;
#pragma unroll
            for (int j = 0; j < 4; ++j) s += (v[u][j].x * v[u][j].x + v[u][j].y * v[u][j].y) + (v[u][j].z * v[u][j].z + v[u][j].w * v[u][j].w);
            const float rs = 1.f / sqrtf(wave_sum(s) * (1.f / 1024.f) + 1e-6f);
            if (OUT_BF16) { u32x2* o8 = (u32x2*)(ob + (size_t)r * DM) + lane;
#pragma unroll
                for (int j = 0; j < 4; ++j) { u32x2 w; w.x = cvt_pk_bf16(v[u][j].x * rs * gg[j].x, v[u][j].y * rs * gg[j].y); w.y = cvt_pk_bf16(v[u][j].z * rs * gg[j].z, v[u][j].w * rs * gg[j].w); o8[64 * j] = w; }
            } else { f32x4* xr = (f32x4*)(x + (size_t)r * DM) + lane;
#pragma unroll
                for (int j = 0; j < 4; ++j) xr[64 * j] = v[u][j] * rs * gg[j]; }
        } }
    }
}

__device__ __forceinline__ bf16x8 afrag(const bf16_t* base, int pitch, int row, int kofs, int hi) {
    const bf16_t* p = base + row * pitch + kofs + 4 * hi;
    const s16x4 lo = *(const s16x4*)p, hh = *(const s16x4*)(p + 8);
    return (bf16x8){lo[0], lo[1], lo[2], lo[3], hh[0], hh[1], hh[2], hh[3]};
}
__device__ __forceinline__ bf16x8 pack8(const f32x16& a, int b) {
    u32x4 w; w.x = cvt_pk_bf16(a[b + 0], a[b + 1]); w.y = cvt_pk_bf16(a[b + 2], a[b + 3]); w.z = cvt_pk_bf16(a[b + 4], a[b + 5]); w.w = cvt_pk_bf16(a[b + 6], a[b + 7]);
    return __builtin_bit_cast(bf16x8, w);
}
#define LBAR() asm volatile("s_waitcnt lgkmcnt(0)\n\ts_barrier" ::: "memory")
constexpr int SC_KK = 0, SC_WW = 8192, SC_BB = 16384, SC_K2 = 24576, SC_RR = 32768, SC_YY = 40960, SC_VV = 49152  , SC_BON = 73728  ;
constexpr int SC_KBT = 74240  , SC_CT = 82944  , SC_OPS = 93440  , SC_OPB = 15616;
constexpr int SC_TAB = 155904;
constexpr int OP_XT = 0, OP_KB = 4352, OP_VT = 8960, OP_WL = 11520, OP_A3 = 11776, OP_A4 = 13056, OP_A5 = 14336;
static_assert(SC_OPS + 4 * SC_OPB <= SC_TAB && SC_TAB + 2048 <= LDS_BYTES - 64, "scan LDS map");
__device__ __forceinline__ void scan_unit(const Args& A, int bh, unsigned char* L) {
    int tid = threadIdx.x; asm volatile("" : "+v"(tid));
    const int b = bh >> 3, h = bh & 7;
    const bf16_t* PROJ = (const bf16_t*)(A.ws + WS_PROJ); const bf16_t* LO = (const bf16_t*)(A.ws + WS_LO); bf16_t* YA = (bf16_t*)(A.ws + WS_YA);
    float* KK = (float*)(L + SC_KK); float* WW = (float*)(L + SC_WW); float* BB = (float*)(L + SC_BB); float* K2 = (float*)(L + SC_K2); float* RR = (float*)(L + SC_RR); float* YY = (float*)(L + SC_YY);
    const int tt = tid >> 4, c4 = (tid & 15) * 4, ch = h * 64 + c4;
    const int lane = tid & 63, wv = __builtin_amdgcn_readfirstlane(tid >> 6), r32 = lane & 31, hi = lane >> 5;
    float* TAB = (float*)(L + SC_TAB);
    if (tid < 64) { const int cc = h * 64 + tid;
        TAB[tid] = A.in[I_MURKV][cc]; TAB[64 + tid] = A.in[I_MURKV][512 + cc]; TAB[128 + tid] = A.in[I_MURKV][1024 + cc]; TAB[192 + tid] = A.in[I_KK][cc];
        TAB[256 + tid] = A.in[I_KA][cc]; TAB[320 + tid] = A.in[I_RK][cc]; TAB[384 + tid] = A.in[I_LNXG][cc]; TAB[448 + tid] = A.in[I_LNXB][cc]; }
    LBAR();
    const f32x16 zero16s = (f32x16){0.f,0.f,0.f,0.f,0.f,0.f,0.f,0.f,0.f,0.f,0.f,0.f,0.f,0.f,0.f,0.f};
    f32x16 St[2]; St[0] = zero16s; St[1] = zero16s;
    u32x2 raw[9];
    float gq_prev[4] = {0.f, 0.f, 0.f, 0.f}, gq_cur[4] = {0.f, 0.f, 0.f, 0.f}, gq_next[4];
    auto load_raw = [&](int chunk) {
        const size_t t = (size_t)b * SEQ + chunk * 32 + tt;
        const bf16_t* p = PROJ + t * LDP + ch;
        raw[0] = *(const u32x2*)(p + C_R); raw[1] = *(const u32x2*)(p + C_K); raw[2] = *(const u32x2*)(p + C_V);
        if (chunk == 0 && tt == 0) { raw[3] = (u32x2){0u, 0u}; raw[4] = raw[3]; raw[5] = raw[3]; }
        else { raw[3] = *(const u32x2*)(p - LDP + C_R); raw[4] = *(const u32x2*)(p - LDP + C_K); raw[5] = *(const u32x2*)(p - LDP + C_V); }
        const bf16_t* q = LO + t * 1536 + ch;
        raw[6] = *(const u32x2*)(q); raw[7] = *(const u32x2*)(q + 512); raw[8] = *(const u32x2*)(q + 1024);
    };
    auto prep = [&](int c) {
        float* VV = (float*)(L + SC_VV + (c % 3) * 8192); float* BON = (float*)(L + SC_BON + (c % 3) * 128);
        float r[4], k[4], v[4], rp[4], kp[4], vp[4], ew[4], a[4];
        unpack4(raw[0], r); unpack4(raw[1], k); unpack4(raw[2], v); unpack4(raw[3], rp); unpack4(raw[4], kp); unpack4(raw[5], vp); unpack4(raw[6], ew); unpack4(raw[7], a); unpack4(raw[8], gq_next);
        const f32x4 mu_r = *(const f32x4*)(TAB + c4), mu_k = *(const f32x4*)(TAB + 64 + c4), mu_v = *(const f32x4*)(TAB + 128 + c4), k_k = *(const f32x4*)(TAB + 192 + c4), k_a = *(const f32x4*)(TAB + 256 + c4), r_k = *(const f32x4*)(TAB + 320 + c4);
        float kku[4], k2[4], ss = 0.f, bon = 0.f;
#pragma unroll
        for (int e = 0; e < 4; ++e) { r[e] += (rp[e] - r[e]) * mu_r[e]; k[e] += (kp[e] - k[e]) * mu_k[e]; v[e] += (vp[e] - v[e]) * mu_v[e];
            kku[e] = k[e] * k_k[e]; ss += kku[e] * kku[e]; k2[e] = k[e] * (1.f + (a[e] - 1.f) * k_a[e]); bon += r[e] * k2[e] * r_k[e]; }
        ss = red16(ss); bon = red16(bon);
        const float inv = fminf(__builtin_amdgcn_rsqf(ss), 1e12f);
        f32x4 kk4, w4, b4, k24, r4, v4;
#pragma unroll
        for (int e = 0; e < 4; ++e) { const float kk = kku[e] * inv; kk4[e] = kk; w4[e] = __expf(-ew[e]); b4[e] = kk * a[e]; k24[e] = k2[e]; r4[e] = r[e]; v4[e] = v[e]; }
        const int o = tt * 64 + c4;
        *(f32x4*)(KK + o) = kk4; *(f32x4*)(WW + o) = w4; *(f32x4*)(BB + o) = b4; *(f32x4*)(K2 + o) = k24; *(f32x4*)(RR + o) = r4; *(f32x4*)(VV + o) = v4;
        if ((tid & 15) == 0) BON[tt] = bon;
    };
    auto stageB = [&](int c) {
        const float* VV = (const float*)(L + SC_VV + (c % 3) * 8192);
        const int sc = wv >> 2, tq = wv & 3, k = lane;
        unsigned char* blk = L + SC_OPS + ((c & 1) * 2 + sc) * SC_OPB;
        bf16_t* XT = (bf16_t*)(blk + OP_XT); bf16_t* KB = (bf16_t*)(blk + OP_KB); bf16_t* VTt = (bf16_t*)(blk + OP_VT); float* WL = (float*)(blk + OP_WL); bf16_t* KBT = (bf16_t*)(L + SC_KBT + sc * 4352);
        float W = 1.f;
#pragma unroll
        for (int t = 0; t < 12; ++t) { const float wq = WW[(16 * sc + t) * 64 + k]; W *= (t < 4 * tq) ? wq : 1.f; }
#pragma unroll
        for (int t4 = 0; t4 < 4; ++t4) {
            const int t = 4 * tq + t4;
            const int o = (16 * sc + t) * 64 + k;
            const float w = WW[o], kk = KK[o], bq = BB[o], k2 = K2[o], r = RR[o], vv = VV[o];
            const float alpha = W * kk; W *= w; const float invW = __builtin_amdgcn_rcpf(W);
            const float beta = bq * invW, kappa = k2 * invW, rho = W * r;
            const unsigned pa = cvt_pk_bf16(alpha, rho), pk = cvt_pk_bf16(kappa, beta), pn = cvt_pk_bf16(-beta, vv);
            XT[t * 68 + k] = (bf16_t)(pa & 0xffffu); XT[(16 + t) * 68 + k] = (bf16_t)(pa >> 16);
            KBT[t * 68 + k] = (bf16_t)(pk & 0xffffu); KBT[(16 + t) * 68 + k] = (bf16_t)(pk >> 16);
            KB[k * 36 + t] = (bf16_t)(pk & 0xffffu); KB[k * 36 + 16 + t] = (bf16_t)(pn & 0xffffu);
            VTt[k * 20 + t] = (bf16_t)(pn >> 16);
        }
        if (tq == 3) WL[k] = W;
    };
    auto stageC = [&](int c) {
        const int sc = wv - 2;
        unsigned char* blk = L + SC_OPS + ((c & 1) * 2 + sc) * SC_OPB;
        const bf16_t* XT = (const bf16_t*)(blk + OP_XT); const bf16_t* KBT = (const bf16_t*)(L + SC_KBT + sc * 4352);
        float* SM = (float*)(L + SC_CT + sc * 5248); float* QT = SM + 1056; bf16_t* A3 = (bf16_t*)(blk + OP_A3); bf16_t* A4 = (bf16_t*)(blk + OP_A4); bf16_t* A5 = (bf16_t*)(blk + OP_A5);
        f32x16 sm = zero16s;
#pragma unroll
        for (int cc = 0; cc < 4; ++cc) sm = __builtin_amdgcn_mfma_f32_32x32x16_bf16(afrag(KBT, 68, r32, 16 * cc, hi), afrag(XT, 68, r32, 16 * cc, hi), sm, 0, 0, 0);
#pragma unroll
        for (int r = 0; r < 16; ++r) SM[((r & 3) + 8 * (r >> 2) + 4 * hi) * 33 + r32] = sm[r];
        if (r32 < 16) { *(f32x4*)(QT + r32 * 16 + 4 * hi) = (f32x4){sm[8], sm[9], sm[10], sm[11]}; *(f32x4*)(QT + r32 * 16 + 8 + 4 * hi) = (f32x4){sm[12], sm[13], sm[14], sm[15]}; }
        asm volatile("s_waitcnt lgkmcnt(0)" ::: "memory");
        {
            const int rr = lane & 15;
            f32x4 q[16][4];
#pragma unroll
            for (int t = 1; t < 16; ++t)
#pragma unroll
                for (int v4 = 0; v4 < 4; ++v4) if (4 * v4 < t) q[t][v4] = *(const f32x4*)(QT + t * 16 + 4 * v4);
            float N[16];
#pragma unroll
            for (int t = 0; t < 16; ++t) {
                float acc0 = (rr == t) ? 1.f : 0.f, acc1 = 0.f;
#pragma unroll
                for (int i = 0; i < t; ++i) { if (i & 1) acc1 -= N[i] * q[t][i >> 2][i & 3]; else acc0 -= N[i] * q[t][i >> 2][i & 3]; }
                N[t] = acc0 + acc1;
            }
            if (lane < 16) {
#pragma unroll
                for (int t = 0; t < 16; ++t) A4[t * 20 + rr] = (bf16_t)(cvt_pk_bf16(N[t], 0.f) & 0xffffu);
            } else if (lane < 32) {
#pragma unroll
                for (int i = 0; i < 16; ++i) A4[lane * 20 + i] = 0;
            }
        }
        {
            const int m = lane & 31, i0 = (lane >> 5) * 8;
#pragma unroll
            for (int e = 0; e < 8; ++e) { const int i = i0 + e;
                float a3, a5;
                if (m < 16) { a3 = (i < m) ? SM[i * 33 + m] : 0.f; a5 = 0.f; }
                else { const int t = m - 16; a3 = (i <= t) ? SM[i * 33 + 16 + t] : 0.f; a5 = (i <= t) ? -SM[(16 + i) * 33 + 16 + t] : 0.f; }
                const unsigned pk = cvt_pk_bf16(a3, a5);
                A3[m * 20 + i] = (bf16_t)(pk & 0xffffu); A5[m * 20 + i] = (bf16_t)(pk >> 16); }
        }
    };
    auto stageD = [&](int c) {
        bf16x8 fXT[2][4], fKB[2][4], fV[2], fA3[2], fA4[2], fA5[2];
#pragma unroll
        for (int sc = 0; sc < 2; ++sc) {
            const unsigned char* blk = L + SC_OPS + ((c & 1) * 2 + sc) * SC_OPB;
            const bf16_t* XT = (const bf16_t*)(blk + OP_XT); const bf16_t* KB = (const bf16_t*)(blk + OP_KB); const bf16_t* VTt = (const bf16_t*)(blk + OP_VT);
#pragma unroll
            for (int q4 = 0; q4 < 4; ++q4) fXT[sc][q4] = afrag(XT, 68, r32, 16 * q4, hi);
            fV[sc] = afrag(VTt, 20, 32 * wv + r32, 0, hi);
            fA3[sc] = afrag((const bf16_t*)(blk + OP_A3), 20, r32, 0, hi); fA4[sc] = afrag((const bf16_t*)(blk + OP_A4), 20, r32, 0, hi); fA5[sc] = afrag((const bf16_t*)(blk + OP_A5), 20, r32, 0, hi);
#pragma unroll
            for (int t2 = 0; t2 < 2; ++t2) { fKB[sc][2 * t2] = afrag(KB, 36, 32 * t2 + r32, 0, hi); fKB[sc][2 * t2 + 1] = afrag(KB, 36, 32 * t2 + r32, 16, hi); }
        }
#pragma unroll
        for (int sc = 0; sc < 2; ++sc) {
            const float* WL = (const float*)(L + SC_OPS + ((c & 1) * 2 + sc) * SC_OPB + OP_WL);
            f32x4 wl[2][4];
#pragma unroll
            for (int t2 = 0; t2 < 2; ++t2)
#pragma unroll
                for (int g4 = 0; g4 < 4; ++g4) wl[t2][g4] = *(const f32x4*)(WL + 32 * t2 + 8 * g4 + 4 * hi);
            f32x16 Gm = zero16s;
#pragma unroll
            for (int t2 = 0; t2 < 2; ++t2)
#pragma unroll
                for (int cc = 0; cc < 2; ++cc) Gm = __builtin_amdgcn_mfma_f32_32x32x16_bf16(fXT[sc][2 * t2 + cc], pack8(St[t2], 8 * cc), Gm, 0, 0, 0);
            Gm = __builtin_amdgcn_mfma_f32_32x32x16_bf16(fA3[sc], fV[sc], Gm, 0, 0, 0);
            const f32x16 Um = __builtin_amdgcn_mfma_f32_32x32x16_bf16(fA4[sc], pack8(Gm, 0), zero16s, 0, 0, 0);
            const bf16x8 ub = pack8(Um, 0);
#pragma unroll
            for (int t2 = 0; t2 < 2; ++t2) {
                St[t2] = __builtin_amdgcn_mfma_f32_32x32x16_bf16(fKB[sc][2 * t2], fV[sc], St[t2], 0, 0, 0);
                St[t2] = __builtin_amdgcn_mfma_f32_32x32x16_bf16(fKB[sc][2 * t2 + 1], ub, St[t2], 0, 0, 0);
            }
            Gm = __builtin_amdgcn_mfma_f32_32x32x16_bf16(fA5[sc], ub, Gm, 0, 0, 0);
#pragma unroll
            for (int t2 = 0; t2 < 2; ++t2)
#pragma unroll
                for (int g4 = 0; g4 < 4; ++g4)
#pragma unroll
                    for (int e = 0; e < 4; ++e) St[t2][4 * g4 + e] *= wl[t2][g4][e];
#pragma unroll
            for (int e = 0; e < 4; ++e) { YY[(16 * sc + 4 * hi + e) * 64 + 32 * wv + r32] = Gm[8 + e]; YY[(16 * sc + 8 + 4 * hi + e) * 64 + 32 * wv + r32] = Gm[12 + e]; }
        }
    };
    auto outst = [&](int c, const float (&gq)[4]) {
        const float* VV = (const float*)(L + SC_VV + (c % 3) * 8192); const float* BON = (const float*)(L + SC_BON + (c % 3) * 128);
        const int o = tt * 64 + c4;
        const f32x4 y4 = *(const f32x4*)(YY + o), v4 = *(const f32x4*)(VV + o);
        const float mean = red16((y4[0] + y4[1]) + (y4[2] + y4[3])) * (1.f / 64.f);
        float q = 0.f;
#pragma unroll
        for (int e = 0; e < 4; ++e) { const float d = y4[e] - mean; q += d * d; }
        const float rstd = __builtin_amdgcn_rsqf(red16(q) * (1.f / 64.f) + 64e-5f);
        const float bon = BON[tt];
        const f32x4 lg = *(const f32x4*)(TAB + 384 + c4), lb = *(const f32x4*)(TAB + 448 + c4);
        float o4[4];
#pragma unroll
        for (int e = 0; e < 4; ++e) o4[e] = ((y4[e] - mean) * rstd * lg[e] + lb[e] + bon * v4[e]) * gq[e];
        u32x2 w; w.x = cvt_pk_bf16(o4[0], o4[1]); w.y = cvt_pk_bf16(o4[2], o4[3]);
        *(u32x2*)(YA + ((size_t)b * SEQ + c * 32 + tt) * 512 + ch) = w;
    };
    load_raw(0);
    prep(0);
#pragma unroll
    for (int e = 0; e < 4; ++e) gq_cur[e] = gq_next[e];
    load_raw(1);
    LBAR();
    stageB(0);
    LBAR();
    if (wv == 2 || wv == 3) stageC(0);
    LBAR();
    for (int c = 0; c < 64; ++c) {
        if (c >= 1) outst(c - 1, gq_prev);
        if (c + 1 < 64) prep(c + 1);
#pragma unroll
        for (int e = 0; e < 4; ++e) { gq_prev[e] = gq_cur[e]; gq_cur[e] = gq_next[e]; }
        if (c + 2 < 64) load_raw(c + 2);
        LBAR();
        if (c + 1 < 64) stageB(c + 1);
        LBAR();
        if (wv < 2) stageD(c);
        else if (wv < 4) { if (c + 1 < 64) stageC(c + 1); }
        LBAR();
    }
    outst(63, gq_prev);
    LBAR();
}

__device__ __forceinline__ float other_half(float x) {
    const auto rr = __builtin_amdgcn_permlane32_swap(__float_as_uint(x), __float_as_uint(x), false, false);
    const float a = __uint_as_float(rr[0]), b = __uint_as_float(rr[1]);
    return (threadIdx.x & 32) ? a : b;
}
__device__ __forceinline__ float halves_max(float x) { const auto rr = __builtin_amdgcn_permlane32_swap(__float_as_uint(x), __float_as_uint(x), false, false); return fmaxf(__uint_as_float(rr[0]), __uint_as_float(rr[1])); }
__device__ __forceinline__ float halves_sum(float x) { const auto rr = __builtin_amdgcn_permlane32_swap(__float_as_uint(x), __float_as_uint(x), false, false); return __uint_as_float(rr[0]) + __uint_as_float(rr[1]); }
typedef short v4i16_t __attribute__((ext_vector_type(4)));
__device__ __forceinline__ s16x4 lds_tr16(const void* p) { return __builtin_bit_cast(s16x4, __builtin_amdgcn_ds_read_tr16_b64_v4i16((LAS v4i16_t*)p)); }
constexpr int KS_PITCH = 72;
struct AttnLds { bf16_t* Ks; bf16_t* Vt; float* IMP; float* SC; unsigned* SEL; };

template <bool MASKED, class VF> __device__ __forceinline__ void attn_step(const AttnLds& Z, const bf16x8 (&qf)[4], f32x16 (&o)[2], float& m, float& l, VF valid, bool lanesel, int r32, int hi) {
    f32x16 s[2];
#pragma unroll
    for (int hv = 0; hv < 2; ++hv) {
        s[hv] = (f32x16){0.f,0.f,0.f,0.f,0.f,0.f,0.f,0.f,0.f,0.f,0.f,0.f,0.f,0.f,0.f,0.f};
#pragma unroll
        for (int c = 0; c < 4; ++c) { const bf16x8 kf = *(const bf16x8*)(Z.Ks + (32 * hv + r32) * KS_PITCH + 16 * c + 8 * hi); s[hv] = __builtin_amdgcn_mfma_f32_32x32x16_bf16(kf, qf[c], s[hv], 0, 0, 0); }
    }
    if (MASKED) {
#pragma unroll
        for (int hv = 0; hv < 2; ++hv)
#pragma unroll
            for (int r = 0; r < 16; ++r) { const int kvl = 32 * hv + (r & 3) + 8 * (r >> 2) + 4 * hi; s[hv][r] = valid(kvl) ? s[hv][r] : -1e30f; }
    }
    float mx0 = fmaxf(s[0][0], s[1][0]), mx1 = fmaxf(s[0][1], s[1][1]);
#pragma unroll
    for (int r = 2; r < 16; r += 2) { mx0 = fmaxf(fmaxf(mx0, s[0][r]), s[1][r]); mx1 = fmaxf(fmaxf(mx1, s[0][r + 1]), s[1][r + 1]); }
    float mx = fmaxf(mx0, mx1);
    mx = halves_max(mx);
    if (__any(mx > m + 8.f)) { const float mn = fmaxf(m, mx); const float alpha = __builtin_amdgcn_exp2f(m - mn); l *= alpha; o[0] = o[0] * alpha; o[1] = o[1] * alpha; m = mn; }
    const float nb = lanesel ? -m : -__builtin_inff();
    f32x2 ps2 = (f32x2){0.f, 0.f};
#pragma unroll
    for (int hv = 0; hv < 2; ++hv) {
#pragma unroll
        for (int r = 0; r < 16; r += 2) {
            const f32x2 d = (f32x2){s[hv][r], s[hv][r + 1]} + (f32x2){nb, nb};
            float p0 = __builtin_amdgcn_exp2f(d.x), p1 = __builtin_amdgcn_exp2f(d.y);
            if (MASKED) { p0 = s[hv][r] > -1e29f ? p0 : 0.f; p1 = s[hv][r + 1] > -1e29f ? p1 : 0.f; }
            s[hv][r] = p0; s[hv][r + 1] = p1; ps2 += (f32x2){p0, p1};
        }
#pragma unroll
        for (int cc = 0; cc < 2; ++cc) {
            const int c = 2 * hv + cc, rb = 8 * cc;
            u32x4 pw; pw.x = cvt_pk_bf16(s[hv][rb + 0], s[hv][rb + 1]); pw.y = cvt_pk_bf16(s[hv][rb + 2], s[hv][rb + 3]); pw.z = cvt_pk_bf16(s[hv][rb + 4], s[hv][rb + 5]); pw.w = cvt_pk_bf16(s[hv][rb + 6], s[hv][rb + 7]);
            const bf16x8 pb = __builtin_bit_cast(bf16x8, pw);
#pragma unroll
            for (int dh = 0; dh < 2; ++dh) {
                const unsigned char* vp = (const unsigned char*)Z.Vt + dh * 4096 + (16 * c + 4 * hi + ((r32 & 15) >> 2)) * 64 + (r32 >> 4) * 32 + (r32 & 3) * 8;
                const s16x4 lo = lds_tr16(vp), hh = lds_tr16(vp + 8 * 64);
                const bf16x8 va = (bf16x8){lo[0], lo[1], lo[2], lo[3], hh[0], hh[1], hh[2], hh[3]};
                o[dh] = __builtin_amdgcn_mfma_f32_32x32x16_bf16(va, pb, o[dh], 0, 0, 0);
            }
        }
    }
    l += ps2.x + ps2.y;
}
__device__ __forceinline__ void attn_stage(const AttnLds& Z, const u32x4 kreg, const u32x4 vreg, int tid) {
    const int row = tid >> 3, chn = tid & 7;
    *(u32x4*)(Z.Ks + row * KS_PITCH + chn * 8) = kreg;
    *(u32x4*)((unsigned char*)Z.Vt + (chn >> 2) * 4096 + row * 64 + (chn & 3) * 16) = vreg;
}

__device__ __forceinline__ void attn_unit(const Args& A, int b, int hk, int qt, unsigned char* lds) {
    int tid = threadIdx.x; asm volatile("" : "+v"(tid));
    const int lane = tid & 63, w = tid >> 6, r32 = lane & 31, hi = lane >> 5, g = w >> 1, th = w & 1;
    AttnLds Z; Z.Ks = (bf16_t*)lds; Z.Vt = (bf16_t*)(lds + 9216); Z.IMP = (float*)(lds + 35840); Z.SC = (float*)(lds + 35840 + 32768); Z.SEL = (unsigned*)(lds + 35840 + 32768 + 8192);
    auto ZBf = [&](int q) -> AttnLds { AttnLds z = Z; z.Ks = (bf16_t*)(lds + q * 17920); z.Vt = (bf16_t*)(lds + q * 17920 + 9216); return z; };
    const bf16_t* PROJ = (const bf16_t*)(A.ws + WS_PROJ);
    const bf16_t* KCB = (const bf16_t*)(A.ws + WS_KCB); const bf16_t* VCB = (const bf16_t*)(A.ws + WS_VCB);
    bf16_t* YB = (bf16_t*)(A.ws + WS_YB);
    const int tokl = 32 * th + r32, spos = 64 * qt + tokl;
    const size_t trow = (size_t)b * SEQ + spos;
    const int head = hk * 4 + g;
    bf16x8 qf[4];
#pragma unroll
    for (int c = 0; c < 4; ++c) qf[c] = *(const bf16x8*)(PROJ + trow * LDP + C_Q + head * 64 + 16 * c + 8 * hi);
    float gate[3];
#pragma unroll
    for (int e = 0; e < 3; ++e) gate[e] = sigmoidf_(bf2f(PROJ[trow * LDP + C_NG + head * 3 + e]));
    f32x16 out[2], o[2];
    const f32x16 zero16 = (f32x16){0.f,0.f,0.f,0.f,0.f,0.f,0.f,0.f,0.f,0.f,0.f,0.f,0.f,0.f,0.f,0.f};
    out[0] = zero16; out[1] = zero16;
    const int srow = tid >> 3, schn = tid & 7;
    u32x4 kreg, vreg;
    float m, l;
    auto finish = [&](float gt) {
        const float lt = halves_sum(l);
        const float sc = lt > 0.f ? gt / lt : 0.f;
        out[0] += o[0] * sc; out[1] += o[1] * sc;
    };
    const int ncmp = 4 * qt + 3 < 127 ? 4 * qt + 3 : 127;
    const int ntl = (ncmp + 63) / 64;
    const bf16_t* kcb = KCB + (size_t)((b * 2 + hk) * 128) * 64; const bf16_t* vcb = VCB + (size_t)((b * 2 + hk) * 128) * 64;
    m = -1e30f; l = 0.f; o[0] = zero16; o[1] = zero16;
    kreg = *(const u32x4*)(kcb + srow * 64 + schn * 8); vreg = *(const u32x4*)(vcb + srow * 64 + schn * 8);
    attn_stage(ZBf(0), kreg, vreg, tid); __syncthreads();
    if (ntl > 1) { kreg = *(const u32x4*)(kcb + (64 + srow) * 64 + schn * 8); vreg = *(const u32x4*)(vcb + (64 + srow) * 64 + schn * 8); }
    for (int tl = 0; tl < ntl; ++tl) {
        if (tl + 1 < ntl) attn_stage(ZBf((tl + 1) & 1), kreg, vreg, tid);
        const int cb0 = 64 * tl;
        if (tl == 0 && qt >= 17) attn_step<false>(ZBf(tl & 1), qf, o, m, l, [&](int) { return true; }, true, r32, hi);
        else attn_step<true>(ZBf(tl & 1), qf, o, m, l, [&](int kvl) { const int c = cb0 + kvl; return (16 * c + 31 <= spos) && (c < 127); }, true, r32, hi);
        __syncthreads();
    }
    finish(gate[0]);
    unsigned selm, uni;
    if (qt >= 16) {
        const float lt = halves_sum(l);
        const float linv = lt > 0.f ? 1.f / lt : 0.f;
        float carry = 0.f;
        kreg = *(const u32x4*)(kcb + srow * 64 + schn * 8);
        for (int tl = 0; tl < 2; ++tl) {
            __syncthreads(); *(u32x4*)(Z.Ks + srow * KS_PITCH + schn * 8) = kreg; __syncthreads();
            if (tl == 0) kreg = *(const u32x4*)(kcb + (64 + srow) * 64 + schn * 8);
#pragma unroll
            for (int hv = 0; hv < 2; ++hv) {
                f32x16 s = zero16;
#pragma unroll
                for (int c = 0; c < 4; ++c) { const bf16x8 kf = *(const bf16x8*)(Z.Ks + (32 * hv + r32) * KS_PITCH + 16 * c + 8 * hi); s = __builtin_amdgcn_mfma_f32_32x32x16_bf16(kf, qf[c], s, 0, 0, 0); }
#pragma unroll
                for (int gq = 0; gq < 4; ++gq) {
                    float pn[4];
#pragma unroll
                    for (int e = 0; e < 4; ++e) { const int c = 64 * tl + 32 * hv + 8 * gq + 4 * hi + e; const bool ok = (16 * c + 31 <= spos) && (c < 127); pn[e] = ok ? __builtin_amdgcn_exp2f(s[4 * gq + e] - m) * linv : 0.f; }
                    const float qsum = (pn[0] + pn[1]) + (pn[2] + pn[3]);
                    const float other_last = other_half(pn[3]);
                    const float extra = hi ? other_last : carry;
                    carry = other_last;
                    const int j = 16 * tl + 8 * hv + 2 * gq + hi;
                    Z.IMP[(g * 64 + tokl) * 32 + j] = qsum + extra;
                }
            }
        }
        __syncthreads();
        {
            const int tok = tid >> 3, jg = tid & 7;
            float sc4[4];
#pragma unroll
            for (int e = 0; e < 4; ++e) { const int j = 4 * jg + e;
                const float imp = (Z.IMP[(0 * 64 + tok) * 32 + j] + Z.IMP[(1 * 64 + tok) * 32 + j]) + (Z.IMP[(2 * 64 + tok) * 32 + j] + Z.IMP[(3 * 64 + tok) * 32 + j]);
                const bool forced = (j == 0) || (j == qt) || (j == qt - 1);
                sc4[e] = forced ? 1e4f : (j <= qt ? imp : -1.f); }
            *(f32x4*)(Z.SC + tok * 32 + 4 * jg) = (f32x4){sc4[0], sc4[1], sc4[2], sc4[3]};
            __syncthreads();
            int rank[4] = {0, 0, 0, 0};
#pragma unroll
            for (int i4 = 0; i4 < 8; ++i4) { const f32x4 v = *(const f32x4*)(Z.SC + tok * 32 + 4 * i4);
#pragma unroll
                for (int ie = 0; ie < 4; ++ie) { const int i = 4 * i4 + ie;
#pragma unroll
                    for (int e = 0; e < 4; ++e) { const int j = 4 * jg + e; rank[e] += (v[ie] > sc4[e] || (v[ie] == sc4[e] && i < j)) ? 1 : 0; } } }
            unsigned bits = 0u;
#pragma unroll
            for (int e = 0; e < 4; ++e) { const int j = 4 * jg + e; if (rank[e] < 16 && j <= qt) bits |= 1u << j; }
            bits |= __shfl_xor(bits, 1); bits |= __shfl_xor(bits, 2); bits |= __shfl_xor(bits, 4);
            if (jg == 0) Z.SEL[tok] = bits;
        }
        __syncthreads();
        selm = Z.SEL[tokl];
        unsigned u = Z.SEL[lane];
#pragma unroll
        for (int ofs = 1; ofs < 64; ofs <<= 1) u |= __shfl_xor(u, ofs);
        uni = u;
    } else { selm = (2u << qt) - 1u; uni = selm; }
    uni = __builtin_amdgcn_readfirstlane(uni);
    {
        const bf16_t* kb = PROJ + (size_t)b * SEQ * LDP + C_KS + hk * 64; const bf16_t* vb = PROJ + (size_t)b * SEQ * LDP + C_VS + hk * 64;
        m = -1e30f; l = 0.f; o[0] = zero16; o[1] = zero16;
        unsigned rem = uni;
        auto popb = [&]() -> int { if (!rem) return -1; const int q = __builtin_ctz(rem); rem &= rem - 1u; return q; };
        int j = popb(), jn = popb();
        kreg = *(const u32x4*)(kb + (size_t)(64 * j + srow) * LDP + schn * 8); vreg = *(const u32x4*)(vb + (size_t)(64 * j + srow) * LDP + schn * 8);
        attn_stage(ZBf(0), kreg, vreg, tid); __syncthreads();
        if (jn >= 0) { kreg = *(const u32x4*)(kb + (size_t)(64 * jn + srow) * LDP + schn * 8); vreg = *(const u32x4*)(vb + (size_t)(64 * jn + srow) * LDP + schn * 8); }
        int pb = 0;
        for (;;) {
            const int jnn = (jn >= 0) ? popb() : -1;
            if (jn >= 0) attn_stage(ZBf(pb ^ 1), kreg, vreg, tid);
            if (jnn >= 0) { kreg = *(const u32x4*)(kb + (size_t)(64 * jnn + srow) * LDP + schn * 8); vreg = *(const u32x4*)(vb + (size_t)(64 * jnn + srow) * LDP + schn * 8); }
            const bool sel = (selm >> j) & 1u; const int kv0 = 64 * j;
            if (j < qt) { if (__any(sel)) attn_step<false>(ZBf(pb), qf, o, m, l, [&](int) { return true; }, sel, r32, hi); }
            else attn_step<true>(ZBf(pb), qf, o, m, l, [&](int kvl) { return kv0 + kvl <= spos; }, sel, r32, hi);
            __syncthreads();
            if (jn < 0) break;
            j = jn; jn = jnn; pb ^= 1;
        }
        finish(gate[1]);
    }
    {
        const bf16_t* kb = PROJ + (size_t)b * SEQ * LDP + C_KW + hk * 64; const bf16_t* vb = PROJ + (size_t)b * SEQ * LDP + C_VW + hk * 64;
        m = -1e30f; l = 0.f; o[0] = zero16; o[1] = zero16;
        const int j0 = qt >= 8 ? qt - 8 : 0;
        kreg = *(const u32x4*)(kb + (size_t)(64 * j0 + srow) * LDP + schn * 8); vreg = *(const u32x4*)(vb + (size_t)(64 * j0 + srow) * LDP + schn * 8);
        attn_stage(ZBf(0), kreg, vreg, tid); __syncthreads();
        if (j0 < qt) { kreg = *(const u32x4*)(kb + (size_t)(64 * (j0 + 1) + srow) * LDP + schn * 8); vreg = *(const u32x4*)(vb + (size_t)(64 * (j0 + 1) + srow) * LDP + schn * 8); }
        for (int j = j0; j <= qt; ++j) {
            const int pb = (j - j0) & 1;
            if (j < qt) attn_stage(ZBf(pb ^ 1), kreg, vreg, tid);
            if (j + 2 <= qt) { kreg = *(const u32x4*)(kb + (size_t)(64 * (j + 2) + srow) * LDP + schn * 8); vreg = *(const u32x4*)(vb + (size_t)(64 * (j + 2) + srow) * LDP + schn * 8); }
            const int kv0 = 64 * j;
            if (j == qt || (qt >= 8 && j == qt - 8)) attn_step<true>(ZBf(pb), qf, o, m, l, [&](int kvl) { const int kp = kv0 + kvl; return (kp <= spos) && (kp > spos - 512); }, true, r32, hi);
            else attn_step<false>(ZBf(pb), qf, o, m, l, [&](int) { return true; }, true, r32, hi);
            __syncthreads();
        }
        finish(gate[2]);
    }
    bf16_t* yb = YB + trow * 512 + head * 64;
#pragma unroll
    for (int dh = 0; dh < 2; ++dh)
#pragma unroll
        for (int gq = 0; gq < 4; ++gq) {
            u32x2 wv; wv.x = cvt_pk_bf16(out[dh][4 * gq + 0], out[dh][4 * gq + 1]); wv.y = cvt_pk_bf16(out[dh][4 * gq + 2], out[dh][4 * gq + 3]);
            *(u32x2*)(yb + 32 * dh + 8 * gq + 4 * hi) = wv;
        }
    __syncthreads();
}

#define XB_TMO      128
#define XB_XCNT(j)  (256  + 64 * (j))
#define XB_XSUB(j)  (1280 + 64 * (j))
#define XB_XGEN(j)  (2304 + 64 * (j))
#define XB_TOP      3328
#define XB_TOPGEN   3392
#define XCD_BAR_WORDS 3456
#define XB_SPIN_CAP (1u << 18)

__device__ __forceinline__ unsigned xb_ld(unsigned* p)              { return __hip_atomic_load(p, __ATOMIC_RELAXED, __HIP_MEMORY_SCOPE_AGENT); }
__device__ __forceinline__ unsigned xb_add(unsigned* p, unsigned v) { return __hip_atomic_fetch_add(p, v, __ATOMIC_RELAXED, __HIP_MEMORY_SCOPE_AGENT); }
__device__ __forceinline__ unsigned xb_xcc_id() { return (unsigned)__builtin_amdgcn_s_getreg((3 << 11) | 20) & 0xFu; }
#define XB_SPIN(cond, bar) do { unsigned _sp = 0; while (cond) { __builtin_amdgcn_s_sleep(1); \
    if ((++_sp & 255u) == 0u) { if (xb_ld(&(bar)[XB_TMO])) break; if (_sp > XB_SPIN_CAP) { atomicAdd(&(bar)[XB_TMO], 1u); break; } } } } while (0)

struct XcdBarrier {
    unsigned* bar; unsigned x;
    volatile LAS unsigned* st;
};

__device__ __forceinline__ XcdBarrier xcd_barrier_post(unsigned* bar, volatile LAS unsigned* st) {
    XcdBarrier b; b.bar = bar; b.x = xb_xcc_id(); b.st = st;
    if (threadIdx.x == 0) (void)xb_add(&bar[XB_XCNT(b.x)], 1u);
    return b;
}
__device__ __forceinline__ void xcd_barrier_complete(unsigned* bar, unsigned x, unsigned& nloc, unsigned& nx) {
    const unsigned G = gridDim.x * gridDim.y * gridDim.z;
    unsigned sum, cnt, mine, sp = 0u;
    for (;;) {
        sum = 0u; cnt = 0u; mine = 0u;
#pragma unroll
        for (unsigned j = 0; j < 16; ++j) { const unsigned c = xb_ld(&bar[XB_XCNT(j)]); sum += c; cnt += (c > 0u) ? 1u : 0u; mine = (j == x) ? c : mine; }
        if (sum == G) break;
        __builtin_amdgcn_s_sleep(1);
        if ((++sp & 255u) == 0u) { if (xb_ld(&bar[XB_TMO])) break; if (sp > XB_SPIN_CAP) { atomicAdd(&bar[XB_TMO], 1u); break; } }
    }
    nloc = mine > 0u ? mine : 1u; nx = cnt > 0u ? cnt : 1u;
}

__device__ __forceinline__ void xcd_barrier(const XcdBarrier& b) {
    asm volatile("s_waitcnt vmcnt(0)" ::: "memory");
    __syncthreads();
    if (threadIdx.x == 0) {
        unsigned* bar = b.bar;
        __builtin_amdgcn_s_waitcnt(0);
        unsigned nloc = b.st[0], nx = b.st[1];
        if (nloc == 0u) { xcd_barrier_complete(bar, b.x, nloc, nx); b.st[0] = nloc; b.st[1] = nx; }
        const unsigned old = xb_add(&bar[XB_XSUB(b.x)], 1u);
        const unsigned gen = old / nloc;
        if (old + 1u == (gen + 1u) * nloc) {
            __builtin_amdgcn_fence(__ATOMIC_RELEASE, "agent");
            asm volatile("s_waitcnt vmcnt(0)" ::: "memory");
            const unsigned og = xb_add(&bar[XB_TOP], 1u);
            const unsigned tg = og / nx;
            if (og + 1u == (tg + 1u) * nx) xb_add(&bar[XB_TOPGEN], 1u);
            else XB_SPIN(xb_ld(&bar[XB_TOPGEN]) == tg, bar);
            __builtin_amdgcn_fence(__ATOMIC_ACQUIRE, "agent");
            xb_add(&bar[XB_XGEN(b.x)], 1u);
            asm volatile("s_waitcnt vmcnt(0)" ::: "memory");
        } else {
            XB_SPIN(xb_ld(&bar[XB_XGEN(b.x)]) == gen, bar);
            __builtin_amdgcn_fence(__ATOMIC_ACQUIRE, "agent");
            asm volatile("s_waitcnt vmcnt(0)" ::: "memory");
        }
    }
    __syncthreads();
}

__global__ void __launch_bounds__(NTHREADS) fwd_kernel(Args A) {
    extern __shared__ __attribute__((aligned(16))) unsigned char lds[];
    cg::grid_group grid = cg::this_grid();
    const int G = gridDim.x, bid = blockIdx.x;
    const int NGW = G * NWAVES, NGT = G * NTHREADS;
    LAS unsigned char* ldsl = (LAS unsigned char*)lds;
    volatile LAS unsigned* xst = (volatile LAS unsigned*)(ldsl + LDS_BYTES - 64);
    if (threadIdx.x < 16) xst[threadIdx.x] = 0u;
    __syncthreads();
    XcdBarrier xbar = xcd_barrier_post((unsigned*)(A.ws + WS_CTL) + 1024, xst);
    grid.sync();
#define GSYNC_CG() do { __threadfence(); grid.sync(); } while (0)
#define GSYNC() xcd_barrier(xbar)

#define WSP(name, off) bf16_t* name = (bf16_t*)(wsq + (off))
#define PHASE_BEGIN() unsigned char* wsq = A.ws; asm volatile("" : "+s"(wsq)); int tid = threadIdx.x; asm volatile("" : "+v"(tid)); const int lane = tid & 63, wave = __builtin_amdgcn_readfirstlane(tid >> 6); const int gw = bid * NWAVES + wave, gtid = bid * NTHREADS + tid; (void)lane; (void)gw; (void)gtid;
#define ALLPTRS() WSP(Win_t, WS_WIN); WSP(Wg_t, WS_WG); WSP(Wup_t, WS_WUP); WSP(Wdn_t, WS_WDN); WSP(Wo_t, WS_WO); WSP(Wpg_t, WS_WPG); WSP(Woa_t, WS_WOA); WSP(Wob_t, WS_WOB); \
    WSP(Wpp_t, WS_WPP); WSP(Wl2_t, WS_WL2); WSP(Wc1k_t, WS_WC1K); WSP(Wc1v_t, WS_WC1V); float* CB = (float*)(wsq + WS_CB); WSP(KCB, WS_KCB); WSP(VCB, WS_VCB); WSP(H12K, WS_H12K); WSP(H12V, WS_H12V); \
    WSP(PB, WS_PB); WSP(PROJ, WS_PROJ); WSP(LO, WS_LO); WSP(A2, WS_A2); WSP(YA, WS_YA); WSP(YB, WS_YB); WSP(SG, WS_SG); WSP(MB, WS_M); WSP(U2, WS_U2); WSP(ACT, WS_ACT); WSP(PP, WS_PP); \
    bf16_t* U = (bf16_t*)A.out; float* H = A.out; \
    (void)Win_t; (void)Wg_t; (void)Wup_t; (void)Wdn_t; (void)Wo_t; (void)Wpg_t; (void)Woa_t; (void)Wob_t; (void)Wpp_t; (void)Wl2_t; (void)Wc1k_t; (void)Wc1v_t; (void)CB; (void)KCB; (void)VCB; (void)H12K; (void)H12V; \
    (void)PB; (void)PROJ; (void)LO; (void)A2; (void)YA; (void)YB; (void)SG; (void)MB; (void)U2; (void)ACT; (void)PP; (void)U; (void)H;
    {
        PHASE_BEGIN(); ALLPTRS();
        float* scr = (float*)(lds + wave * 16384);
        { const float* w_in = A.in[I_WIN]; const float* w1 = A.in[I_W1]; const float* a1 = A.in[I_A1]; const float* g1 = A.in[I_G1]; const float* mu = A.in[I_MUWAG];
          tr_matrix([=](int k, int n) -> float {
              if (n < C_L1) { const float v = __builtin_nontemporal_load(w_in + (size_t)k * WIN_LD + n); return (n >= C_Q && n < C_KC) ? v * QSCALE : v; }
              if (n >= LDP) return 0.f;
              const bool second = n >= C_L2; const int i = n - (second ? C_L2 : C_L1);
              float v, mm;
              if (i < 64) { v = w1[k * 64 + i]; mm = mu[k]; } else if (i < 128) { v = a1[k * 64 + i - 64]; mm = mu[1024 + k]; } else { v = g1[k * 160 + i - 128]; mm = mu[2048 + k]; }
              return second ? v * mm : v * (1.f - mm);
          }, 1024, 3424, Win_t, scr, gw, NGW, lane);
          tr_matrix([=](int k, int n) -> float { return __builtin_nontemporal_load(w_in + (size_t)k * WIN_LD + C_L1 + n); }, 1024, 2048, Wg_t, scr, gw, NGW, lane); }
        { const float* w = A.in[I_WUP]; const float* g2 = A.in[I_LN2]; tr_matrix([=](int k, int n) -> float { const int pn = n >> 8, wq = n & 255; const int src = wq < 128 ? pn * 128 + wq : DFF + pn * 128 + (wq - 128); return __builtin_nontemporal_load(w + (size_t)k * 5632 + src) * g2[k]; }, 1024, 5632, Wup_t, scr, gw, NGW, lane); }
        { const float* w = A.in[I_WDN]; tr_matrix([=](int k, int n) -> float { return __builtin_nontemporal_load(w + (size_t)k * 1024 + n); }, 2816, 1024, Wdn_t, scr, gw, NGW, lane); }
        { const float* w = A.in[I_WO]; tr_matrix([=](int k, int n) -> float { return __builtin_nontemporal_load(w + (size_t)k * 1024 + n); }, 1024, 1024, Wo_t, scr, gw, NGW, lane); }
        { const float* w = A.in[I_WPG]; const float* g3 = A.in[I_LN3]; tr_matrix([=](int k, int n) -> float { return __builtin_nontemporal_load(w + (size_t)k * 1024 + n) * g3[k]; }, 1024, 1024, Wpg_t, scr, gw, NGW, lane); }
        { const float* w = A.in[I_WOA]; tr_matrix([=](int k, int n) -> float { return __builtin_nontemporal_load(w + (size_t)k * 1024 + n); }, 512, 1024, Woa_t, scr, gw, NGW, lane); }
        { const float* w = A.in[I_WOB]; tr_matrix([=](int k, int n) -> float { return __builtin_nontemporal_load(w + (size_t)k * 1024 + n); }, 512, 1024, Wob_t, scr, gw, NGW, lane); }
        { const float* w = A.in[I_WPP]; tr_matrix([=](int k, int n) -> float { return __builtin_nontemporal_load(w + (size_t)k * 1024 + n); }, 256, 1024, Wpp_t, scr, gw, NGW, lane); }
        { const float* w2 = A.in[I_W2]; const float* a2 = A.in[I_A2]; const float* g2 = A.in[I_G2];
          tr_matrix([=](int k, int n) -> float {
              if (n < 512) return k < 64 ? w2[k * 512 + n] : 0.f;
              if (n < 1024) return (k >= 64 && k < 128) ? a2[(k - 64) * 512 + n - 512] : 0.f;
              return (k >= 128 && k < 288) ? g2[(k - 128) * 512 + n - 1024] : 0.f;
          }, 384, 1536, Wl2_t, scr, gw, NGW, lane); }
        { const float* c1 = A.in[I_CW1];
          tr_matrix([=](int k, int n) -> float { return n < 128 ? c1[(size_t)k * 128 + n] : c1[(size_t)(1024 + k) * 128 + n - 128]; }, 1024, 256, Wc1k_t, scr, gw, NGW, lane);
          tr_matrix([=](int k, int n) -> float { return n < 128 ? c1[(size_t)(2048 + k) * 128 + n] : c1[(size_t)(2048 + 1024 + k) * 128 + n - 128]; }, 1024, 256, Wc1v_t, scr, gw, NGW, lane); }
        rms_rows<true, true>((float*)A.in[I_X], A.in[I_LN1], U, gw, NGW, lane);
        { const f32x4* p4 = (const f32x4*)A.in[I_P]; u32x2* o = (u32x2*)PB;
          for (int i0 = gtid; i0 < T * PLE / 4; i0 += 8 * NGT) { f32x4 v[8];
#pragma unroll
              for (int u = 0; u < 8; ++u) { const int i = i0 + u * NGT; if (i < T * PLE / 4) v[u] = __builtin_nontemporal_load(p4 + i); }
#pragma unroll
              for (int u = 0; u < 8; ++u) { const int i = i0 + u * NGT; if (i < T * PLE / 4) { u32x2 w; w.x = cvt_pk_bf16(v[u].x, v[u].y); w.y = cvt_pk_bf16(v[u].z, v[u].w); o[i] = w; } } } }
        {
            for (int it = gw; it < 2048; it += NGW) {
                const int o = it & 255, part = it >> 8, kv = o >> 7, n = o & 127; const float* pos = A.in[I_CPOS] + kv * 2048 + part * 256; const float* c1 = A.in[I_CW1] + ((size_t)kv * 2048 + part * 256) * 128;
                float s = 0.f;
#pragma unroll
                for (int q = 0; q < 4; ++q) { const int i = lane + 64 * q; s += pos[i] * c1[(size_t)i * 128 + n]; }
                s = wave_sum(s);
                if (lane == 0) CB[part * 256 + o] = s;
            }
        }
    }
    GSYNC();
    {
        PHASE_BEGIN(); ALLPTRS();
        pg8::Gemm g = pg8::mk_gemm(U, DM, Win_t, T, 5632, DM); pg8::StaticOrder S; S.init(T, 5632, G, bid);
        pg8::EpiProj E{PROJ, (unsigned char*)A.out + 64 * MiB};
        pg8::gemm_phase<pg8::EpiProj, true>(ldsl, g, S, E);
    }
    GSYNC();
    {
        PHASE_BEGIN(); ALLPTRS();
        {
            const int gt2 = gtid, NG2 = NGT;
            for (int i0 = gt2; i0 < T * 48; i0 += 4 * NG2) {
                u32x4 la[4], lb[4];
#pragma unroll
                for (int u = 0; u < 4; ++u) { const int i = i0 + u * NG2; la[u] = (u32x4){0u, 0u, 0u, 0u}; lb[u] = la[u];
                    if (i < T * 48) { const int t = i / 48, cg8 = (i % 48) * 8;
                        if (cg8 < 288) { la[u] = *(const u32x4*)(PROJ + (size_t)t * LDP + C_L1 + cg8); if ((t & (SEQ - 1)) != 0) lb[u] = *(const u32x4*)(PROJ + (size_t)(t - 1) * LDP + C_L2 + cg8); } } }
#pragma unroll
                for (int u = 0; u < 4; ++u) { const int i = i0 + u * NG2;
                    if (i < T * 48) { const int t = i / 48, cg8 = (i % 48) * 8;
                        u32x4 w = (u32x4){0u, 0u, 0u, 0u};
                        if (cg8 < 288) {
                            float a[8], bq[8]; unpack8(la[u], a); unpack8(lb[u], bq);
#pragma unroll
                            for (int e = 0; e < 8; ++e) a[e] += bq[e];
                            if (cg8 < 64) {
#pragma unroll
                                for (int e = 0; e < 8; ++e) a[e] = tanhf_(a[e]);
                            } else if (cg8 >= 128) {
#pragma unroll
                                for (int e = 0; e < 8; ++e) a[e] = sigmoidf_(a[e]);
                            }
                            w.x = cvt_pk_bf16(a[0], a[1]); w.y = cvt_pk_bf16(a[2], a[3]); w.z = cvt_pk_bf16(a[4], a[5]); w.w = cvt_pk_bf16(a[6], a[7]);
                        }
                        *(u32x4*)(A2 + (size_t)t * 384 + cg8) = w; } }
            }
        }
        __syncthreads();
        if (bid < 128) {
            const int isv = bid >> 6, sq = (bid >> 4) & 3;
            pg8::Gemm g; g.M = 4096; g.N = 256; g.K = 256; g.ldb = 1024; g.a_row = 16u * LDP * 2u; g.a_kstep = (size_t)LDP * 2; g.a_hstep = 128; g.a_tstep = (size_t)SEQ * LDP * 2;
            pg8::StaticOrder S; S.init(4096, 256, 16, bid & 15);
            g.A = PROJ + (isv ? C_VC : C_KC) + (size_t)(4 * sq) * LDP; g.Bt = (isv ? Wc1v_t : Wc1k_t) + 256 * sq;
            bf16_t* hdst = (bf16_t*)(wsq + WS_H12P) + (size_t)(isv * 4 + sq) * 4096 * 256;
            pg8::EpiB<0> E{hdst, 256, 256, nullptr, nullptr, nullptr, 0, nullptr}; pg8::gemm_phase<pg8::EpiB<0>, true>(ldsl, g, S, E);
        }
    }
    GSYNC();
    {
        PHASE_BEGIN(); ALLPTRS();
        {
            pg8::Gemm g = pg8::mk_gemm(A2, 384, Wl2_t, T, 1536, 384); pg8::StaticOrder S; S.init(T, 1536, G, bid);
            pg8::EpiB<2> E{LO, 1536, 1536, A.in[I_W0], A.in[I_A0], nullptr, 0, nullptr};
            pg8::gemm_phase<pg8::EpiB<2>, true>(ldsl, g, S, E);
        }
        const float* cw2 = A.in[I_CW2];
        for (int it = gw; it < 2 * 32 * 128; it += NGW) {
            const int kv = it >> 12, rowi = it & 4095, c = rowi & 127;
            bf16_t* dst = (kv ? VCB : KCB) + (size_t)rowi * 64;
            if (c == 127) { dst[lane] = 0; continue; }
            const bf16_t* Hm = (const bf16_t*)(wsq + WS_H12P) + (size_t)(kv * 4) * 4096 * 256;
            float cb0 = 0.f, cb1 = 0.f;
#pragma unroll
            for (int part = 0; part < 8; ++part) { cb0 += CB[part * 256 + kv * 128 + lane]; cb1 += CB[part * 256 + kv * 128 + 64 + lane]; }
            float h0 = cb0, h1 = cb1;
#pragma unroll
            for (int sq = 0; sq < 4; ++sq) { const bf16_t* Hs = Hm + (size_t)sq * 4096 * 256;
                h0 += bf2f(Hs[(size_t)rowi * 256 + lane]) + bf2f(Hs[(size_t)(rowi + 1) * 256 + 128 + lane]);
                h1 += bf2f(Hs[(size_t)rowi * 256 + 64 + lane]) + bf2f(Hs[(size_t)(rowi + 1) * 256 + 192 + lane]); }
            h0 = h0 * sigmoidf_(h0); h1 = h1 * sigmoidf_(h1);
            const float* w2 = cw2 + kv * 128 * 64;
            float acc = 0.f;
#pragma unroll 16
            for (int i = 0; i < 64; ++i) acc += __shfl(h0, i) * w2[i * 64 + lane];
#pragma unroll 16
            for (int i = 0; i < 64; ++i) acc += __shfl(h1, i) * w2[(64 + i) * 64 + lane];
            dst[lane] = (bf16_t)(cvt_pk_bf16(acc, 0.f) & 0xffffu);
        }
    }
    GSYNC();
    {
        PHASE_BEGIN(); ALLPTRS();
        if (bid < 128) scan_unit(A, bid, lds);
        unsigned* qheads = (unsigned*)(wsq + WS_CTL) + 6144;
        unsigned* slot = (unsigned*)(lds + 35840 + 32768 + 8192 + 512);
        const int myx = (int)(xb_xcc_id() & 7u);
        for (int qq = 0; qq < 8; ++qq) {
            const int q = (myx + qq) & 7;
            for (;;) {
                __syncthreads();
                if (tid == 0) *slot = atomicAdd(qheads + 64 * q, 1u);
                __syncthreads();
                const unsigned v = *slot;
                if (v >= 128u) break;
                const int qt = 31 - (int)(v >> 2), bh = 4 * q + (int)(v & 3);
                attn_unit(A, bh >> 1, bh & 1, qt, lds);
            }
        }
    }
    GSYNC();
    {
        PHASE_BEGIN(); ALLPTRS();
        pg8::StaticOrder S; S.init(T, 1024, G, bid);
        { pg8::Gemm g = pg8::mk_gemm(YA, 512, Woa_t, T, 1024, 512); pg8::EpiB<3> E{MB, 1024, 1024, nullptr, nullptr, (const bf16_t*)((const unsigned char*)A.out + 64 * MiB), 2048, nullptr}; pg8::gemm_phase<pg8::EpiB<3>, true>(ldsl, g, S, E); }
        asm volatile("s_waitcnt vmcnt(0)" ::: "memory"); __syncthreads();
        { pg8::Gemm g = pg8::mk_gemm(YB, 512, Wob_t, T, 1024, 512); pg8::EpiB<3> E{MB, 1024, 1024, nullptr, nullptr, (const bf16_t*)((const unsigned char*)A.out + 64 * MiB + 1024), 2048, MB}; pg8::gemm_phase<pg8::EpiB<3>, true>(ldsl, g, S, E); }
    }
    GSYNC();
    {
        PHASE_BEGIN(); ALLPTRS();
        pg8::Gemm g = pg8::mk_gemm(MB, 1024, Wo_t, T, 1024, 1024); pg8::StaticOrder S; S.init(T, 1024, G, bid);
        pg8::EpiFN<false> E{A.in[I_X], U2, 1024, (float*)(wsq + WS_PART)};
        pg8::gemm_phase<pg8::EpiFN<false>, true>(ldsl, g, S, E);
    }
    GSYNC();
    {
        PHASE_BEGIN(); ALLPTRS();
        pg8::Gemm g = pg8::mk_gemm(U2, DM, Wup_t, T, 5632, DM); pg8::StaticOrder S; S.init(T, 5632, G, bid);
        {
            const float* part = (const float*)(wsq + WS_PART); float* RS = (float*)(wsq + WS_RS); pg8::Unit uu; int lastpm = -1;
            for (int ui = 0; S.next(ui, uu); ++ui) { if (uu.pm == lastpm) continue; lastpm = uu.pm;
                if (tid < 256) { const int r = uu.pm * 256 + tid; float sum = 0.f;
#pragma unroll
                    for (int q = 0; q < 16; ++q) sum += part[(size_t)q * T + r];
                    RS[r] = 1.f / sqrtf(sum * (1.f / 1024.f) + 1e-6f); } }
            asm volatile("s_waitcnt vmcnt(0)" ::: "memory"); __syncthreads();
        }
        pg8::EpiGlu E{ACT, A.in[I_CONVW], A.in[I_CONVB], (float*)(wsq + WS_GH), (LAS float*)(ldsl + 131072), (const float*)(wsq + WS_RS)};
        pg8::gemm_phase<pg8::EpiGlu, true, true>(ldsl, g, S, E);
        {
            pg8::Gemm g2 = pg8::mk_gemm(PB, 256, Wpp_t, T, 1024, 256); pg8::StaticOrder S2; S2.init(T, 1024, G, bid);
            pg8::EpiB<0> E2{PP, 1024, 1024, nullptr, nullptr, nullptr, 0, nullptr};
            pg8::gemm_phase<pg8::EpiB<0>, true>(ldsl, g2, S2, E2);
        }
    }
    GSYNC();
    {
        PHASE_BEGIN(); ALLPTRS();
        pg8::Gemm g = pg8::mk_gemm(ACT, DFF, Wdn_t, T, 1024, DFF); pg8::StaticOrder S; S.init(T, 1024, G, bid);
        {
            const float* cw = A.in[I_CONVW]; const float* cb = A.in[I_CONVB]; const float* GH = (const float*)(wsq + WS_GH);
            pg8::Unit uu;
            for (int ui = 0; S.next(ui, uu); ++ui) {
                const int pm = uu.pm; if ((pm & 7) == 0) continue;
                for (int idx = tid; idx < 2 * DFF; idx += NTHREADS) {
                    const int row = idx / DFF, col = idx - row * DFF;
                    float xa[4], xb[4];
#pragma unroll
                    for (int q = 0; q < 4; ++q) { const int tp = q < 2 ? pm - 1 : pm, rr = q < 2 ? 2 + q : q - 2; xa[q] = GH[((size_t)(tp * 4 + rr) * 2 + 0) * DFF + col]; xb[q] = GH[((size_t)(tp * 4 + rr) * 2 + 1) * DFF + col]; }
                    const float a0 = row ? xa[1] : xa[0], a1 = row ? xa[2] : xa[1], a2 = row ? xa[3] : xa[2], b0 = row ? xb[1] : xb[0], b1 = row ? xb[2] : xb[1], b2 = row ? xb[3] : xb[2];
                    const float ha = cb[col] + cw[col] * a0 + cw[5632 + col] * a1 + cw[2 * 5632 + col] * a2;
                    const float hb = cb[DFF + col] + cw[DFF + col] * b0 + cw[5632 + DFF + col] * b1 + cw[2 * 5632 + DFF + col] * b2;
                    ACT[((size_t)pm * 256 + row) * DFF + col] = (bf16_t)(cvt_pk_bf16(ha * sigmoidf_(ha) * hb, 0.f) & 0xffffu);
                }
            }
            asm volatile("s_waitcnt vmcnt(0)" ::: "memory"); __syncthreads();
        }
        pg8::EpiFN<true> E{U2, U2, 1024, (float*)(wsq + WS_PART)};
        pg8::gemm_phase<pg8::EpiFN<true>, true>(ldsl, g, S, E);
    }
    GSYNC();
    {
        PHASE_BEGIN(); ALLPTRS();
        pg8::Gemm g = pg8::mk_gemm(U2, DM, Wpg_t, T, 1024, DM); pg8::StaticOrder S; S.init(T, 1024, G, bid);
        {
            const float* part = (const float*)(wsq + WS_PART); float* RS = (float*)(wsq + WS_RS); pg8::Unit uu; int lastpm = -1;
            for (int ui = 0; S.next(ui, uu); ++ui) { if (uu.pm == lastpm) continue; lastpm = uu.pm;
                if (tid < 256) { const int r = uu.pm * 256 + tid; float sum = 0.f;
#pragma unroll
                    for (int q = 0; q < 16; ++q) sum += part[(size_t)q * T + r];
                    RS[r] = 1.f / sqrtf(sum * (1.f / 1024.f) + 1e-6f); } }
            asm volatile("s_waitcnt vmcnt(0)" ::: "memory"); __syncthreads();
        }
        pg8::EpiFinal E{U2, H, 1024, PP, (const float*)(wsq + WS_RS), A.in[I_LNF], (float*)(wsq + WS_PART + 2 * MiB), (unsigned*)(wsq + WS_CTL + 32768), (LAS float*)(ldsl + 131072)};
        pg8::gemm_phase<pg8::EpiFinal, true>(ldsl, g, S, E);
    }
}

extern "C" void kernel_launch(void* const* d_in, const int* in_sizes, int n_in, void* d_out, int out_size, void* d_ws, size_t ws_size, hipStream_t stream) {
    static int grid = 0;
    if (grid == 0) {
        if (n_in != 34 || ws_size < WS_END) { fprintf(stderr, "kernel_launch: unexpected n_in %d / ws_size %zu\n", n_in, ws_size); grid = -1; return; }
        int dev = 0, cus = 0, per_cu = 0;
        hipGetDevice(&dev); hipDeviceGetAttribute(&cus, hipDeviceAttributeMultiprocessorCount, dev);
        hipFuncSetAttribute((const void*)fwd_kernel, hipFuncAttributeMaxDynamicSharedMemorySize, LDS_BYTES);
        hipOccupancyMaxActiveBlocksPerMultiprocessor(&per_cu, (const void*)fwd_kernel, NTHREADS, LDS_BYTES);
        if (per_cu < 1) { fprintf(stderr, "kernel_launch: occupancy query says %d\n", per_cu); per_cu = 1; }
        (void)hipGetLastError();
        grid = cus * 1;
        if (grid > 256) grid = 256;
    }
    if (grid < 0) return;
    hipMemsetAsync((char*)d_ws + WS_CTL, 0, 65536, stream);
    Args a{};
    for (int i = 0; i < 34; ++i) a.in[i] = (const float*)d_in[i];
    a.out = (float*)d_out; a.ws = (unsigned char*)d_ws;
    void* args[] = {&a};
    hipError_t e = hipLaunchCooperativeKernel((const void*)fwd_kernel, dim3(grid), dim3(NTHREADS), args, LDS_BYTES, stream);
    if (e != hipSuccess) fprintf(stderr, "cooperative launch failed: %s (grid %d)\n", hipGetErrorString(e), grid);
}
```
